# Optimizing an MI355X kernel written in HIP

```python
import math
import jax, jax.numpy as jnp
from jax import lax
import numpy as np

D_MODEL = 1024
BATCH = 1
SEQ = 16384
DEPTH = 4

N_MIXERS = 4
EPS = 1e-6
Q_BLOCK = 128
D_FF = 4 * D_MODEL

DSA_HEADS = 8
DSA_HEAD_DIM = D_MODEL // DSA_HEADS
IDX_HEADS = 8
IDX_DIM = 64
TOPK_MAX = 256
DSA_IN = 3 * D_MODEL + IDX_HEADS * IDX_DIM + IDX_DIM + IDX_HEADS

CONV_WIDTH = 31

MLA_HEADS = 16
MLA_Q_LORA = 384
MLA_KV_LORA = 256
MLA_NOPE = 64
MLA_ROPE = 32
MLA_V = 64
ROPE_THETA = 10000.0
MLA_IN = MLA_Q_LORA + MLA_KV_LORA + MLA_ROPE

GDN_HEADS = 8
GDN_DK = 128
GDN_DV = 128
GDN_CONV = 4
GDN_CHUNK = 64
GDN_HK = GDN_HEADS * GDN_DK
GDN_HV = GDN_HEADS * GDN_DV
GDN_IN = 2 * GDN_HK + 2 * GDN_HV + 2 * GDN_HEADS

kernel_name = 'hybrid_dsa_conformer_mla_gdn_trunk'


def rmsnorm(x, g):
    xf = x.astype(jnp.float32)
    y = xf * lax.rsqrt(jnp.mean(xf * xf, axis=-1, keepdims=True) + EPS)
    return (y * g.astype(jnp.float32)).astype(x.dtype)


def layernorm(x, g, b):
    xf = x.astype(jnp.float32)
    mu = jnp.mean(xf, axis=-1, keepdims=True)
    var = jnp.mean(jnp.square(xf - mu), axis=-1, keepdims=True)
    y = (xf - mu) * lax.rsqrt(var + EPS) * g.astype(jnp.float32) + b.astype(jnp.float32)
    return y.astype(x.dtype)


def l2norm(x):
    return x * lax.rsqrt(jnp.sum(x * x, axis=-1, keepdims=True) + EPS)


def causal_depthwise_conv(x, w):
    width = w.shape[0]
    xp = jnp.pad(x, ((0, 0), (width - 1, 0), (0, 0)))
    return lax.conv_general_dilated(xp, w[:, None, :].astype(x.dtype), window_strides=(1,), padding='VALID',
                                    dimension_numbers=('NWC', 'WIO', 'NWC'), feature_group_count=x.shape[-1])


def rope_tables(length, dim):
    pos = jnp.arange(length, dtype=jnp.float32)
    inv_freq = ROPE_THETA ** (-jnp.arange(0, dim, 2, dtype=jnp.float32) / dim)
    ang = pos[:, None] * inv_freq[None, :]
    return jnp.cos(ang), jnp.sin(ang)


def apply_rope(x, cos, sin):
    xf = x.astype(jnp.float32)
    half = x.shape[-1] // 2
    x1, x2 = xf[..., :half], xf[..., half:]
    return jnp.concatenate([x1 * cos - x2 * sin, x2 * cos + x1 * sin], axis=-1).astype(x.dtype)


def blocked_queries(fn, *qs):
    b, length = qs[0].shape[0], qs[0].shape[1]
    nb = length // Q_BLOCK
    blks = [jnp.moveaxis(q.reshape(b, nb, Q_BLOCK, *q.shape[2:]), 1, 0) for q in qs]
    t0 = jnp.arange(nb, dtype=jnp.int32) * Q_BLOCK
    out = lax.map(lambda a: fn(*a), (t0, *blks))
    out = jnp.moveaxis(out, 0, 1)
    return out.reshape(b, length, *out.shape[3:])


def dsa_mixer(h, w_in, idx_k_g, idx_k_b, w_out):
    b, length, _ = h.shape
    topk = min(TOPK_MAX, length // 4)
    proj = h @ w_in
    o1 = D_MODEL; o2 = 2 * D_MODEL; o3 = 3 * D_MODEL
    o4 = o3 + IDX_HEADS * IDX_DIM; o5 = o4 + IDX_DIM
    q = proj[..., :o1].reshape(b, length, DSA_HEADS, DSA_HEAD_DIM)
    k = proj[..., o1:o2].reshape(b, length, DSA_HEADS, DSA_HEAD_DIM)
    v = proj[..., o2:o3].reshape(b, length, DSA_HEADS, DSA_HEAD_DIM)
    qi = proj[..., o3:o4].reshape(b, length, IDX_HEADS, IDX_DIM).astype(jnp.float32)
    ki = layernorm(proj[..., o4:o5], idx_k_g, idx_k_b).astype(jnp.float32)
    wi = proj[..., o5:].astype(jnp.float32) * (IDX_HEADS ** -0.5 * IDX_DIM ** -0.5)
    key_pos = jnp.arange(length, dtype=jnp.int32)
    scale = DSA_HEAD_DIM ** -0.5

    def block(t0, qb, qib, wib):
        qpos = t0 + jnp.arange(Q_BLOCK, dtype=jnp.int32)
        causal = key_pos[None, :] <= qpos[:, None]
        s = jax.nn.relu(jnp.einsum('bqhd,bsd->bqhs', qib, ki))
        score = jnp.einsum('bqh,bqhs->bqs', wib, s)
        score = jnp.where(causal[None], score, -jnp.inf)
        _, sel = lax.top_k(score, topk)
        valid = sel <= qpos[None, :, None]
        k_sel = jax.vmap(lambda kk, ii: kk[ii])(k, sel)
        v_sel = jax.vmap(lambda vv, ii: vv[ii])(v, sel)
        logits = jnp.einsum('bqhd,bqkhd->bqhk', qb, k_sel).astype(jnp.float32) * scale
        logits = jnp.where(valid[:, :, None, :], logits, -jnp.inf)
        p = jax.nn.softmax(logits, axis=-1)
        return jnp.einsum('bqhk,bqkhd->bqhd', p.astype(v.dtype), v_sel)

    o = blocked_queries(block, q, qi, wi)
    return o.reshape(b, length, D_MODEL) @ w_out


def conv_mixer(h, w_pw1, b_pw1, w_dw, b_dw, ln_g, ln_b, w_pw2, b_pw2):
    a = h @ w_pw1 + b_pw1
    u = a[..., :D_MODEL] * jax.nn.sigmoid(a[..., D_MODEL:])
    u = causal_depthwise_conv(u, w_dw) + b_dw
    u = jax.nn.silu(layernorm(u, ln_g, ln_b))
    return u @ w_pw2 + b_pw2


def mla_mixer(h, w_in, q_norm_g, w_uq, kv_norm_g, w_ukv, w_out):
    b, length, _ = h.shape
    proj = h @ w_in
    cq = rmsnorm(proj[..., :MLA_Q_LORA], q_norm_g)
    ckv = rmsnorm(proj[..., MLA_Q_LORA:MLA_Q_LORA + MLA_KV_LORA], kv_norm_g)
    kr = proj[..., MLA_Q_LORA + MLA_KV_LORA:]
    q = (cq @ w_uq).reshape(b, length, MLA_HEADS, MLA_NOPE + MLA_ROPE)
    kv = (ckv @ w_ukv).reshape(b, length, MLA_HEADS, MLA_NOPE + MLA_V)
    q_nope, q_rope = q[..., :MLA_NOPE], q[..., MLA_NOPE:]
    k_nope, v = kv[..., :MLA_NOPE], kv[..., MLA_NOPE:]
    cos, sin = rope_tables(length, MLA_ROPE)
    q_rope = apply_rope(q_rope, cos[None, :, None, :], sin[None, :, None, :])
    kr = apply_rope(kr, cos[None], sin[None])
    key_pos = jnp.arange(length, dtype=jnp.int32)
    scale = (MLA_NOPE + MLA_ROPE) ** -0.5

    def block(t0, qn, qr):
        qpos = t0 + jnp.arange(Q_BLOCK, dtype=jnp.int32)
        causal = key_pos[None, :] <= qpos[:, None]
        logits = (jnp.einsum('bqhd,bshd->bhqs', qn, k_nope)
                  + jnp.einsum('bqhr,bsr->bhqs', qr, kr)).astype(jnp.float32) * scale
        logits = jnp.where(causal[None, None], logits, -jnp.inf)
        p = jax.nn.softmax(logits, axis=-1)
        return jnp.einsum('bhqs,bshd->bqhd', p.astype(v.dtype), v)

    o = blocked_queries(block, q_nope, q_rope)
    return o.reshape(b, length, MLA_HEADS * MLA_V) @ w_out


def chunk_gated_delta_rule(q, k, v, g, beta):
    b, length, nh, dk = q.shape
    dv = v.shape[-1]
    c = GDN_CHUNK
    n = length // c

    def to_chunks(x):
        return jnp.moveaxis(x.reshape(b, n, c, nh, *x.shape[3:]), 3, 1)

    q, k, v, g, beta = to_chunks(q), to_chunks(k), to_chunks(v), to_chunks(g), to_chunks(beta)
    gc = jnp.cumsum(g, axis=-1)
    tril = jnp.tril(jnp.ones((c, c), dtype=bool))
    tril_strict = jnp.tril(jnp.ones((c, c), dtype=bool), -1)
    diff = gc[..., :, None] - gc[..., None, :]
    decay_mat = jnp.where(tril, jnp.exp(jnp.where(tril, diff, 0.0)), 0.0)
    kk = jnp.einsum('bhncd,bhnsd->bhncs', k, k)
    a_mat = jnp.where(tril_strict, beta[..., :, None] * kk * decay_mat, 0.0)
    eye = jnp.eye(c, dtype=jnp.float32)
    rhs = jnp.concatenate([v * beta[..., None], k * (beta * jnp.exp(gc))[..., None]], axis=-1)
    sol = lax.linalg.triangular_solve(eye + a_mat, rhs, left_side=True, lower=True, unit_diagonal=True)
    u, w = sol[..., :dv], sol[..., dv:]
    qk = jnp.einsum('bhncd,bhnsd->bhncs', q, k) * decay_mat
    q_dec = q * jnp.exp(gc)[..., None]
    k_dec = k * jnp.exp(gc[..., -1:] - gc)[..., None]
    g_last = jnp.exp(gc[..., -1])

    xs = (jnp.moveaxis(u, 2, 0), jnp.moveaxis(w, 2, 0), jnp.moveaxis(qk, 2, 0),
          jnp.moveaxis(q_dec, 2, 0), jnp.moveaxis(k_dec, 2, 0), jnp.moveaxis(g_last, 2, 0))

    def step(s, inp):
        u_c, w_c, qk_c, qd_c, kd_c, gl_c = inp
        v_new = u_c - jnp.einsum('bhcd,bhdv->bhcv', w_c, s)
        o_c = jnp.einsum('bhcd,bhdv->bhcv', qd_c, s) + jnp.einsum('bhcs,bhsv->bhcv', qk_c, v_new)
        s = s * gl_c[..., None, None] + jnp.einsum('bhcd,bhcv->bhdv', kd_c, v_new)
        return s, o_c

    s0 = jnp.zeros((b, nh, dk, dv), dtype=jnp.float32)
    _, o = lax.scan(step, s0, xs)
    return jnp.transpose(o, (1, 0, 3, 2, 4)).reshape(b, length, nh, dv)


def gdn_mixer(h, w_in, conv_w, a_log, dt_bias, o_norm_g, w_out):
    b, length, _ = h.shape
    proj = h @ w_in
    n_qkv = 2 * GDN_HK + GDN_HV
    qkv = jax.nn.silu(causal_depthwise_conv(proj[..., :n_qkv], conv_w))
    gate = proj[..., n_qkv:n_qkv + GDN_HV].reshape(b, length, GDN_HEADS, GDN_DV).astype(jnp.float32)
    b_raw = proj[..., n_qkv + GDN_HV:n_qkv + GDN_HV + GDN_HEADS].astype(jnp.float32)
    a_raw = proj[..., n_qkv + GDN_HV + GDN_HEADS:].astype(jnp.float32)
    q = l2norm(qkv[..., :GDN_HK].reshape(b, length, GDN_HEADS, GDN_DK).astype(jnp.float32))
    k = l2norm(qkv[..., GDN_HK:2 * GDN_HK].reshape(b, length, GDN_HEADS, GDN_DK).astype(jnp.float32))
    v = qkv[..., 2 * GDN_HK:].reshape(b, length, GDN_HEADS, GDN_DV).astype(jnp.float32)
    beta = jax.nn.sigmoid(b_raw)
    g = -jnp.exp(a_log.astype(jnp.float32)) * jax.nn.softplus(a_raw + dt_bias.astype(jnp.float32))
    o = chunk_gated_delta_rule(q * GDN_DK ** -0.5, k, v, g, beta)
    o = rmsnorm(o, o_norm_g) * jax.nn.silu(gate)
    return o.reshape(b, length, GDN_HV).astype(h.dtype) @ w_out


def sq_relu_mlp(h, w1, w2):
    return jnp.square(jax.nn.relu(h @ w1)) @ w2


def _num_layers_of(m):
    return len(range(m, DEPTH, N_MIXERS))


def setup_inputs(seed: int = 0) -> dict:
    key = jax.random.key(seed)
    keys = jax.random.split(key, 64)
    counter = [0]

    def nxt():
        kk = keys[counter[0]]
        counter[0] += 1
        return kk

    def nrm(shape, fan_in):
        return jax.random.normal(nxt(), shape, jnp.float32) * fan_in ** -0.5

    def gain(shape):
        return 1.0 + 0.02 * jax.random.normal(nxt(), shape, jnp.float32)

    def bias(shape):
        return 0.02 * jax.random.normal(nxt(), shape, jnp.float32)

    na, nb, nc, nd = (_num_layers_of(m) for m in range(N_MIXERS))
    x = jax.random.normal(nxt(), (BATCH, SEQ, D_MODEL), jnp.float32)
    dt = jnp.exp(jax.random.uniform(nxt(), (nd, GDN_HEADS), jnp.float32, math.log(1e-3), math.log(1e-1)))
    return {
        'x': x,
        'norm_mix_g': gain((DEPTH, D_MODEL)),
        'norm_mlp_g': gain((DEPTH, D_MODEL)),
        'final_g': gain((D_MODEL,)),
        'mlp_w1': nrm((DEPTH, D_MODEL, D_FF), D_MODEL),
        'mlp_w2': nrm((DEPTH, D_FF, D_MODEL), D_FF),
        'dsa_w_in': nrm((na, D_MODEL, DSA_IN), D_MODEL),
        'dsa_idx_k_g': gain((na, IDX_DIM)),
        'dsa_idx_k_b': bias((na, IDX_DIM)),
        'dsa_w_out': nrm((na, D_MODEL, D_MODEL), D_MODEL),
        'conv_w_pw1': nrm((nb, D_MODEL, 2 * D_MODEL), D_MODEL),
        'conv_b_pw1': bias((nb, 2 * D_MODEL)),
        'conv_w_dw': nrm((nb, CONV_WIDTH, D_MODEL), CONV_WIDTH),
        'conv_b_dw': bias((nb, D_MODEL)),
        'conv_ln_g': gain((nb, D_MODEL)),
        'conv_ln_b': bias((nb, D_MODEL)),
        'conv_w_pw2': nrm((nb, D_MODEL, D_MODEL), D_MODEL),
        'conv_b_pw2': bias((nb, D_MODEL)),
        'mla_w_in': nrm((nc, D_MODEL, MLA_IN), D_MODEL),
        'mla_q_norm_g': gain((nc, MLA_Q_LORA)),
        'mla_w_uq': nrm((nc, MLA_Q_LORA, MLA_HEADS * (MLA_NOPE + MLA_ROPE)), MLA_Q_LORA),
        'mla_kv_norm_g': gain((nc, MLA_KV_LORA)),
        'mla_w_ukv': nrm((nc, MLA_KV_LORA, MLA_HEADS * (MLA_NOPE + MLA_V)), MLA_KV_LORA),
        'mla_w_out': nrm((nc, MLA_HEADS * MLA_V, D_MODEL), MLA_HEADS * MLA_V),
        'gdn_w_in': nrm((nd, D_MODEL, GDN_IN), D_MODEL),
        'gdn_conv_w': nrm((nd, GDN_CONV, 2 * GDN_HK + GDN_HV), GDN_CONV),
        'gdn_a_log': jnp.log(jax.random.uniform(nxt(), (nd, GDN_HEADS), jnp.float32, 1.0, 16.0)),
        'gdn_dt_bias': dt + jnp.log(-jnp.expm1(-dt)),
        'gdn_o_norm_g': gain((nd, GDN_DV)),
        'gdn_w_out': nrm((nd, GDN_HV, D_MODEL), GDN_HV),
    }


def reference(x, norm_mix_g, norm_mlp_g, final_g, mlp_w1, mlp_w2,
              dsa_w_in, dsa_idx_k_g, dsa_idx_k_b, dsa_w_out,
              conv_w_pw1, conv_b_pw1, conv_w_dw, conv_b_dw, conv_ln_g, conv_ln_b, conv_w_pw2, conv_b_pw2,
              mla_w_in, mla_q_norm_g, mla_w_uq, mla_kv_norm_g, mla_w_ukv, mla_w_out,
              gdn_w_in, gdn_conv_w, gdn_a_log, gdn_dt_bias, gdn_o_norm_g, gdn_w_out):
    h = x
    for i in range(DEPTH):
        m = i % N_MIXERS
        j = i // N_MIXERS
        hn = rmsnorm(h, norm_mix_g[i])
        if m == 0:
            y = dsa_mixer(hn, dsa_w_in[j], dsa_idx_k_g[j], dsa_idx_k_b[j], dsa_w_out[j])
        elif m == 1:
            y = conv_mixer(hn, conv_w_pw1[j], conv_b_pw1[j], conv_w_dw[j], conv_b_dw[j],
                           conv_ln_g[j], conv_ln_b[j], conv_w_pw2[j], conv_b_pw2[j])
        elif m == 2:
            y = mla_mixer(hn, mla_w_in[j], mla_q_norm_g[j], mla_w_uq[j], mla_kv_norm_g[j],
                          mla_w_ukv[j], mla_w_out[j])
        else:
            y = gdn_mixer(hn, gdn_w_in[j], gdn_conv_w[j], gdn_a_log[j], gdn_dt_bias[j],
                          gdn_o_norm_g[j], gdn_w_out[j])
        h = h + y
        h = h + sq_relu_mlp(rmsnorm(h, norm_mlp_g[i]), mlp_w1[i], mlp_w2[i])
    return rmsnorm(h, final_g)
```

```cpp
#include <hip/hip_runtime.h>
#include <cstdio>
#include <cstdint>
#ifndef SKIPMIX
#define SKIPMIX 0
#endif

#define GAS __attribute__((address_space(1)))
#define LAS __attribute__((address_space(3)))
typedef unsigned short u16;
typedef unsigned char uchar;
typedef short s16x8 __attribute__((ext_vector_type(8)));
typedef short s16x4 __attribute__((ext_vector_type(4)));
typedef _Float16 h16x8 __attribute__((ext_vector_type(8)));
typedef _Float16 h16x2 __attribute__((ext_vector_type(2)));
typedef float f32x2 __attribute__((ext_vector_type(2)));
typedef float f32x4 __attribute__((ext_vector_type(4)));
typedef float f32x16 __attribute__((ext_vector_type(16)));
typedef unsigned u32x2 __attribute__((ext_vector_type(2)));
typedef unsigned u32x4 __attribute__((ext_vector_type(4)));

__device__ __forceinline__ unsigned pk16(float lo, float hi) { h16x2 v = {(_Float16)lo, (_Float16)hi}; return __builtin_bit_cast(unsigned, v); }
__device__ __forceinline__ u16 f2h(float f) { _Float16 h = (_Float16)f; return __builtin_bit_cast(u16, h); }
__device__ __forceinline__ float h2f(u16 u) { return (float)__builtin_bit_cast(_Float16, u); }
__device__ __forceinline__ f32x4 mfma16(s16x8 a, s16x8 b, f32x4 c) { return __builtin_amdgcn_mfma_f32_16x16x32_f16(__builtin_bit_cast(h16x8, a), __builtin_bit_cast(h16x8, b), c, 0, 0, 0); }
__device__ __forceinline__ f32x16 mfma32(s16x8 a, s16x8 b, f32x16 c) { return __builtin_amdgcn_mfma_f32_32x32x16_f16(__builtin_bit_cast(h16x8, a), __builtin_bit_cast(h16x8, b), c, 0, 0, 0); }
__device__ __forceinline__ u32x4 pack8(f32x4 a, f32x4 b) { u32x4 w; w.x = pk16(a[0], a[1]); w.y = pk16(a[2], a[3]); w.z = pk16(b[0], b[1]); w.w = pk16(b[2], b[3]); return w; }
__device__ __forceinline__ float wave_sum(float v) {
#pragma unroll
    for (int o = 1; o < 64; o <<= 1) v += __shfl_xor(v, o);
    return v;
}
__device__ __forceinline__ float sigmoidf_(float x) { return 1.f / (1.f + __expf(-x)); }
__device__ __forceinline__ float siluf_(float x) { return x / (1.f + __expf(-x)); }

__device__ __forceinline__ int opaque_tid() { int t = threadIdx.x; asm volatile("" : "+v"(t)); return t; }

namespace pg8 {
#define PG8_LAS __attribute__((address_space(3)))
typedef unsigned short bf16_t;
typedef short bf16x8 __attribute__((ext_vector_type(8)));
typedef float f32x4 __attribute__((ext_vector_type(4)));
typedef unsigned u32x4 __attribute__((ext_vector_type(4)));
constexpr int BM = 256, BK = 64, HALF = 128, HTB = HALF * BK * 2  , STAGE_BYTES = 8 * HTB, NXCD = 8, WGM = 8;

__host__ __device__ __forceinline__ int lds_byte(int r, int c) { const int st = (r >> 4) * 2 + (c >> 5), rr = r & 15, cc = c & 31, ob = rr * 64 + cc * 2; return st * 1024 + (ob ^ (((ob >> 9) & 1) << 5)); }
__host__ __device__ __forceinline__ void stage_rc(int b, int& R, int& C) { const int st = b / 1024, sb = b % 1024, swz = sb ^ (((sb >> 9) & 1) << 5); R = (st >> 1) * 16 + swz / 64; C = (st & 1) * 32 + (swz % 64) / 2; }
__host__ __device__ __forceinline__ int perm32(int rho) { const int n = rho >> 4, i = rho & 15; return 8 * (i >> 2) + 4 * n + (i & 3); }

struct Unit { int pm, pn; };
struct Gemm { const bf16_t* A; const bf16_t* Bt; int M, N, K, lda, ldb; };

struct StaticOrder {
    int nM, nN, nwg, G, c;
    __host__ __device__ void init(int M, int N, int G_, int c_) { nM = M / BM; nN = N / BM; nwg = nM * nN; G = G_; c = c_; }
    __host__ __device__ bool next(int i, Unit& u) const {
        const long L = (long)i * G + c; if (L >= nwg) return false;
        int wgid = (int)L; { const int q = nwg / NXCD, r = nwg % NXCD, xcd = wgid % NXCD, off = wgid / NXCD; wgid = (xcd < r ? xcd * (q + 1) : r * (q + 1) + (xcd - r) * q) + off; }
        const int nig = WGM * nN, gid = wgid / nig, fm = gid * WGM, gsz = (nM - fm) < WGM ? (nM - fm) : WGM;
        u.pm = fm + ((wgid % nig) % gsz); u.pn = (wgid % nig) / gsz; return true;
    }
    __device__ __forceinline__ void a_ready(const Unit&) const {}
    __device__ __forceinline__ void done(const Unit&) const {}
};

template <class Epi, class Sched, bool ALIGN_EPI = false, bool SP2 = false>
__device__ __forceinline__ void gemm_phase(PG8_LAS unsigned char* lds, const Gemm g, const Sched& S, const Epi& E) {
    int tid = threadIdx.x; asm volatile("" : "+v"(tid));
    const int wid = __builtin_amdgcn_readfirstlane(tid >> 6), lane = tid & 63, wr = wid >> 2, wc = wid & 3, fr = lane & 15, fq = lane >> 4;
    const int K = g.K, nt = K / BK, lda = g.lda, ldb = g.ldb;
    unsigned voffA[2], voffB[2];
#pragma unroll
    for (int i = 0; i < 2; ++i) { int R, C; stage_rc(tid * 16 + i * 8192, R, C); const int Rb = Epi::PERM ? ((R & ~31) + perm32(R & 31)) : R;
        voffA[i] = (unsigned)(R * lda + C) * 2u; voffB[i] = (unsigned)(Rb * ldb + C) * 2u; }
    const size_t kstep = (size_t)(BK * 2);
    const size_t hstepA = (size_t)HALF * lda * 2, hstepB = (size_t)HALF * ldb * 2;
    const size_t tstepA = 2 * hstepA, tstepB = 2 * hstepB;
    const unsigned ldsw = (unsigned)wid * 1024u;
    const int aoff = lds_byte(wr * 64 + fr, fq * 8), boff = lds_byte(wc * 32 + fr, fq * 8);
#define PG8_SA(b, h) (((b) * 2 + (h)) * HTB)
#define PG8_SB(b, h) ((4 + (b) * 2 + (h)) * HTB)
#define PG8_STAGE(bufoff, gbase, voff) do { _Pragma("unroll") for (int _i = 0; _i < 2; ++_i) \
        __builtin_amdgcn_global_load_lds((const unsigned*)((const char*)(gbase) + (voff)[_i]), (PG8_LAS unsigned*)(lds + (bufoff) + ldsw + _i * 8192), 16, 0, 0); } while (0)
#define PG8_LDA(dst, b, h) do { _Pragma("unroll") for (int m = 0; m < 4; ++m) _Pragma("unroll") for (int k = 0; k < 2; ++k) dst[m][k] = *(const PG8_LAS bf16x8*)(lds + PG8_SA(b, h) + aoff + m * 2048 + k * 1024); } while (0)
#define PG8_LDB(dst, b, h) do { _Pragma("unroll") for (int n = 0; n < 2; ++n) _Pragma("unroll") for (int k = 0; k < 2; ++k) dst[n][k] = *(const PG8_LAS bf16x8*)(lds + PG8_SB(b, h) + boff + n * 2048 + k * 1024); } while (0)
#define PG8_MMA(ai, bj, At, Bt) do { __builtin_amdgcn_s_setprio(1); _Pragma("unroll") for (int m = 0; m < 4; ++m) _Pragma("unroll") for (int n = 0; n < 2; ++n) _Pragma("unroll") for (int k = 0; k < 2; ++k) \
        acc[ai][bj][m][n] = mfma16(Bt[n][k], At[m][k], acc[ai][bj][m][n]); __builtin_amdgcn_s_setprio(0); } while (0)
#define PG8_WAIT_V(n) asm volatile("s_waitcnt vmcnt(" #n ")" ::: "memory")
#define PG8_WAIT_L(n) asm volatile("s_waitcnt lgkmcnt(" #n ")" ::: "memory")
#define PG8_BAR __builtin_amdgcn_s_barrier()
#define PG8_SCHED __builtin_amdgcn_sched_barrier(0)
    Unit cur, nxt; int ui = 0;
    if (!S.next(0, cur)) return;
    f32x4 acc[2][2][4][2];
#pragma unroll
    for (int a = 0; a < 2; ++a)
#pragma unroll
        for (int b = 0; b < 2; ++b)
#pragma unroll
            for (int m = 0; m < 4; ++m)
#pragma unroll
                for (int n = 0; n < 2; ++n) acc[a][b][m][n] = (f32x4){0.f, 0.f, 0.f, 0.f};
    bf16x8 At[4][2], B0[2][2], B1[2][2];
    const char* cA = (const char*)g.A + (size_t)cur.pm * tstepA; const char* cB = (const char*)g.Bt + (size_t)cur.pn * tstepB;
    S.a_ready(cur);
    if constexpr (SP2) {
        PG8_STAGE(PG8_SB(0, 0), cB, voffB); PG8_STAGE(PG8_SB(0, 1), cB + hstepB, voffB); PG8_STAGE(PG8_SA(0, 0), cA, voffA); PG8_STAGE(PG8_SA(0, 1), cA + hstepA, voffA);
        if (wr == 1) PG8_BAR;
        PG8_WAIT_V(2); PG8_BAR;
        PG8_STAGE(PG8_SB(1, 0), cB + kstep, voffB); PG8_STAGE(PG8_SA(1, 0), cA + kstep, voffA); PG8_STAGE(PG8_SB(1, 1), cB + hstepB + kstep, voffB);
        PG8_WAIT_V(6); PG8_BAR;
    } else {
        PG8_STAGE(PG8_SB(0, 0), cB, voffB); PG8_STAGE(PG8_SA(0, 0), cA, voffA); PG8_STAGE(PG8_SB(0, 1), cB + hstepB, voffB); PG8_STAGE(PG8_SA(0, 1), cA + hstepA, voffA);
        if (wr == 1) PG8_BAR;
        PG8_WAIT_V(4); PG8_BAR;
        PG8_STAGE(PG8_SB(1, 0), cB + kstep, voffB); PG8_STAGE(PG8_SA(1, 0), cA + kstep, voffA); PG8_STAGE(PG8_SB(1, 1), cB + hstepB + kstep, voffB);
        PG8_WAIT_V(6); PG8_BAR;
    }
    for (;;) {
        const bool has_next = S.next(ui + 1, nxt);
        const char* nA = has_next ? (const char*)g.A + (size_t)nxt.pm * tstepA : cA; const char* nB = has_next ? (const char*)g.Bt + (size_t)nxt.pn * tstepB : cB;
#pragma unroll 1
        for (int t = 0; t < nt; t += 2) {
            const bool last = (t == nt - 2);
            const char* a1 = cA + (size_t)(t + 1) * kstep;
            const char* a2 = last ? nA : cA + (size_t)(t + 2) * kstep; const char* b2 = last ? nB : cB + (size_t)(t + 2) * kstep;
            const char* a3 = a2 + kstep; const char* b3 = b2 + kstep;
            if (last && has_next) S.a_ready(nxt);
            if constexpr (SP2) {
            PG8_LDB(B0, 0, 0); PG8_LDB(B1, 0, 1); PG8_SCHED; PG8_LDA(At, 0, 0); PG8_STAGE(PG8_SA(1, 1), a1 + hstepA, voffA);
            PG8_WAIT_V(8); PG8_WAIT_L(0); PG8_BAR; PG8_MMA(0, 0, At, B0); PG8_MMA(0, 1, At, B1); PG8_BAR; PG8_SCHED;
            PG8_LDA(At, 0, 1); PG8_STAGE(PG8_SB(0, 0), b2, voffB); PG8_STAGE(PG8_SB(0, 1), b2 + hstepB, voffB); PG8_STAGE(PG8_SA(0, 0), a2, voffA);
            PG8_WAIT_V(8); PG8_WAIT_L(0); PG8_BAR; PG8_MMA(1, 0, At, B0); PG8_MMA(1, 1, At, B1); PG8_BAR; PG8_SCHED;
            PG8_LDB(B0, 1, 0); PG8_LDB(B1, 1, 1); PG8_SCHED; PG8_LDA(At, 1, 0); PG8_STAGE(PG8_SA(0, 1), a2 + hstepA, voffA);
            PG8_WAIT_V(8); PG8_WAIT_L(0); PG8_BAR; PG8_MMA(0, 0, At, B0); PG8_MMA(0, 1, At, B1); PG8_BAR; PG8_SCHED;
            PG8_LDA(At, 1, 1); PG8_STAGE(PG8_SB(1, 0), b3, voffB); PG8_STAGE(PG8_SB(1, 1), b3 + hstepB, voffB); PG8_STAGE(PG8_SA(1, 0), a3, voffA);
            PG8_WAIT_V(8); PG8_WAIT_L(0); PG8_BAR; PG8_MMA(1, 0, At, B0); PG8_MMA(1, 1, At, B1); PG8_BAR; PG8_SCHED;
            } else {
            PG8_LDB(B0, 0, 0); PG8_SCHED; PG8_LDA(At, 0, 0); PG8_STAGE(PG8_SA(1, 1), a1 + hstepA, voffA);
            PG8_WAIT_L(8); PG8_BAR; PG8_WAIT_L(0); PG8_MMA(0, 0, At, B0); PG8_BAR; PG8_SCHED;
            PG8_LDB(B1, 0, 1); PG8_STAGE(PG8_SB(0, 0), b2, voffB);
            PG8_BAR; PG8_WAIT_L(0); PG8_MMA(0, 1, At, B1); PG8_BAR;
            PG8_LDA(At, 0, 1); PG8_STAGE(PG8_SA(0, 0), a2, voffA);
            PG8_BAR; PG8_WAIT_L(0); PG8_MMA(1, 0, At, B0); PG8_BAR; PG8_SCHED;
            PG8_STAGE(PG8_SB(0, 1), b2 + hstepB, voffB);
            PG8_WAIT_V(6); PG8_BAR; PG8_MMA(1, 1, At, B1); PG8_BAR;
            PG8_LDB(B0, 1, 0); PG8_SCHED; PG8_LDA(At, 1, 0); PG8_STAGE(PG8_SA(0, 1), a2 + hstepA, voffA);
            PG8_WAIT_L(8); PG8_BAR; PG8_WAIT_L(0); PG8_MMA(0, 0, At, B0); PG8_BAR; PG8_SCHED;
            PG8_LDB(B1, 1, 1); PG8_STAGE(PG8_SB(1, 0), b3, voffB);
            PG8_BAR; PG8_WAIT_L(0); PG8_MMA(0, 1, At, B1); PG8_BAR;
            PG8_LDA(At, 1, 1); PG8_STAGE(PG8_SA(1, 0), a3, voffA);
            PG8_BAR; PG8_WAIT_L(0); PG8_MMA(1, 0, At, B0); PG8_BAR; PG8_SCHED;
            PG8_STAGE(PG8_SB(1, 1), b3 + hstepB, voffB);
            PG8_WAIT_V(6); PG8_BAR; PG8_MMA(1, 1, At, B1); PG8_BAR;
            }
        }
        if constexpr (ALIGN_EPI) { if (wr == 0) PG8_BAR; }
        if constexpr (!Epi::AFTER_DRAIN) { E(acc, cur, ui, wr, wc, fr, fq); S.done(cur); }
        if (!has_next) break;
#pragma unroll
        for (int a = 0; a < 2; ++a)
#pragma unroll
            for (int b = 0; b < 2; ++b)
#pragma unroll
                for (int m = 0; m < 4; ++m)
#pragma unroll
                    for (int n = 0; n < 2; ++n) acc[a][b][m][n] = (f32x4){0.f, 0.f, 0.f, 0.f};
        cur = nxt; cA = nA; cB = nB; ++ui;
        if constexpr (ALIGN_EPI) { if (wr == 1) PG8_BAR; }
    }
    PG8_WAIT_V(0);
    if constexpr (!ALIGN_EPI) { if (wr == 0) PG8_BAR; }
    PG8_BAR;
    if constexpr (Epi::AFTER_DRAIN) { E.fused(acc, cur, wr, wc, fr, fq, lds, wid, lane); S.done(cur); }
#undef PG8_SA
#undef PG8_SB
#undef PG8_STAGE
#undef PG8_LDA
#undef PG8_LDB
#undef PG8_MMA
#undef PG8_WAIT_V
#undef PG8_WAIT_L
#undef PG8_BAR
#undef PG8_SCHED
}
}

using pg8::Unit;
constexpr int L = 16384, D = 1024, FF = 4096, NWAVES = 8, NTHR = 512;
constexpr float EPS = 1e-6f;
constexpr float LOG2E = 1.4426950408889634f;
constexpr float QS_DSA = 0.08838834764831845f * LOG2E;
constexpr float QS_MLA = 0.10206207261596575f * LOG2E;
constexpr float WI_SCALE = 0.04419417382415922f;
constexpr float GDN_QS = 0.08838834764831845f;
#define NEG_INF (-__builtin_inff())

constexpr size_t MiB = 1u << 20;
constexpr size_t WS_CTL = 0, CTL_ZERO_BYTES = 1 * MiB;
constexpr size_t WS_ROPE = 1 * MiB;
constexpr size_t WS_STAT = 3 * MiB;
constexpr size_t WS_STAT2 = 5 * MiB;
constexpr size_t WS_RSTDX = 7 * MiB;
constexpr size_t WS_WIN = 8 * MiB;
constexpr size_t WS_WB = 10 * MiB, WS_WC = 12 * MiB, WS_WD = 14 * MiB;
constexpr size_t WS_WOUT = 16 * MiB;
constexpr size_t WS_W1 = 20 * MiB, WS_W2 = 28 * MiB;
constexpr size_t WS_A16 = 36 * MiB;
constexpr size_t WS_ACT = 68 * MiB;
constexpr size_t WS_HID = WS_ACT;
constexpr size_t WS_DQ = 68 * MiB, WS_DK = 100 * MiB, WS_DVT = 132 * MiB, WS_DQI = 164 * MiB, WS_DKI = 180 * MiB, WS_DWI = 182 * MiB, WS_DBITS = 188 * MiB;
constexpr size_t WS_CU = 68 * MiB, WS_CL = 100 * MiB;
constexpr size_t WS_MP = 68 * MiB, WS_MKR = 88 * MiB, WS_MQ = 90 * MiB, WS_MKN = 138 * MiB, WS_MVT = 170 * MiB, WS_MO = 202 * MiB;
constexpr size_t WS_GQ = 68 * MiB, WS_GK = 100 * MiB, WS_GV = 132 * MiB, WS_GW = 164 * MiB, WS_GQK = 196 * MiB, WS_GHALO = 212 * MiB, WS_GG = 217 * MiB, WS_GBETA = WS_GG + 512 * 1024, WS_GGL = 218 * MiB, WS_GGATE = 219 * MiB;
constexpr size_t WS_END = 256 * MiB;
constexpr int CW_TMO = 0, CW_BAR = 4096;

constexpr int RING_BYTES = 131072;
constexpr int TABA_OFF = 131072, TABB_OFF = 139264, MISC_OFF = 147456, LDS_BYTES = 148480;

typedef GAS unsigned gu32;
#define RLX_AGENT __ATOMIC_RELAXED, __HIP_MEMORY_SCOPE_AGENT
#define XB_TMO      128
#define XB_XCNT(j)  (256  + 64 * (j))
#define XB_XSUB(j)  (1280 + 64 * (j))
#define XB_XGEN(j)  (2304 + 64 * (j))
#define XB_TOP      3328
#define XB_TOPGEN   3392
#define XCD_BAR_WORDS 3456
#define XB_SPIN_CAP (1u << 18)

__device__ __forceinline__ unsigned xb_ld(unsigned* p)              { return __hip_atomic_load(p, __ATOMIC_RELAXED, __HIP_MEMORY_SCOPE_AGENT); }
__device__ __forceinline__ unsigned xb_add(unsigned* p, unsigned v) { return __hip_atomic_fetch_add(p, v, __ATOMIC_RELAXED, __HIP_MEMORY_SCOPE_AGENT); }
__device__ __forceinline__ unsigned xb_xcc_id() { return (unsigned)__builtin_amdgcn_s_getreg((3 << 11) | 20) & 0xFu; }
#define XB_SPIN(cond, bar) do { unsigned _sp = 0; while (cond) { __builtin_amdgcn_s_sleep(1); \
    if ((++_sp & 255u) == 0u) { if (xb_ld(&(bar)[XB_TMO])) break; if (_sp > XB_SPIN_CAP) { atomicAdd(&(bar)[XB_TMO], 1u); break; } } } } while (0)

struct XcdBarrier {
    unsigned* bar; unsigned x;
    volatile LAS unsigned* st;
};

__device__ __forceinline__ XcdBarrier xcd_barrier_post(unsigned* bar, volatile LAS unsigned* st) {
    XcdBarrier b; b.bar = bar; b.x = xb_xcc_id(); b.st = st;
    if (threadIdx.x == 0) (void)xb_add(&bar[XB_XCNT(b.x)], 1u);
    return b;
}
__device__ __forceinline__ void xcd_barrier_complete(unsigned* bar, unsigned x, unsigned& nloc, unsigned& nx) {
    const unsigned G = gridDim.x * gridDim.y * gridDim.z;
    unsigned sum, cnt, mine, sp = 0u;
    for (;;) {
        sum = 0u; cnt = 0u; mine = 0u;
#pragma unroll
        for (unsigned j = 0; j < 16; ++j) { const unsigned c = xb_ld(&bar[XB_XCNT(j)]); sum += c; cnt += (c > 0u) ? 1u : 0u; mine = (j == x) ? c : mine; }
        if (sum == G) break;
        __builtin_amdgcn_s_sleep(1);
        if ((++sp & 255u) == 0u) { if (xb_ld(&bar[XB_TMO])) break; if (sp > XB_SPIN_CAP) { atomicAdd(&bar[XB_TMO], 1u); break; } }
    }
    nloc = mine > 0u ? mine : 1u; nx = cnt > 0u ? cnt : 1u;
}

__device__ __forceinline__ void xcd_barrier(const XcdBarrier& b) {
    asm volatile("s_waitcnt vmcnt(0)" ::: "memory");
    __syncthreads();
    if (threadIdx.x == 0) {
        unsigned* bar = b.bar;
        __builtin_amdgcn_s_waitcnt(0);
        unsigned nloc = b.st[0], nx = b.st[1];
        if (nloc == 0u) { xcd_barrier_complete(bar, b.x, nloc, nx); b.st[0] = nloc; b.st[1] = nx; }
        const unsigned old = xb_add(&bar[XB_XSUB(b.x)], 1u);
        const unsigned gen = old / nloc;
        if (old + 1u == (gen + 1u) * nloc) {
            __builtin_amdgcn_fence(__ATOMIC_RELEASE, "agent");
            asm volatile("s_waitcnt vmcnt(0)" ::: "memory");
            const unsigned og = xb_add(&bar[XB_TOP], 1u);
            const unsigned tg = og / nx;
            if (og + 1u == (tg + 1u) * nx) xb_add(&bar[XB_TOPGEN], 1u);
            else XB_SPIN(xb_ld(&bar[XB_TOPGEN]) == tg, bar);
            __builtin_amdgcn_fence(__ATOMIC_ACQUIRE, "agent");
            xb_add(&bar[XB_XGEN(b.x)], 1u);
            asm volatile("s_waitcnt vmcnt(0)" ::: "memory");
        } else {
            XB_SPIN(xb_ld(&bar[XB_XGEN(b.x)]) == gen, bar);
            __builtin_amdgcn_fence(__ATOMIC_ACQUIRE, "agent");
            asm volatile("s_waitcnt vmcnt(0)" ::: "memory");
        }
    }
    __syncthreads();
}

#define EROW(ai, m) (u.pm * 256 + (ai) * 128 + wr * 64 + (m) * 16 + fr)
#define ECOL(bj) ((bj) * 128 + wc * 32 + fq * 8)
#define ETAB(tab, ai, m) ((tab)[ui * 256 + (ai) * 128 + wr * 64 + (m) * 16 + fr])
#define EPI_ARGS const f32x4 (&acc)[2][2][4][2], const Unit& u, int ui, int wr, int wc, int fr, int fq

struct EpiDsaIn {
    static constexpr int ID = 0; static constexpr bool SP2 = true; static constexpr bool PERM = true, AFTER_DRAIN = false;
    const float* rstdx; u16 *Q, *K, *Vt, *QI, *KI; float* WI; const float *kg, *kb;
    __device__ __forceinline__ void operator()(EPI_ARGS) const {
        const int pn = u.pn;
#pragma unroll
        for (int ai = 0; ai < 2; ++ai)
#pragma unroll
        for (int m = 0; m < 4; ++m) {
            const int row = EROW(ai, m); const float rs = rstdx[row];
            if (pn < 8) {
                u16* base = (pn < 4 ? Q : K) + (size_t)row * 1024 + (pn & 3) * 256; const float s = pn < 4 ? rs * QS_DSA : rs;
#pragma unroll
                for (int bj = 0; bj < 2; ++bj) *(u32x4*)(base + ECOL(bj)) = pack8(acc[ai][bj][m][0] * s, acc[ai][bj][m][1] * s);
            } else if (pn < 12) {
#pragma unroll
                for (int bj = 0; bj < 2; ++bj)
#pragma unroll
                for (int n = 0; n < 2; ++n)
#pragma unroll
                for (int e = 0; e < 4; ++e) Vt[(size_t)((pn - 8) * 256 + ECOL(bj) + n * 4 + e) * L + row] = f2h(acc[ai][bj][m][n][e] * rs);
            } else if (pn < 14) {
                u16* base = QI + (size_t)row * 512 + (pn - 12) * 256;
#pragma unroll
                for (int bj = 0; bj < 2; ++bj) *(u32x4*)(base + ECOL(bj)) = pack8(acc[ai][bj][m][0] * rs, acc[ai][bj][m][1] * rs);
            } else {
                if (wc == 0) {
                    f32x4 x[2][2]; float s = 0.f;
#pragma unroll
                    for (int bj = 0; bj < 2; ++bj)
#pragma unroll
                    for (int n = 0; n < 2; ++n) { x[bj][n] = acc[ai][bj][m][n] * rs; s += (x[bj][n][0] + x[bj][n][1]) + (x[bj][n][2] + x[bj][n][3]); }
                    s += __shfl_xor(s, 16); s += __shfl_xor(s, 32);
                    const float mean = s * (1.f / 64.f); float v = 0.f;
#pragma unroll
                    for (int bj = 0; bj < 2; ++bj)
#pragma unroll
                    for (int n = 0; n < 2; ++n) { x[bj][n] = x[bj][n] - mean; v += (x[bj][n][0] * x[bj][n][0] + x[bj][n][1] * x[bj][n][1]) + (x[bj][n][2] * x[bj][n][2] + x[bj][n][3] * x[bj][n][3]); }
                    v += __shfl_xor(v, 16); v += __shfl_xor(v, 32);
                    const float r2 = rsqrtf(v * (1.f / 64.f) + EPS);
#pragma unroll
                    for (int bj = 0; bj < 2; ++bj) { const int d0 = bj * 32 + fq * 8;
                        const f32x4 g0 = *(const f32x4*)(kg + d0), g1 = *(const f32x4*)(kg + d0 + 4), b0 = *(const f32x4*)(kb + d0), b1 = *(const f32x4*)(kb + d0 + 4);
                        *(u32x4*)(KI + (size_t)row * 64 + d0) = pack8(x[bj][0] * r2 * g0 + b0, x[bj][1] * r2 * g1 + b1); }
                } else if (wc == 1 && fq == 0) {
                    *(f32x4*)(WI + (size_t)row * 8) = acc[ai][0][m][0] * (rs * WI_SCALE); *(f32x4*)(WI + (size_t)row * 8 + 4) = acc[ai][0][m][1] * (rs * WI_SCALE);
                }
            }
        }
    }
};

struct EpiUp {
    static constexpr int ID = 1; static constexpr bool SP2 = true; static constexpr bool PERM = true, AFTER_DRAIN = false;
    u16* H; int ldc; const LAS float* tab;
    __device__ __forceinline__ void operator()(EPI_ARGS) const {
#pragma unroll
        for (int ai = 0; ai < 2; ++ai)
#pragma unroll
        for (int m = 0; m < 4; ++m) { const int row = EROW(ai, m); const float rs = ETAB(tab, ai, m); u16* base = H + (size_t)row * ldc + u.pn * 256;
#pragma unroll
            for (int bj = 0; bj < 2; ++bj) { f32x4 a = acc[ai][bj][m][0] * rs, b = acc[ai][bj][m][1] * rs;
#pragma unroll
                for (int e = 0; e < 4; ++e) { a[e] = fmaxf(a[e], 0.f); a[e] *= a[e]; b[e] = fmaxf(b[e], 0.f); b[e] *= b[e]; }
                *(u32x4*)(base + ECOL(bj)) = pack8(a, b); } }
    }
};

struct EpiScale16 {
    static constexpr int ID = 2; static constexpr bool SP2 = true; static constexpr bool PERM = true, AFTER_DRAIN = false;
    u16* O; int ldc; size_t split; const LAS float* tab;
    __device__ __forceinline__ void operator()(EPI_ARGS) const {
        u16* ob = split ? O + (size_t)(u.pn >> 2) * split + (u.pn & 3) * 256 : O + u.pn * 256;
#pragma unroll
        for (int ai = 0; ai < 2; ++ai)
#pragma unroll
        for (int m = 0; m < 4; ++m) { const int row = EROW(ai, m); const float rs = ETAB(tab, ai, m); u16* base = ob + (size_t)row * ldc;
#pragma unroll
            for (int bj = 0; bj < 2; ++bj) *(u32x4*)(base + ECOL(bj)) = pack8(acc[ai][bj][m][0] * rs, acc[ai][bj][m][1] * rs); }
    }
};

struct EpiGlu {
    static constexpr int ID = 3; static constexpr bool SP2 = true; static constexpr bool PERM = true, AFTER_DRAIN = false;
    u16* U; const float* bias; const LAS float* tab;
    __device__ __forceinline__ void operator()(EPI_ARGS) const {
        const int col = u.pn * 128 + wc * 32 + fq * 8;
        f32x4 ba[2], bg[2];
#pragma unroll
        for (int n = 0; n < 2; ++n) { ba[n] = *(const f32x4*)(bias + col + 4 * n); bg[n] = *(const f32x4*)(bias + 1024 + col + 4 * n); }
#pragma unroll
        for (int ai = 0; ai < 2; ++ai)
#pragma unroll
        for (int m = 0; m < 4; ++m) { const int row = EROW(ai, m); const float rs = ETAB(tab, ai, m); f32x4 o[2];
#pragma unroll
            for (int n = 0; n < 2; ++n) { const f32x4 a = acc[ai][0][m][n] * rs + ba[n], g = acc[ai][1][m][n] * rs + bg[n];
#pragma unroll
                for (int e = 0; e < 4; ++e) o[n][e] = a[e] * sigmoidf_(g[e]); }
            *(u32x4*)(U + (size_t)row * 1024 + col) = pack8(o[0], o[1]); }
    }
};

struct EpiResid {
    static constexpr int ID = 4; static constexpr bool SP2 = true; static constexpr bool PERM = true, AFTER_DRAIN = false;
    const float* hin; float* hout; u16* a16; float* part; const float* bias;
    __device__ __forceinline__ void operator()(EPI_ARGS) const {
#pragma unroll
        for (int ai = 0; ai < 2; ++ai)
#pragma unroll
        for (int m = 0; m < 4; ++m) { const int row = EROW(ai, m); float ssq[2];
#pragma unroll
            for (int bj = 0; bj < 2; ++bj) { const int col = u.pn * 256 + ECOL(bj); const size_t o = (size_t)row * 1024 + col;
                f32x4 v0 = acc[ai][bj][m][0] + *(const f32x4*)(hin + o), v1 = acc[ai][bj][m][1] + *(const f32x4*)(hin + o + 4);
                if (bias) { v0 = v0 + *(const f32x4*)(bias + col); v1 = v1 + *(const f32x4*)(bias + col + 4); }
                *(f32x4*)(hout + o) = v0; *(f32x4*)(hout + o + 4) = v1;
                ssq[bj] = (v0[0] * v0[0] + v0[1] * v0[1]) + (v0[2] * v0[2] + v0[3] * v0[3]) + (v1[0] * v1[0] + v1[1] * v1[1]) + (v1[2] * v1[2] + v1[3] * v1[3]);
                if (a16) *(u32x4*)(a16 + o) = pack8(v0, v1); }
            if (part) {
#pragma unroll
                for (int bj = 0; bj < 2; ++bj) { float s = ssq[bj]; s += __shfl_xor(s, 16); s += __shfl_xor(s, 32); if (fq == 0) part[(size_t)row * 32 + u.pn * 8 + bj * 4 + wc] = s; } }
        }
    }
};

struct EpiMlaIn {
    static constexpr int ID = 5; static constexpr bool SP2 = true; static constexpr bool PERM = true, AFTER_DRAIN = false;
    u16* P16; u16* KR; float* part2; const f32x2* rope; const LAS float* tab;
    __device__ __forceinline__ void operator()(EPI_ARGS) const {
#pragma unroll
        for (int ai = 0; ai < 2; ++ai)
#pragma unroll
        for (int m = 0; m < 4; ++m) { const int row = EROW(ai, m); const float rs = ETAB(tab, ai, m);
#pragma unroll
            for (int bj = 0; bj < 2; ++bj) { const int hb = u.pn * 2 + bj; const f32x4 v0 = acc[ai][bj][m][0] * rs, v1 = acc[ai][bj][m][1] * rs;
                if (hb < 5) {
                    *(u32x4*)(P16 + (size_t)row * 640 + hb * 128 + wc * 32 + fq * 8) = pack8(v0, v1);
                    float s = (v0[0] * v0[0] + v0[1] * v0[1]) + (v0[2] * v0[2] + v0[3] * v0[3]) + (v1[0] * v1[0] + v1[1] * v1[1]) + (v1[2] * v1[2] + v1[3] * v1[3]);
                    s += __shfl_xor(s, 16); s += __shfl_xor(s, 32);
                    if (fq == 0) part2[(size_t)row * 32 + hb * 4 + wc] = s;
                } else if (hb == 5 && wc == 0) {
                    const f32x2* rp = rope + (size_t)row * 16 + 4 * fq;
                    const f32x2 c0 = rp[0], c1 = rp[1], c2 = rp[2], c3 = rp[3];
                    f32x4 o0, o1;
                    o0[0] = v0[0] * c0.x - v0[1] * c0.y; o0[1] = v0[1] * c0.x + v0[0] * c0.y; o0[2] = v0[2] * c1.x - v0[3] * c1.y; o0[3] = v0[3] * c1.x + v0[2] * c1.y;
                    o1[0] = v1[0] * c2.x - v1[1] * c2.y; o1[1] = v1[1] * c2.x + v1[0] * c2.y; o1[2] = v1[2] * c3.x - v1[3] * c3.y; o1[3] = v1[3] * c3.x + v1[2] * c3.y;
                    *(u32x4*)(KR + (size_t)row * 32 + fq * 8) = pack8(o0, o1);
                } }
        }
    }
};

struct EpiMlaUq {
    static constexpr int ID = 6; static constexpr bool SP2 = true; static constexpr bool PERM = true, AFTER_DRAIN = false;
    u16* QM; const f32x2* rope; const LAS float* tab;
    __device__ __forceinline__ void operator()(EPI_ARGS) const {
#pragma unroll
        for (int ai = 0; ai < 2; ++ai)
#pragma unroll
        for (int m = 0; m < 4; ++m) { const unsigned row = EROW(ai, m); const float rs = ETAB(tab, ai, m) * QS_MLA;
#pragma unroll
            for (int bj = 0; bj < 2; ++bj) { const unsigned cg = u.pn * 256 + ECOL(bj); const int d0 = (int)(cg % 96u); f32x4 v0 = acc[ai][bj][m][0] * rs, v1 = acc[ai][bj][m][1] * rs;
                if (d0 >= 64) { const f32x2* rp = rope + (row * 16u + (unsigned)((d0 - 64) >> 1));
                    { const f32x2 c0 = rp[0], c1 = rp[1]; const f32x4 t = v0; v0[0] = t[0] * c0.x - t[1] * c0.y; v0[1] = t[1] * c0.x + t[0] * c0.y; v0[2] = t[2] * c1.x - t[3] * c1.y; v0[3] = t[3] * c1.x + t[2] * c1.y; }
                    { const f32x2 c2 = rp[2], c3 = rp[3]; const f32x4 t = v1; v1[0] = t[0] * c2.x - t[1] * c2.y; v1[1] = t[1] * c2.x + t[0] * c2.y; v1[2] = t[2] * c3.x - t[3] * c3.y; v1[3] = t[3] * c3.x + t[2] * c3.y; } }
                *(u32x4*)((char*)QM + (size_t)((row * 1536u + cg) * 2u)) = pack8(v0, v1); }
            asm volatile("" ::: "memory");
        }
    }
};

struct EpiMlaUkv {
    static constexpr int ID = 7; static constexpr bool SP2 = true; static constexpr bool PERM = true, AFTER_DRAIN = false;
    u16* KN; u16* Vt; const LAS float* tab;
    __device__ __forceinline__ void operator()(EPI_ARGS) const {
#pragma unroll
        for (int ai = 0; ai < 2; ++ai)
#pragma unroll
        for (int m = 0; m < 4; ++m) { const unsigned row = EROW(ai, m); const float rs = ETAB(tab, ai, m);
#pragma unroll
            for (int bj = 0; bj < 2; ++bj) { const unsigned head = u.pn * 2 + bj;
                if (wc < 2) *(u32x4*)((char*)KN + (size_t)((row * 1024u + head * 64u + wc * 32 + fq * 8) * 2u)) = pack8(acc[ai][bj][m][0] * rs, acc[ai][bj][m][1] * rs);
                else { unsigned off = ((head * 64u + (wc - 2) * 32 + fq * 8) * (unsigned)L + row) * 2u;
#pragma unroll
                    for (int n = 0; n < 2; ++n)
#pragma unroll
                    for (int e = 0; e < 4; ++e) { *(u16*)((char*)Vt + (size_t)off) = f2h(acc[ai][bj][m][n][e] * rs); off += (unsigned)L * 2u; } } }
            asm volatile("" ::: "memory");
        }
    }
};

template <class Sched> __device__ __forceinline__ void build_tab(LAS float* tab, const Sched& S, const float* part, int g0, int g1, float inv_n) {
    Unit u;
    for (int i = 0; i < 8 && S.next(i, u); ++i)
        for (int r = opaque_tid(); r < 256; r += NTHR) { const float* p = part + (size_t)(u.pm * 256 + r) * 32; float s = 0.f; for (int g = g0; g < g1; ++g) s += p[g]; tab[i * 256 + r] = rsqrtf(s * inv_n + EPS); }
    __syncthreads();
}

__device__ const float INV_FREQ[16] = {1.0f, 0.5623413324356079f, 0.3162277638912201f, 0.17782793939113617f, 0.10000000149011612f, 0.05623413249850273f, 0.03162277489900589f, 0.017782794311642647f,
    0.009999999776482582f, 0.005623413249850273f, 0.003162277629598975f, 0.0017782794311642647f, 0.0010000000474974513f, 0.000562341301701963f, 0.0003162277571391314f, 0.00017782794020604342f};

template <class Map> __device__ __forceinline__ void tr_item(const float* W, int K, int N, const float* gain, u16* WT, const Map& map, LAS float* scr, int item, int lane) {
    const int nblk = (N + 31) / 32, kb = item / nblk, nb = item % nblk, k0 = 64 * kb, n0 = 32 * nb;
#pragma unroll 8
    for (int i = 0; i < 32; ++i) { const int kk = 2 * i + (lane >> 5), n = n0 + (lane & 31); float v = (n < N) ? W[(size_t)(k0 + kk) * N + n] : 0.f; if (gain) v *= gain[k0 + kk]; scr[kk * 33 + (lane & 31)] = v; }
    asm volatile("s_waitcnt lgkmcnt(0)" ::: "memory");
    const int c = lane & 7;
#pragma unroll
    for (int j = 0; j < 4; ++j) { const int nl = (lane >> 3) + 8 * j, n = n0 + nl; const int dr = (n < N) ? map(n) : -1; const LAS float* s = scr + (8 * c) * 33 + nl;
        if (dr >= 0) { u32x4 o; o.x = pk16(s[0 * 33], s[1 * 33]); o.y = pk16(s[2 * 33], s[3 * 33]); o.z = pk16(s[4 * 33], s[5 * 33]); o.w = pk16(s[6 * 33], s[7 * 33]);
            *(u32x4*)(WT + (size_t)dr * K + k0 + 8 * c) = o; } }
    asm volatile("s_waitcnt lgkmcnt(0)" ::: "memory");
}
template <class Map> __device__ __forceinline__ void conv_mat(int& base, int gw, int NGW, const float* W, int K, int N, const float* gain, u16* WT, const Map& map, LAS float* scr, int lane) {
    const int nitems = (K / 64) * ((N + 31) / 32);
    int first = (gw - base) % NGW; if (first < 0) first += NGW;
    for (int it = first; it < nitems; it += NGW) tr_item(W, K, N, gain, WT, map, scr, it, lane);
    base += nitems;
}
__device__ __forceinline__ void zero_rows(u16* WT, int K, int r0, int r1, int gw, int NGW, int lane) {
    const int per_row = K / 8;
    const long total = (long)(r1 - r0) * per_row;
    for (long c = (long)gw * 64 + lane; c < total; c += (long)NGW * 64) *(u32x4*)(WT + (size_t)r0 * K + c * 8) = (u32x4){0u, 0u, 0u, 0u};
}
struct MapId { int off; __device__ __forceinline__ int operator()(int n) const { return n + off; } };
struct MapDsaIn { __device__ __forceinline__ int operator()(int n) const { if (n < 3584) return n; if (n < 3648) { const int d = n - 3584; return d < 32 ? 3584 + d : 3584 + 128 + (d - 32); } return 3584 + 32 + (n - 3648); } };
struct MapPw1 { __device__ __forceinline__ int operator()(int n) const { return n < 1024 ? 256 * (n >> 7) + (n & 127) : 256 * ((n - 1024) >> 7) + 128 + (n & 127); } };
struct MapMlaIn { __device__ __forceinline__ int operator()(int n) const { if (n < 640) return n; const int d = n - 640; return 640 + 2 * (d & 15) + (d >> 4); } };
struct MapMlaUq { __device__ __forceinline__ int operator()(int n) const { const int h = n / 96, d = n % 96; if (d < 64) return n; const int r = d - 64; return h * 96 + 64 + 2 * (r & 15) + (r >> 4); } };
struct MapGdnQkv { __device__ __forceinline__ int operator()(int n) const { return n < 3072 ? n : -1; } };
struct MapGdnGate { __device__ __forceinline__ int operator()(int n) const { return (n >= 3072 && n < 4096) ? n - 3072 : -1; } };

struct Args { const float* in[30]; float* out; uchar* ws; };
typedef const __attribute__((address_space(4))) Args* KArgs;
struct Ptrs {
    KArgs ka; float* out; uchar* ws;
    __device__ __forceinline__ const float* in(int k) const { KArgs p = ka; asm volatile("" : "+s"(p)); return p->in[k]; }
};

template <int LAYER> __device__ __forceinline__ void convert_layer(const Ptrs& P, LAS uchar* lds, int vcu, int G) {
    const int tid_ = opaque_tid(), lane = tid_ & 63, wave = __builtin_amdgcn_readfirstlane(tid_ >> 6);
    LAS float* scr = (LAS float*)(lds + wave * 16384);
    const int gw = vcu * NWAVES + wave, NGW = G * NWAVES; int base = 0;
    uchar* ws = P.ws;
    const float* gmix = P.in(1) + LAYER * 1024; const float* gmlp = P.in(2) + LAYER * 1024;
    conv_mat(base, gw, NGW, P.in(4) + (size_t)LAYER * 1024 * 4096, 1024, 4096, gmlp, (u16*)(ws + WS_W1), MapId{0}, scr, lane);
    conv_mat(base, gw, NGW, P.in(5) + (size_t)LAYER * 4096 * 1024, 4096, 1024, nullptr, (u16*)(ws + WS_W2), MapId{0}, scr, lane);
    if (LAYER == 0) {
        conv_mat(base, gw, NGW, P.in(6), 1024, 3656, gmix, (u16*)(ws + WS_WIN), MapDsaIn{}, scr, lane);
        if (SKIPMIX & 1) zero_rows((u16*)(ws + WS_WOUT), 1024, 0, 1024, gw, NGW, lane); else conv_mat(base, gw, NGW, P.in(9), 1024, 1024, nullptr, (u16*)(ws + WS_WOUT), MapId{0}, scr, lane);
        zero_rows((u16*)(ws + WS_WIN), 1024, 3624, 3712, gw, NGW, lane); zero_rows((u16*)(ws + WS_WIN), 1024, 3744, 3840, gw, NGW, lane);
    } else if (LAYER == 1) {
        conv_mat(base, gw, NGW, P.in(10), 1024, 2048, gmix, (u16*)(ws + WS_WIN), MapPw1{}, scr, lane);
        conv_mat(base, gw, NGW, P.in(16), 1024, 1024, nullptr, (u16*)(ws + WS_WOUT), MapId{0}, scr, lane);
    } else if (LAYER == 2) {
        conv_mat(base, gw, NGW, P.in(18), 1024, 672, gmix, (u16*)(ws + WS_WIN), MapMlaIn{}, scr, lane);
        conv_mat(base, gw, NGW, P.in(20), 384, 1536, P.in(19), (u16*)(ws + WS_WB), MapMlaUq{}, scr, lane);
        conv_mat(base, gw, NGW, P.in(22), 256, 2048, P.in(21), (u16*)(ws + WS_WC), MapId{0}, scr, lane);
        conv_mat(base, gw, NGW, P.in(23), 1024, 1024, nullptr, (u16*)(ws + WS_WOUT), MapId{0}, scr, lane);
        zero_rows((u16*)(ws + WS_WIN), 1024, 672, 768, gw, NGW, lane);
    } else {
        conv_mat(base, gw, NGW, P.in(24), 1024, 4112, gmix, (u16*)(ws + WS_WIN), MapGdnQkv{}, scr, lane);
        conv_mat(base, gw, NGW, P.in(24), 1024, 4112, gmix, (u16*)(ws + WS_WD), MapGdnGate{}, scr, lane);
        conv_mat(base, gw, NGW, P.in(29), 1024, 1024, nullptr, (u16*)(ws + WS_WOUT), MapId{0}, scr, lane);
    }
}

__device__ __forceinline__ void prologue_x(const Ptrs& P, int vcu, int G) {
    const int tid_ = opaque_tid(), lane = tid_ & 63, wave = __builtin_amdgcn_readfirstlane(tid_ >> 6);
    const int gw = vcu * NWAVES + wave, NGW = G * NWAVES;
    const float* x = P.in(0); u16* a16 = (u16*)(P.ws + WS_A16); float* rstdx = (float*)(P.ws + WS_RSTDX);
    for (int m = gw; m < L; m += NGW) {
        const f32x4* xr = (const f32x4*)(x + (size_t)m * D) + lane; f32x4 v[4]; float s = 0.f;
#pragma unroll
        for (int j = 0; j < 4; ++j) { v[j] = xr[64 * j]; s += (v[j][0] * v[j][0] + v[j][1] * v[j][1]) + (v[j][2] * v[j][2] + v[j][3] * v[j][3]); }
        s = wave_sum(s);
        if (lane == 0) rstdx[m] = rsqrtf(s * (1.f / D) + EPS);
        u32x2* o = (u32x2*)(a16 + (size_t)m * D) + lane;
#pragma unroll
        for (int j = 0; j < 4; ++j) { u32x2 w; w.x = pk16(v[j][0], v[j][1]); w.y = pk16(v[j][2], v[j][3]); o[64 * j] = w; }
    }
    f32x2* rope = (f32x2*)(P.ws + WS_ROPE);
    for (int i = gw * 64 + lane; i < L * 16; i += NGW * 64) {
        const int t = i >> 4, k = i & 15; const float ang = (float)t * INV_FREQ[k];
        const double rev = (double)ang * 0.15915494309189535; const float fr = (float)(rev - floor(rev));
        f32x2 cs; cs.x = __builtin_amdgcn_cosf(fr); cs.y = __builtin_amdgcn_sinf(fr); rope[i] = cs;
    }
}

template <int DQK, int DV, bool BITS>
__device__ __forceinline__ void attn_unit(LAS uchar* lds, const u16* __restrict__ Qh, int ldq, const u16* __restrict__ Kh, int ldk, const u16* __restrict__ Kr, int ldkr,
                                          const u16* __restrict__ Vth, const unsigned* __restrict__ bits, u16* Oh, int ldo, int qb) {
    constexpr int KPB = (DQK + 8) * 2, VPB = 136, KBYTES = 64 * KPB, VBYTES = DV * VPB, BUF = KBYTES + VBYTES;
    constexpr int NS = DQK / 16, NDB = DV / 32, KCH = DQK / 8, NKC = 64 * KCH, NVC = DV * 8, KIT = (NKC + 511) / 512, VIT = (NVC + 511) / 512;
    const int tid = opaque_tid(), lane = tid & 63, wid = __builtin_amdgcn_readfirstlane(tid >> 6), r32 = lane & 31, hi = lane >> 5;
    LAS float* wsc = (LAS float*)(lds + 2 * BUF) + wid * 32;
    const int q0 = qb * 256, q0w = q0 + wid * 32, tq = q0w + r32, NT = (q0 + 256) / 64;
    s16x8 qf[NS];
#pragma unroll
    for (int s = 0; s < NS; ++s) qf[s] = *(const s16x8*)(Qh + (size_t)tq * ldq + 16 * s + 8 * hi);
    f32x16 o[NDB];
#pragma unroll
    for (int db = 0; db < NDB; ++db)
#pragma unroll
        for (int r = 0; r < 16; ++r) o[db][r] = 0.f;
    float mrun = -1e30f, lrun = 0.f;
    u32x4 kst[KIT], vst[VIT];
#define ATT_LOAD(t) do { _Pragma("unroll") for (int i_ = 0; i_ < KIT; ++i_) { const int c_ = tid + 512 * i_; if (c_ < NKC) { const int row_ = c_ / KCH, cc_ = c_ % KCH; \
            const u16* src_ = (DQK == 96 && cc_ >= 8) ? Kr + (size_t)((t) * 64 + row_) * ldkr + (cc_ - 8) * 8 : Kh + (size_t)((t) * 64 + row_) * ldk + cc_ * 8; kst[i_] = *(const u32x4*)src_; } } \
        _Pragma("unroll") for (int i_ = 0; i_ < VIT; ++i_) { const int c_ = tid + 512 * i_; if (c_ < NVC) { const int d_ = c_ >> 3, cc_ = c_ & 7; vst[i_] = *(const u32x4*)(Vth + (size_t)d_ * L + (t) * 64 + cc_ * 8); } } } while (0)
#define ATT_STORE(b) do { _Pragma("unroll") for (int i_ = 0; i_ < KIT; ++i_) { const int c_ = tid + 512 * i_; if (c_ < NKC) { const int row_ = c_ / KCH, cc_ = c_ % KCH; *(LAS u32x4*)(lds + (b) * BUF + row_ * KPB + cc_ * 16) = kst[i_]; } } \
        _Pragma("unroll") for (int i_ = 0; i_ < VIT; ++i_) { const int c_ = tid + 512 * i_; if (c_ < NVC) { const int d_ = c_ >> 3, cc_ = c_ & 7; LAS uchar* p_ = lds + (b) * BUF + KBYTES + d_ * VPB + cc_ * 16; \
            *(LAS u32x2*)p_ = (u32x2){vst[i_].x, vst[i_].y}; *(LAS u32x2*)(p_ + 8) = (u32x2){vst[i_].z, vst[i_].w}; } } } while (0)
    ATT_LOAD(0); ATT_STORE(0); __syncthreads();
    for (int t = 0; t < NT; ++t) {
        const int cur = t & 1; const bool more = t + 1 < NT;
        if (more) ATT_LOAD(t + 1);
        const int kv0 = t * 64;
        if (kv0 <= q0w + 31) {
            const LAS uchar* Kl = lds + cur * BUF; const LAS uchar* Vl = Kl + KBYTES;
            f32x16 S0, S1;
#pragma unroll
            for (int r = 0; r < 16; ++r) { S0[r] = 0.f; S1[r] = 0.f; }
#pragma unroll
            for (int s = 0; s < NS; ++s) {
                const s16x8 a0 = *(const LAS s16x8*)(Kl + r32 * KPB + 32 * s + 16 * hi), a1 = *(const LAS s16x8*)(Kl + (32 + r32) * KPB + 32 * s + 16 * hi);
                S0 = mfma32(a0, qf[s], S0); S1 = mfma32(a1, qf[s], S1);
            }
            if (BITS) {
                const unsigned w0 = bits[(size_t)(2 * t) * L + tq], w1 = bits[(size_t)(2 * t + 1) * L + tq];
#pragma unroll
                for (int r = 0; r < 16; ++r) { const int kr = (r & 3) + 8 * (r >> 2) + 4 * hi; if (!((w0 >> kr) & 1u)) S0[r] = NEG_INF; if (!((w1 >> kr) & 1u)) S1[r] = NEG_INF; }
            }
            if (kv0 + 63 > q0w) {
#pragma unroll
                for (int r = 0; r < 16; ++r) { const int key = kv0 + (r & 3) + 8 * (r >> 2) + 4 * hi; if (key > tq) S0[r] = NEG_INF; if (key + 32 > tq) S1[r] = NEG_INF; }
            }
            float rm = fmaxf(S0[0], S1[0]);
#pragma unroll
            for (int r = 1; r < 16; ++r) rm = fmaxf(rm, fmaxf(S0[r], S1[r]));
            rm = fmaxf(rm, __shfl_xor(rm, 32));
            if (__any(rm > mrun + 8.f)) {
                const float mn = fmaxf(mrun, rm), al = __builtin_amdgcn_exp2f(mrun - mn); lrun *= al; mrun = mn;
                if (hi == 0) wsc[r32] = al;
                asm volatile("s_waitcnt lgkmcnt(0)" ::: "memory");
#pragma unroll
                for (int g = 0; g < 4; ++g) { const f32x4 a4 = *(const LAS f32x4*)(wsc + 8 * g + 4 * hi);
#pragma unroll
                    for (int db = 0; db < NDB; ++db) { o[db][4 * g] *= a4[0]; o[db][4 * g + 1] *= a4[1]; o[db][4 * g + 2] *= a4[2]; o[db][4 * g + 3] *= a4[3]; } }
                asm volatile("s_waitcnt lgkmcnt(0)" ::: "memory");
            }
            float ls = 0.f;
#pragma unroll
            for (int r = 0; r < 16; ++r) { S0[r] = __builtin_amdgcn_exp2f(S0[r] - mrun); S1[r] = __builtin_amdgcn_exp2f(S1[r] - mrun); ls += S0[r] + S1[r]; }
            lrun += ls;
            s16x8 pf[4];
            { u32x4 w;
              w.x = pk16(S0[0], S0[1]); w.y = pk16(S0[2], S0[3]); w.z = pk16(S0[4], S0[5]); w.w = pk16(S0[6], S0[7]); pf[0] = __builtin_bit_cast(s16x8, w);
              w.x = pk16(S0[8], S0[9]); w.y = pk16(S0[10], S0[11]); w.z = pk16(S0[12], S0[13]); w.w = pk16(S0[14], S0[15]); pf[1] = __builtin_bit_cast(s16x8, w);
              w.x = pk16(S1[0], S1[1]); w.y = pk16(S1[2], S1[3]); w.z = pk16(S1[4], S1[5]); w.w = pk16(S1[6], S1[7]); pf[2] = __builtin_bit_cast(s16x8, w);
              w.x = pk16(S1[8], S1[9]); w.y = pk16(S1[10], S1[11]); w.z = pk16(S1[12], S1[13]); w.w = pk16(S1[14], S1[15]); pf[3] = __builtin_bit_cast(s16x8, w); }
#pragma unroll
            for (int db = 0; db < NDB; ++db)
#pragma unroll
                for (int sp = 0; sp < 4; ++sp) { const LAS uchar* vp = Vl + (32 * db + r32) * VPB + (16 * sp + 4 * hi) * 2;
                    const u32x2 lo = *(const LAS u32x2*)vp, hh = *(const LAS u32x2*)(vp + 16); const u32x4 vw = {lo.x, lo.y, hh.x, hh.y};
                    o[db] = mfma32(pf[sp], __builtin_bit_cast(s16x8, vw), o[db]); }
        }
        if (more) ATT_STORE(cur ^ 1);
        __syncthreads();
    }
#undef ATT_LOAD
#undef ATT_STORE
    lrun += __shfl_xor(lrun, 32);
    if (hi == 0) wsc[r32] = 1.f / lrun;
    asm volatile("s_waitcnt lgkmcnt(0)" ::: "memory");
#pragma unroll
    for (int g = 0; g < 4; ++g) { const f32x4 a4 = *(const LAS f32x4*)(wsc + 8 * g + 4 * hi);
#pragma unroll
        for (int e = 0; e < 4; ++e) { const int r = 4 * g + e; const int qrow = q0w + 8 * g + 4 * hi + e;
#pragma unroll
            for (int db = 0; db < NDB; ++db) Oh[(size_t)qrow * ldo + 32 * db + r32] = f2h(o[db][r] * a4[e]); } }
    asm volatile("s_waitcnt lgkmcnt(0)" ::: "memory");
    __syncthreads();
}

__device__ __forceinline__ unsigned okey(float f) { const unsigned u = __float_as_uint(f); return (u & 0x80000000u) ? ~u : (u | 0x80000000u); }
#define LDS_FENCE() asm volatile("s_waitcnt lgkmcnt(0)" ::: "memory")

template <int NE, int TOP> __device__ __forceinline__ unsigned radix_kth(const unsigned (&ek)[NE], unsigned vmask, int m, LAS unsigned* hist, int lane, int& m_rem) {
    unsigned prefix = 0; int mm = m;
#pragma unroll
    for (int sh = TOP; sh >= 0; sh -= 8) {
        hist[lane] = 0u; hist[lane + 64] = 0u; hist[lane + 128] = 0u; hist[lane + 192] = 0u;
        LDS_FENCE();
#pragma unroll
        for (int e = 0; e < NE; ++e) { const bool ok = ((vmask >> e) & 1u) && (sh == TOP || (ek[e] >> ((sh + 8) & 31)) == (prefix >> ((sh + 8) & 31)));
            if (ok) __hip_atomic_fetch_add(&hist[(ek[e] >> sh) & 255u], 1u, __ATOMIC_RELAXED, __HIP_MEMORY_SCOPE_WORKGROUP); }
        LDS_FENCE();
        const unsigned c0 = hist[255 - 4 * lane], c1 = hist[254 - 4 * lane], c2 = hist[253 - 4 * lane], c3 = hist[252 - 4 * lane];
        LDS_FENCE();
        const int T = (int)(c0 + c1 + c2 + c3); int I = T;
#pragma unroll
        for (int o = 1; o < 64; o <<= 1) { const int t = __shfl_up(I, o); if (lane >= o) I += t; }
        const int E = I - T; const bool mine = (E < mm) && (mm <= I);
        int dsel = 0, mnew = 0;
        if (mine) { int r = E;
            if (mm <= r + (int)c0) { dsel = 255 - 4 * lane; mnew = mm - r; }
            else { r += (int)c0; if (mm <= r + (int)c1) { dsel = 254 - 4 * lane; mnew = mm - r; }
                else { r += (int)c1; if (mm <= r + (int)c2) { dsel = 253 - 4 * lane; mnew = mm - r; } else { r += (int)c2; dsel = 252 - 4 * lane; mnew = mm - r; } } } }
        const unsigned long long b = __ballot(mine); const int src = b ? (__ffsll((long long)b) - 1) : 0;
        dsel = __shfl(dsel, src); mnew = __shfl(mnew, src);
        prefix |= (unsigned)dsel << sh; mm = mnew;
    }
    m_rem = mm; return prefix;
}

__device__ __forceinline__ void dsa_indexer(const Ptrs& P, LAS uchar* lds, int vcu, int G) {
    const int tid = opaque_tid(), lane = tid & 63, wid = __builtin_amdgcn_readfirstlane(tid >> 6), r32 = lane & 31, hi = lane >> 5;
    const u16* QI = (const u16*)(P.ws + WS_DQI); const u16* KI = (const u16*)(P.ws + WS_DKI); const float* WI = (const float*)(P.ws + WS_DWI);
    unsigned* bitsg = (unsigned*)(P.ws + WS_DBITS);
    float* listf = (float*)(P.ws + WS_A16 + (size_t)vcu * 131072); u16* lists = (u16*)listf;
    float* candS = (float*)P.out + (size_t)vcu * 32768; u16* candI = (u16*)((uchar*)P.out + 32 * MiB) + (size_t)vcu * 32768;
    LAS unsigned* lbits = (LAS unsigned*)lds;
    LAS unsigned* hist = (LAS unsigned*)(lds + 65536) + wid * 256;
    LAS unsigned* cnt = (LAS unsigned*)(lds + 65536 + 8192);
    LAS unsigned* tau = cnt + 32;
    LAS uchar* qlds = lds + 65536 + 8192 + 256;
    LAS float* wlds = (LAS float*)(qlds + 32 * 1040);
    constexpr int CAP = 1024, MSAMP = 64;
    for (int blk0 = vcu; blk0 < 256; blk0 += G) for (int side = 0; side < 2; ++side) {
        const int blk = side ? 511 - blk0 : blk0;
        const int t0 = 32 * blk, NT = blk + 1, tq = t0 + r32;
        for (int c = tid; c < 2048; c += NTHR) { const int row = c >> 6, cc = c & 63; *(LAS u32x4*)(qlds + row * 1040 + cc * 16) = *(const u32x4*)(QI + (size_t)(t0 + row) * 512 + cc * 8); }
        if (tid < 64) *(LAS f32x4*)(wlds + tid * 4) = *(const f32x4*)(WI + (size_t)t0 * 8 + tid * 4);
        const LAS uchar* qrow = qlds + r32 * 1040 + 16 * hi; const LAS float* wrow = wlds + r32 * 8;
#define IDX_SCORES(keyrow) s16x8 af[4]; _Pragma("unroll") for (int s = 0; s < 4; ++s) af[s] = *(const s16x8*)(KI + (size_t)(keyrow) * 64 + 16 * s + 8 * hi); \
        float sc[16]; _Pragma("unroll") for (int r = 0; r < 16; ++r) sc[r] = 0.f; \
        _Pragma("unroll 1") for (int hp = 0; hp < 4; ++hp) { f32x16 a_, b_; _Pragma("unroll") for (int r = 0; r < 16; ++r) { a_[r] = 0.f; b_[r] = 0.f; } \
            const LAS uchar* qp_ = qrow + hp * 256; const f32x2 w2_ = *(const LAS f32x2*)(wrow + 2 * hp); \
            _Pragma("unroll") for (int s = 0; s < 4; ++s) { a_ = mfma32(af[s], *(const LAS s16x8*)(qp_ + s * 32), a_); b_ = mfma32(af[s], *(const LAS s16x8*)(qp_ + 128 + s * 32), b_); } \
            _Pragma("unroll") for (int r = 0; r < 16; ++r) sc[r] += w2_.x * fmaxf(a_[r], 0.f) + w2_.y * fmaxf(b_[r], 0.f); }
        for (int i = tid; i < NT * 32; i += NTHR) lbits[i] = 0u;
        if (tid < 32) cnt[tid] = 0u;
        __syncthreads();
        const bool exact = (t0 + 32 <= 1024);
        if (exact) {
            {
#pragma unroll 1
            for (int jt = wid; jt < NT; jt += 8) { IDX_SCORES(32 * jt + r32)
#pragma unroll
                for (int r = 0; r < 16; ++r) { const int key = 32 * jt + (r & 3) + 8 * (r >> 2) + 4 * hi; if (key <= tq) listf[(size_t)r32 * 1024 + key] = sc[r]; } } }
            __syncthreads();
            for (int q = wid; q < 32; q += 8) { const int t = t0 + q, n = t + 1;
                unsigned ek[16]; unsigned vmask = 0u;
#pragma unroll
                for (int e = 0; e < 16; ++e) { const int p = e * 64 + lane; const bool v = p < n; ek[e] = v ? okey(listf[(size_t)q * 1024 + p]) : 0u; vmask |= (v ? 1u : 0u) << e; }
                unsigned thr = 0u; int mrem = 0x7fffffff;
                if (n > 256) thr = radix_kth<16, 24>(ek, vmask, 256, hist, lane, mrem);
                int eqbase = 0;
#pragma unroll
                for (int e = 0; e < 16; ++e) { const bool v = (vmask >> e) & 1u; const bool gt = v && ek[e] > thr, eq = v && ek[e] == thr;
                    const unsigned long long be = __ballot(eq); const int ord = eqbase + __popcll(be & ((1ull << lane) - 1ull)); eqbase += __popcll(be);
                    if (gt || (eq && ord < mrem)) { const int p = e * 64 + lane; __hip_atomic_fetch_or(&lbits[(p >> 5) * 32 + q], 1u << (p & 31), __ATOMIC_RELAXED, __HIP_MEMORY_SCOPE_WORKGROUP); } }
            }
        } else {
            const int NTS = (t0 + 32 + 255) / 256;
            {
#pragma unroll 1
            for (int js = wid; js < NTS; js += 8) { IDX_SCORES(8 * (32 * js + r32))
#pragma unroll
                for (int r = 0; r < 16; ++r) { const int so = 32 * js + (r & 3) + 8 * (r >> 2) + 4 * hi; if (8 * so <= tq) lists[(size_t)r32 * 2048 + so] = (u16)(okey(sc[r]) >> 16); } } }
            __syncthreads();
            for (int q = wid; q < 32; q += 8) { const int t = t0 + q, ns = (t >> 3) + 1;
                unsigned ek[32]; unsigned vmask = 0u;
#pragma unroll
                for (int e = 0; e < 32; ++e) { const int p = e * 64 + lane; const bool v = p < ns; ek[e] = v ? (unsigned)lists[(size_t)q * 2048 + p] : 0u; vmask |= (v ? 1u : 0u) << e; }
                int mrem; const unsigned thr = radix_kth<32, 8>(ek, vmask, MSAMP, hist, lane, mrem);
                if (lane == 0) tau[q] = thr;
            }
            __syncthreads();
            const unsigned tq16 = tau[r32];
            {
#pragma unroll 1
            for (int jt = wid; jt < NT; jt += 8) { IDX_SCORES(32 * jt + r32)
                unsigned pm = 0u;
#pragma unroll
                for (int r = 0; r < 16; ++r) { const int key = 32 * jt + (r & 3) + 8 * (r >> 2) + 4 * hi; if (key <= tq && (okey(sc[r]) >> 16) >= tq16) pm |= 1u << r; }
                if (pm) { unsigned pos = __hip_atomic_fetch_add(&cnt[r32], (unsigned)__popc(pm), __ATOMIC_RELAXED, __HIP_MEMORY_SCOPE_WORKGROUP);
#pragma unroll
                    for (int r = 0; r < 16; ++r) if ((pm >> r) & 1u) { if (pos < (unsigned)CAP) { candS[(size_t)r32 * CAP + pos] = sc[r]; candI[(size_t)r32 * CAP + pos] = (u16)(32 * jt + (r & 3) + 8 * (r >> 2) + 4 * hi); } ++pos; } }
            } }
            __syncthreads();
            for (int q = wid; q < 32; q += 8) { const int n = min((int)cnt[q], CAP);
                unsigned ek[16]; unsigned ei[16]; unsigned vmask = 0u;
#pragma unroll
                for (int e = 0; e < 16; ++e) { const int p = e * 64 + lane; const bool v = p < n; ek[e] = v ? okey(candS[(size_t)q * CAP + p]) : 0u; ei[e] = v ? (unsigned)candI[(size_t)q * CAP + p] : 0u; vmask |= (v ? 1u : 0u) << e; }
                unsigned thr = 0u; int mrem = 0x7fffffff;
                if (n > 256) thr = radix_kth<16, 24>(ek, vmask, 256, hist, lane, mrem);
                int eqbase = 0;
#pragma unroll
                for (int e = 0; e < 16; ++e) { const bool v = (vmask >> e) & 1u; const bool gt = v && ek[e] > thr, eq = v && ek[e] == thr;
                    const unsigned long long be = __ballot(eq); const int ord = eqbase + __popcll(be & ((1ull << lane) - 1ull)); eqbase += __popcll(be);
                    if (gt || (eq && ord < mrem)) { const unsigned p = ei[e]; __hip_atomic_fetch_or(&lbits[(p >> 5) * 32 + q], 1u << (p & 31), __ATOMIC_RELAXED, __HIP_MEMORY_SCOPE_WORKGROUP); } }
            }
        }
        __syncthreads();
        for (int i = tid; i < NT * 32; i += NTHR) bitsg[(size_t)(i >> 5) * L + t0 + (i & 31)] = lbits[i];
        __syncthreads();
#undef IDX_SCORES
    }
}

__device__ __forceinline__ void conv_dw_phase(const Ptrs& P, LAS uchar* lds, int vcu, int G) {
    const int tid = opaque_tid(), lane = tid & 63, wid = __builtin_amdgcn_readfirstlane(tid >> 6);
    const u16* U = (const u16*)(P.ws + WS_CU); u16* CL = (u16*)(P.ws + WS_CL);
    const float* wdw = P.in(12); const float* bdw = P.in(13); const float* lng = P.in(14); const float* lnb = P.in(15);
    LAS float* co = (LAS float*)lds;
    for (int it = vcu; it < L / 32; it += G) {
        const int t0 = it * 32;
#pragma unroll 1
        for (int cc = 0; cc < 2; ++cc) { const int ch = tid + 512 * cc;
            float w[31];
#pragma unroll
            for (int j = 0; j < 31; ++j) w[j] = wdw[j * 1024 + ch];
            const float bb = bdw[ch];
            float win[62];
#pragma unroll
            for (int i = 0; i < 62; ++i) { const int t = t0 - 30 + i; win[i] = (t >= 0) ? h2f(U[(size_t)t * 1024 + ch]) : 0.f; }
#pragma unroll
            for (int tt = 0; tt < 32; ++tt) { float a = bb;
#pragma unroll
                for (int j = 0; j < 31; ++j) a += w[j] * win[tt + j];
                co[tt * 1024 + ch] = a; }
        }
        __syncthreads();
#pragma unroll 1
        for (int k = 0; k < 4; ++k) { const int tt = wid * 4 + k; float v[16]; float s = 0.f;
#pragma unroll
            for (int i = 0; i < 16; ++i) { v[i] = co[tt * 1024 + lane + 64 * i]; s += v[i]; }
            const float mean = wave_sum(s) * (1.f / 1024.f); float q = 0.f;
#pragma unroll
            for (int i = 0; i < 16; ++i) { v[i] -= mean; q += v[i] * v[i]; }
            const float rstd = rsqrtf(wave_sum(q) * (1.f / 1024.f) + EPS);
#pragma unroll
            for (int i = 0; i < 16; ++i) { const int ch = lane + 64 * i; const float y = v[i] * rstd * lng[ch] + lnb[ch]; CL[(size_t)(t0 + tt) * 1024 + ch] = f2h(siluf_(y)); }
        }
        __syncthreads();
    }
}

__device__ __forceinline__ void gdn_pre(const Ptrs& P, int vcu, int G) {
    const int tid_ = opaque_tid(), lane = tid_ & 63, wave = __builtin_amdgcn_readfirstlane(tid_ >> 6);
    const int gw = vcu * NWAVES + wave, NGW = G * NWAVES;
    const u16* RQ = (const u16*)(P.ws + WS_GQ); u16* HALO = (u16*)(P.ws + WS_GHALO);
    for (long c = (long)gw * 64 + lane; c < 256L * 9 * 128; c += (long)NGW * 64) {
        const int it = (int)(c >> 7), ch = (int)(c & 127); const int n = it / 9, r = it % 9, j = r / 3, which = r % 3;
        if (n == 0) continue;
        const u16* src = RQ + (size_t)which * (16 * MiB) + (size_t)(64 * n - 3 + j) * 1024 + ch * 8;
        *(u32x4*)(HALO + ((size_t)(n * 3 + j) * 3 + which) * 1024 + ch * 8) = *(const u32x4*)src;
    }
    const float* h = P.out; const float* W = P.in(24); const float* gmix = P.in(1) + 3 * 1024;
    float* Gd = (float*)(P.ws + WS_GG); float* Bt = (float*)(P.ws + WS_GBETA);
    const float* alog = P.in(26); const float* dtb = P.in(27);
    for (int half = 0; half < 2; ++half) {
        float wr[16][8];
#pragma unroll
        for (int i = 0; i < 16; ++i) { const int k = lane + 64 * i; const float g = gmix[k]; const f32x4 a = *(const f32x4*)(W + (size_t)k * 4112 + 4096 + 8 * half), b = *(const f32x4*)(W + (size_t)k * 4112 + 4100 + 8 * half);
            wr[i][0] = a[0] * g; wr[i][1] = a[1] * g; wr[i][2] = a[2] * g; wr[i][3] = a[3] * g; wr[i][4] = b[0] * g; wr[i][5] = b[1] * g; wr[i][6] = b[2] * g; wr[i][7] = b[3] * g; }
        for (int m = gw; m < L; m += NGW) {
            float acc[8], ss = 0.f;
#pragma unroll
            for (int j = 0; j < 8; ++j) acc[j] = 0.f;
#pragma unroll
            for (int i = 0; i < 16; ++i) { const float x = h[(size_t)m * 1024 + lane + 64 * i]; ss += x * x;
#pragma unroll
                for (int j = 0; j < 8; ++j) acc[j] += x * wr[i][j]; }
            ss = wave_sum(ss); const float rs = rsqrtf(ss * (1.f / 1024.f) + EPS);
#pragma unroll
            for (int j = 0; j < 8; ++j) acc[j] = wave_sum(acc[j]) * rs;
            if (lane < 8) { float v = acc[0];
#pragma unroll
                for (int j = 1; j < 8; ++j) v = (lane == j) ? acc[j] : v;
                if (half == 0) Bt[(size_t)m * 8 + lane] = sigmoidf_(v);
                else { const float xx = v + dtb[lane]; const float sp = xx > 20.f ? xx : log1pf(__expf(xx)); Gd[(size_t)m * 8 + lane] = -__expf(alog[lane]) * sp; } }
        }
    }
}

__device__ __forceinline__ void gdn_chunk(const Ptrs& P, LAS uchar* lds, int vcu, int G) {
    const int tid = opaque_tid(), lane = tid & 63, wid = __builtin_amdgcn_readfirstlane(tid >> 6);
    u16* RQ = (u16*)(P.ws + WS_GQ); u16* RK = (u16*)(P.ws + WS_GK); u16* RV = (u16*)(P.ws + WS_GV); u16* WB = (u16*)(P.ws + WS_GW); u16* QK = (u16*)(P.ws + WS_GQK);
    const u16* HALO = (const u16*)(P.ws + WS_GHALO); const float* Gd = (const float*)(P.ws + WS_GG); const float* Bt = (const float*)(P.ws + WS_GBETA); float* GL = (float*)(P.ws + WS_GGL);
    const float* cw = P.in(25);
    constexpr int PT = 132;
    LAS float* Am = (LAS float*)lds; LAS float* gcs = Am + 4096; LAS float* egc = gcs + 64; LAS float* bet = egc + 64;
    LAS float* qs = bet + 64; LAS float* ks = qs + 64 * PT; LAS float* vs = ks + 64 * PT;
    for (int it = vcu; it < 2048; it += G) {
        const int n = it >> 3, hd = it & 7;
        if (tid < 384) { const int which = tid >> 7, ch = tid & 127, col = hd * 128 + ch;
            const u16* src = (which == 0 ? RQ : which == 1 ? RK : RV) + col; LAS float* dst = (which == 0 ? qs : which == 1 ? ks : vs) + ch;
            const float c0 = cw[0 * 3072 + which * 1024 + col], c1 = cw[1 * 3072 + which * 1024 + col], c2 = cw[2 * 3072 + which * 1024 + col], c3 = cw[3 * 3072 + which * 1024 + col];
            float x0 = 0.f, x1 = 0.f, x2 = 0.f;
            if (n > 0) { const u16* hp = HALO + ((size_t)(n * 3) * 3 + which) * 1024 + col; x0 = h2f(hp[0]); x1 = h2f(hp[3 * 1024]); x2 = h2f(hp[6 * 1024]); }
#pragma unroll 8
            for (int c = 0; c < 64; ++c) { const float x3 = h2f(src[(size_t)(64 * n + c) * 1024]); const float y = c0 * x0 + c1 * x1 + c2 * x2 + c3 * x3; dst[c * PT] = siluf_(y); x0 = x1; x1 = x2; x2 = x3; }
        } else if (tid < 448) { const int c = tid - 384; float g = Gd[(size_t)(64 * n + c) * 8 + hd];
#pragma unroll
            for (int o = 1; o < 64; o <<= 1) { const float t = __shfl_up(g, o); if (lane >= o) g += t; }
            gcs[c] = g; egc[c] = __expf(g); bet[c] = Bt[(size_t)(64 * n + c) * 8 + hd];
        }
        __syncthreads();
        for (int r = wid * 16; r < wid * 16 + 16; ++r) { LAS float* row = (r < 64 ? qs + r * PT : ks + (r - 64) * PT); const float a = row[lane], b = row[lane + 64];
            const float s = wave_sum(a * a + b * b); const float rn = rsqrtf(s + EPS) * (r < 64 ? GDN_QS : 1.f); row[lane] = a * rn; row[lane + 64] = b * rn; }
        __syncthreads();
        { const int i = tid >> 3, jg = tid & 7; float kk[8], qk[8];
#pragma unroll
            for (int jj = 0; jj < 8; ++jj) { kk[jj] = 0.f; qk[jj] = 0.f; }
            if (jg * 8 <= i) {
                for (int d = 0; d < 128; d += 4) { const f32x4 ki = *(const LAS f32x4*)(ks + i * PT + d), qi = *(const LAS f32x4*)(qs + i * PT + d);
#pragma unroll
                    for (int jj = 0; jj < 8; ++jj) { const f32x4 kj = *(const LAS f32x4*)(ks + (jg * 8 + jj) * PT + d);
                        kk[jj] += (ki[0] * kj[0] + ki[1] * kj[1]) + (ki[2] * kj[2] + ki[3] * kj[3]); qk[jj] += (qi[0] * kj[0] + qi[1] * kj[1]) + (qi[2] * kj[2] + qi[3] * kj[3]); } }
            }
            f32x4 o0, o1;
#pragma unroll
            for (int jj = 0; jj < 8; ++jj) { const int j = jg * 8 + jj; const float dec = (j <= i) ? __expf(gcs[i] - gcs[j]) : 0.f;
                Am[i * 64 + j] = (j < i) ? bet[i] * kk[jj] * dec : 0.f; const float qv = (j <= i) ? qk[jj] * dec : 0.f; if (jj < 4) o0[jj] = qv; else o1[jj - 4] = qv; }
            *(u32x4*)(QK + (size_t)it * 4096 + i * 64 + jg * 8) = pack8(o0, o1);
        }
        __syncthreads();
        if (tid < 256) {
            const int col = tid; float x[64];
            if (col < 128) {
#pragma unroll
                for (int i = 0; i < 64; ++i) x[i] = bet[i] * vs[i * PT + col];
            } else {
#pragma unroll
                for (int i = 0; i < 64; ++i) x[i] = bet[i] * egc[i] * ks[i * PT + col - 128];
            }
#pragma unroll
            for (int i = 1; i < 64; ++i) { float a = x[i];
#pragma unroll
                for (int jq = 0; jq < (i + 3) / 4; ++jq) { const f32x4 a4 = *(const LAS f32x4*)(Am + i * 64 + 4 * jq);
                    a -= a4[0] * x[4 * jq]; if (4 * jq + 1 < i) a -= a4[1] * x[4 * jq + 1]; if (4 * jq + 2 < i) a -= a4[2] * x[4 * jq + 2]; if (4 * jq + 3 < i) a -= a4[3] * x[4 * jq + 3]; }
                x[i] = a; }
            if (col < 128) { u16* dst = RV + (size_t)(64 * n + (col >> 1)) * 1024 + hd * 128 + (col & 1) * 64;
#pragma unroll
                for (int c8 = 0; c8 < 8; ++c8) { u32x4 w; w.x = pk16(x[8 * c8], x[8 * c8 + 1]); w.y = pk16(x[8 * c8 + 2], x[8 * c8 + 3]); w.z = pk16(x[8 * c8 + 4], x[8 * c8 + 5]); w.w = pk16(x[8 * c8 + 6], x[8 * c8 + 7]); *(u32x4*)(dst + 8 * c8) = w; }
            } else { u16* dst = WB + (size_t)(64 * n) * 1024 + hd * 128 + (col - 128);
#pragma unroll
                for (int c = 0; c < 64; ++c) dst[(size_t)c * 1024] = f2h(x[c]); }
        } else { const int t2 = tid - 256; const float gl = gcs[63];
            for (int idx = t2; idx < 1024; idx += 256) { const int c = idx >> 4, ch8 = (idx & 15) * 8; const float e = egc[c];
                const f32x4 a = *(const LAS f32x4*)(qs + c * PT + ch8) * e, b = *(const LAS f32x4*)(qs + c * PT + ch8 + 4) * e;
                *(u32x4*)(RQ + (size_t)(64 * n + c) * 1024 + hd * 128 + ch8) = pack8(a, b); }
            for (int idx = t2; idx < 1024; idx += 256) { const int dk = idx >> 3, c8 = (idx & 7) * 8; f32x4 a, b;
#pragma unroll
                for (int jj = 0; jj < 4; ++jj) { a[jj] = ks[(c8 + jj) * PT + dk] * __expf(gl - gcs[c8 + jj]); b[jj] = ks[(c8 + 4 + jj) * PT + dk] * __expf(gl - gcs[c8 + 4 + jj]); }
                *(u32x4*)(RK + (size_t)(64 * n + (dk >> 1)) * 1024 + hd * 128 + (dk & 1) * 64 + c8) = pack8(a, b); }
            if (t2 == 0) GL[it] = __expf(gl);
        }
        __syncthreads();
    }
}

__device__ __forceinline__ s16x8 ld2x8(const u16* p) { const u32x2 a = *(const u32x2*)p, b = *(const u32x2*)(p + 16); const u32x4 w = {a.x, a.y, b.x, b.y}; return __builtin_bit_cast(s16x8, w); }
__device__ __forceinline__ s16x8 pk2blk(f32x4 a, f32x4 b) { return __builtin_bit_cast(s16x8, pack8(a, b)); }

__device__ __forceinline__ void gdn_scan(const Ptrs& P, int chain, int lane) {
    const u16* RQ = (const u16*)(P.ws + WS_GQ); const u16* RK = (const u16*)(P.ws + WS_GK); u16* RV = (u16*)(P.ws + WS_GV); const u16* WB = (const u16*)(P.ws + WS_GW); const u16* QK = (const u16*)(P.ws + WS_GQK);
    const float* GL = (const float*)(P.ws + WS_GGL);
    const int hd = chain >> 3, dv = (chain & 7) * 16 + (lane & 15), lo = lane & 15, g = lane >> 4;
    f32x4 Sb[8];
#pragma unroll
    for (int b = 0; b < 8; ++b) Sb[b] = (f32x4){0.f, 0.f, 0.f, 0.f};
    for (int n = 0; n < 256; ++n) {
        const int it = n * 8 + hd; const size_t rbase = (size_t)(64 * n) * 1024 + hd * 128;
        s16x8 Bs[4];
#pragma unroll
        for (int ks = 0; ks < 4; ++ks) Bs[ks] = pk2blk(Sb[2 * ks], Sb[2 * ks + 1]);
        u16* up = RV + rbase + (size_t)(dv >> 1) * 1024 + (dv & 1) * 64 + 4 * g;
        f32x4 vn[4];
#pragma unroll
        for (int mb = 0; mb < 4; ++mb) { f32x4 a = {0.f, 0.f, 0.f, 0.f};
#pragma unroll
            for (int ks = 0; ks < 4; ++ks) a = mfma16(ld2x8(WB + rbase + (size_t)(16 * mb + lo) * 1024 + 32 * ks + 4 * g), Bs[ks], a);
            const u32x2 uw = *(const u32x2*)(up + 16 * mb); const unsigned ux_ = uw.x, uy_ = uw.y;
            const h16x2 u01 = __builtin_bit_cast(h16x2, ux_), u23 = __builtin_bit_cast(h16x2, uy_);
            vn[mb][0] = (float)u01[0] - a[0]; vn[mb][1] = (float)u01[1] - a[1]; vn[mb][2] = (float)u23[0] - a[2]; vn[mb][3] = (float)u23[1] - a[3]; }
        s16x8 Bv[2];
#pragma unroll
        for (int k2 = 0; k2 < 2; ++k2) Bv[k2] = pk2blk(vn[2 * k2], vn[2 * k2 + 1]);
        f32x4 ob[4];
#pragma unroll
        for (int mb = 0; mb < 4; ++mb) { f32x4 a = {0.f, 0.f, 0.f, 0.f};
#pragma unroll
            for (int ks = 0; ks < 4; ++ks) a = mfma16(ld2x8(RQ + rbase + (size_t)(16 * mb + lo) * 1024 + 32 * ks + 4 * g), Bs[ks], a);
#pragma unroll
            for (int k2 = 0; k2 < 2; ++k2) a = mfma16(ld2x8(QK + (size_t)it * 4096 + (16 * mb + lo) * 64 + 32 * k2 + 4 * g), Bv[k2], a);
            ob[mb] = a; }
        const float gl = GL[it];
#pragma unroll
        for (int b = 0; b < 8; ++b) { f32x4 a = Sb[b] * gl; const int dk = 16 * b + lo;
#pragma unroll
            for (int k2 = 0; k2 < 2; ++k2) a = mfma16(ld2x8(RK + rbase + (size_t)(dk >> 1) * 1024 + (dk & 1) * 64 + 32 * k2 + 4 * g), Bv[k2], a);
            Sb[b] = a; }
#pragma unroll
        for (int mb = 0; mb < 4; ++mb) { u32x2 w; w.x = pk16(ob[mb][0], ob[mb][1]); w.y = pk16(ob[mb][2], ob[mb][3]); *(u32x2*)(up + 16 * mb) = w; }
    }
}

__device__ __forceinline__ void gdn_out(const Ptrs& P, LAS uchar* lds, int vcu, int G) {
    const int tid = opaque_tid(), lane = tid & 63, wid = __builtin_amdgcn_readfirstlane(tid >> 6);
    const u16* RV = (const u16*)(P.ws + WS_GV); u16* GATE = (u16*)(P.ws + WS_GGATE); const float* og = P.in(28);
    LAS u16* ot = (LAS u16*)lds;
    for (int it = vcu; it < 2048; it += G) { const int n = it >> 3, hd = it & 7;
        for (int idx = tid; idx < 1024; idx += NTHR) { const int row = idx >> 4, cc = idx & 15; const u32x4 w = *(const u32x4*)(RV + (size_t)(64 * n + row) * 1024 + hd * 128 + cc * 8);
            const int e0 = row * 128 + cc * 8, dvv = e0 >> 6, c0 = e0 & 63; const unsigned ww[4] = {w.x, w.y, w.z, w.w};
#pragma unroll
            for (int k = 0; k < 4; ++k) { ot[(c0 + 2 * k) * 130 + dvv] = (u16)(ww[k] & 0xffffu); ot[(c0 + 2 * k + 1) * 130 + dvv] = (u16)(ww[k] >> 16); } }
        __syncthreads();
        for (int c = wid * 8; c < wid * 8 + 8; ++c) { const float o0 = h2f(ot[c * 130 + lane]), o1 = h2f(ot[c * 130 + lane + 64]);
            const float rs = rsqrtf(wave_sum(o0 * o0 + o1 * o1) * (1.f / 128.f) + EPS);
            u16* gp = GATE + (size_t)(64 * n + c) * 1024 + hd * 128; const float g0 = h2f(gp[lane]), g1 = h2f(gp[lane + 64]);
            gp[lane] = f2h(o0 * rs * og[lane] * siluf_(g0)); gp[lane + 64] = f2h(o1 * rs * og[lane + 64] * siluf_(g1)); }
        __syncthreads();
    }
}

__device__ __forceinline__ void final_norm(const Ptrs& P, int vcu, int G) {
    const int tid_ = opaque_tid(), lane = tid_ & 63, wave = __builtin_amdgcn_readfirstlane(tid_ >> 6);
    const int gw = vcu * NWAVES + wave, NGW = G * NWAVES; const float* fg = P.in(3);
    for (int m = gw; m < L; m += NGW) { f32x4* xr = (f32x4*)(P.out + (size_t)m * D) + lane; f32x4 v[4]; float s = 0.f;
#pragma unroll
        for (int j = 0; j < 4; ++j) { v[j] = xr[64 * j]; s += (v[j][0] * v[j][0] + v[j][1] * v[j][1]) + (v[j][2] * v[j][2] + v[j][3] * v[j][3]); }
        const float rs = rsqrtf(wave_sum(s) * (1.f / D) + EPS);
#pragma unroll
        for (int j = 0; j < 4; ++j) xr[64 * j] = v[j] * rs * *((const f32x4*)fg + lane + 64 * j); }
}

#ifndef CHECK
#define CHECK 0
#endif
constexpr size_t WS_CHK = 251 * MiB;
constexpr int CW_CHK = 2048;
__device__ __forceinline__ void chk_accum(const Ptrs& P, float num, float den) {
    num = wave_sum(num); den = wave_sum(den);
    if ((opaque_tid() & 63) == 0) { float* c = (float*)(P.ws + WS_CTL) + CW_CHK; atomicAdd(c, num); atomicAdd(c + 1, den); }
}
__device__ __forceinline__ void chk_emit(const Ptrs& P, int vcu, int G) {
    const float* c = (const float*)(P.ws + WS_CTL) + CW_CHK; const float num = __hip_atomic_load(c, __ATOMIC_RELAXED, __HIP_MEMORY_SCOPE_AGENT), den = __hip_atomic_load(c + 1, __ATOMIC_RELAXED, __HIP_MEMORY_SCOPE_AGENT);
    const float v = 1000.f * sqrtf(num / fmaxf(den, 1e-30f));
    for (size_t i = (size_t)vcu * NTHR + opaque_tid(); i < (size_t)L * D; i += (size_t)G * NTHR) P.out[i] = v;
}
#if CHECK == 3
constexpr int CHK_T = 2048;
__device__ __forceinline__ void chk_gdn_ref(const Ptrs& P, LAS uchar* lds, int vcu) {
    if (vcu >= 8) return;
    const int tid = opaque_tid(), hd = vcu;
    const u16* RQ = (const u16*)(P.ws + WS_GQ); const float* Gd = (const float*)(P.ws + WS_GG); const float* Bt = (const float*)(P.ws + WS_GBETA);
    const float* cw = P.in(25); u16* ref = (u16*)(P.ws + WS_CHK);
    LAS float* buf = (LAS float*)lds;
    LAS float* sst = buf + 512;
    for (int i = tid; i < 128 * 128; i += NTHR) sst[i] = 0.f;
    __syncthreads();
    const int which = tid >> 7, ch = tid & 127, col = hd * 128 + ch;
    float c0 = 0, c1 = 0, c2 = 0, c3 = 0, x0 = 0, x1 = 0, x2 = 0;
    if (tid < 384) { c0 = cw[0 * 3072 + which * 1024 + col]; c1 = cw[1 * 3072 + which * 1024 + col]; c2 = cw[2 * 3072 + which * 1024 + col]; c3 = cw[3 * 3072 + which * 1024 + col]; }
    const u16* src = RQ + (size_t)which * (16 * MiB) + col;
    for (int t = 0; t < CHK_T; ++t) {
        if (tid < 384) { const float x3 = h2f(src[(size_t)t * 1024]); buf[which * 128 + ch] = siluf_(c0 * x0 + c1 * x1 + c2 * x2 + c3 * x3); x0 = x1; x1 = x2; x2 = x3; }
        __syncthreads();
        if (tid < 128) { const int w = tid >> 6, l = tid & 63; const float a = buf[w * 128 + l], b = buf[w * 128 + l + 64]; const float ss = wave_sum(a * a + b * b); if (l == 0) buf[384 + w] = rsqrtf(ss + EPS); }
        __syncthreads();
        if (tid < 128) { const float rq = buf[384] * GDN_QS, rk = buf[385]; const float eg = __expf(Gd[(size_t)t * 8 + hd]), be = Bt[(size_t)t * 8 + hd];
            float r = 0.f;
            for (int d = 0; d < 128; ++d) { const float sv = sst[d * 128 + tid] * eg; sst[d * 128 + tid] = sv; r += sv * (buf[128 + d] * rk); }
            r = buf[256 + tid] - r; float o = 0.f;
            for (int d = 0; d < 128; ++d) { const float sv = sst[d * 128 + tid] + be * (buf[128 + d] * rk) * r; sst[d * 128 + tid] = sv; o += sv * (buf[d] * rq); }
            ref[((size_t)t * 8 + hd) * 128 + tid] = f2h(o); ((u16*)(P.ws + WS_STAT2))[((size_t)t * 8 + hd) * 128 + tid] = f2h(be * r); }
        __syncthreads();
    }
}
__device__ __forceinline__ void chk_gdn_cmp(const Ptrs& P, int vcu, int G, bool umode) {
    const u16* RV = (const u16*)(P.ws + WS_GV); const u16* ref = (const u16*)(P.ws + (umode ? WS_STAT2 : WS_CHK));
    float num = 0.f, den = 0.f;
    for (int i = vcu * NTHR + opaque_tid(); i < CHK_T * 1024; i += G * NTHR) { const int t = i >> 10, hd = (i >> 7) & 7, dv = i & 127, n = t >> 6, c = t & 63;
        const float mine = h2f(RV[(size_t)(64 * n + (dv >> 1)) * 1024 + hd * 128 + (dv & 1) * 64 + c]), r = h2f(ref[i]); num += (mine - r) * (mine - r); den += r * r; }
    chk_accum(P, num, den);
}
#endif

#if CHECK == 3
__device__ __forceinline__ void chk_gdn_qku(const Ptrs& P, int vcu, int G) {
    const u16* RV = (const u16*)(P.ws + WS_GV); const u16* QK = (const u16*)(P.ws + WS_GQK); u16* ref = (u16*)(P.ws + WS_CHK);
    float num = 0.f, den = 0.f;
    for (int i = vcu * NTHR + opaque_tid(); i < 64 * 1024; i += G * NTHR) { const int t = i >> 10, hd = (i >> 7) & 7, dv = i & 127; float o = 0.f;
        for (int j = 0; j < 64; ++j) o += h2f(QK[(size_t)hd * 4096 + t * 64 + j]) * h2f(RV[(size_t)(dv >> 1) * 1024 + hd * 128 + (dv & 1) * 64 + j]);
#ifdef CHK_W
        { const float r = h2f(ref[i]); num += (o - r) * (o - r); den += r * r; }
#else
        ref[i] = f2h(o);
#endif
    }
#ifdef CHK_W
    chk_accum(P, num, den);
#endif
}
#endif
#if CHECK == 9
__device__ __forceinline__ void chk_mfma(const Ptrs& P) {
    const int lane = opaque_tid() & 63, lo = lane & 15, g = lane >> 4;
    float bad = 0.f;
    { s16x8 a = {0,0,0,0,0,0,0,0}, b = {0,0,0,0,0,0,0,0};
      if (g == 0) { a[0] = (short)f2h((float)lo); b[0] = (short)f2h(1.f); }
      f32x4 d = {0.f, 0.f, 0.f, 0.f}; d = mfma16(a, b, d);
      for (int r = 0; r < 4; ++r) if (d[r] != (float)(4 * g + r)) bad += 1.f; }
    for (int J = 0; J < 32; ++J) {
        f32x4 v0, v1;
        for (int r = 0; r < 4; ++r) { v0[r] = (float)(4 * g + r); v1[r] = (float)(16 + 4 * g + r); }
        const s16x8 Bv = pk2blk(v0, v1);
        s16x8 a = {0,0,0,0,0,0,0,0};
        for (int e = 0; e < 8; ++e) { const int j = 16 * (e >> 2) + 4 * g + (e & 3); a[e] = (j == J) ? (short)f2h(1.f) : (short)0; }
        f32x4 d = {0.f, 0.f, 0.f, 0.f}; d = mfma16(a, Bv, d);
        for (int r = 0; r < 4; ++r) if (d[r] != (float)J) bad += 1000.f;
    }
    bad = wave_sum(bad);
    if (lane == 0) { float* c = (float*)(P.ws + WS_CTL) + CW_CHK; atomicAdd(c, bad); atomicAdd(c + 1, 1.f); }
}
#endif
#ifndef PHM
#define PHM 0xffff
#endif

__global__ void __launch_bounds__(NTHR, 2) fwd(Args args) {
    extern __shared__ __attribute__((aligned(16))) unsigned char lds_[];
    LAS uchar* lds = (LAS uchar*)lds_;
    const int tid = threadIdx.x;
    const int G = gridDim.x, bid = blockIdx.x; const int vcu = (G % 8 == 0) ? (bid % 8) * (G / 8) + bid / 8 : bid;
    Ptrs P; P.ka = (KArgs)__builtin_amdgcn_kernarg_segment_ptr(); P.out = args.out; P.ws = args.ws;
    uchar* ws = args.ws;
    volatile LAS unsigned* MISC = (volatile LAS unsigned*)(lds + MISC_OFF);
    for (int u = tid; u < (LDS_BYTES - MISC_OFF) / 4; u += NTHR) MISC[u] = 0u;
    __syncthreads();
    unsigned* ctl = (unsigned*)(ws + WS_CTL);
    XcdBarrier bar = xcd_barrier_post(ctl + CW_BAR, MISC + 8);
#define GRID_BAR() xcd_barrier(bar)
    LAS float* tabA = (LAS float*)(lds + TABA_OFF); LAS float* tabB = (LAS float*)(lds + TABB_OFF);
    u16* A16 = (u16*)(ws + WS_A16); float* STAT = (float*)(ws + WS_STAT); float* STAT2 = (float*)(ws + WS_STAT2);
    u16* WIN = (u16*)(ws + WS_WIN); u16* WOUT = (u16*)(ws + WS_WOUT); u16* W1 = (u16*)(ws + WS_W1); u16* W2 = (u16*)(ws + WS_W2); u16* HID = (u16*)(ws + WS_HID);
    const f32x2* ROPE = (const f32x2*)(ws + WS_ROPE);
    float* H = args.out;

#if PHM & 1024
#ifndef GMASK
#define GMASK 0xffff
#endif
#define RUN_GEMM(EPI, e_, A_, B_, N_, K_, lda_, ldb_, S_) do { if constexpr ((GMASK >> EPI::ID) & 1) { pg8::Gemm g_{(const u16*)(A_), (const u16*)(B_), L, (N_), (K_), (lda_), (ldb_)}; \
        pg8::gemm_phase<EPI, pg8::StaticOrder, true, EPI::SP2>(lds, g_, S_, e_); } } while (0)
#else
#define RUN_GEMM(EPI, e_, A_, B_, N_, K_, lda_, ldb_, S_) do { (void)e_; } while (0)
#endif
#define MLP_BLOCK() do { \
        { pg8::StaticOrder S; S.init(L, 2048, G, bid); build_tab(tabA, S, STAT, 0, 32, 1.f / 1024.f); EpiUp e{HID, 2048, tabA}; RUN_GEMM(EpiUp, e, A16, W1, 2048, 1024, 1024, 1024, S); } GRID_BAR(); \
        { pg8::StaticOrder S; S.init(L, 1024, G, bid); EpiResid e{H, H, nullptr, nullptr, nullptr}; RUN_GEMM(EpiResid, e, HID, W2, 1024, 2048, 2048, 4096, S); } GRID_BAR(); \
        { pg8::StaticOrder S; S.init(L, 2048, G, bid); build_tab(tabA, S, STAT, 0, 32, 1.f / 1024.f); EpiUp e{HID, 2048, tabA}; RUN_GEMM(EpiUp, e, A16, W1 + (size_t)2048 * 1024, 2048, 1024, 1024, 1024, S); } GRID_BAR(); \
        { pg8::StaticOrder S; S.init(L, 1024, G, bid); EpiResid e{H, H, A16, STAT, nullptr}; RUN_GEMM(EpiResid, e, HID, W2 + 2048, 1024, 2048, 2048, 4096, S); } GRID_BAR(); } while (0)

#if CHECK == 9
    if (bid == 0 && tid < 64) chk_mfma(P);
#endif
#if PHM & 1
    prologue_x(P, vcu, G);
    convert_layer<0>(P, lds, vcu, G);
#endif
    GRID_BAR();

    { pg8::StaticOrder S; S.init(L, 3840, G, bid);
      EpiDsaIn e{(const float*)(ws + WS_RSTDX), (u16*)(ws + WS_DQ), (u16*)(ws + WS_DK), (u16*)(ws + WS_DVT), (u16*)(ws + WS_DQI), (u16*)(ws + WS_DKI), (float*)(ws + WS_DWI), P.in(7), P.in(8)};
      RUN_GEMM(EpiDsaIn, e, A16, WIN, 3840, 1024, 1024, 1024, S); }
    GRID_BAR();
#if PHM & 4
    dsa_indexer(P, lds, vcu, G);
#endif
    GRID_BAR();
#if PHM & 8
    { const u16* Q = (const u16*)(ws + WS_DQ); const u16* K = (const u16*)(ws + WS_DK); const u16* VT = (const u16*)(ws + WS_DVT); const unsigned* BITS = (const unsigned*)(ws + WS_DBITS); u16* O = (u16*)(ws + WS_DQ);
      if (G == 256) { const int head = vcu >> 5, s = vcu & 31;
#pragma unroll 1
          for (int i = 0; i < 2; ++i) { const int qb = i ? 63 - s : s; attn_unit<128, 128, true>(lds, Q + head * 128, 1024, K + head * 128, 1024, nullptr, 0, VT + (size_t)head * 128 * L, BITS, O + head * 128, 1024, qb); } }
      else { for (int j = vcu; j < 8 * 64; j += G) { const int head = j >> 6, qb = j & 63; attn_unit<128, 128, true>(lds, Q + head * 128, 1024, K + head * 128, 1024, nullptr, 0, VT + (size_t)head * 128 * L, BITS, O + head * 128, 1024, qb); } } }
#endif
    GRID_BAR();
    { pg8::StaticOrder S; S.init(L, 1024, G, bid); EpiResid e{P.in(0), H, A16, STAT, nullptr}; RUN_GEMM(EpiResid, e, ws + WS_DQ, WOUT, 1024, 1024, 1024, 1024, S); }
    GRID_BAR();
    MLP_BLOCK();
#if PHM & 1
    convert_layer<1>(P, lds, vcu, G);
#endif
    GRID_BAR();

    { pg8::StaticOrder S; S.init(L, 2048, G, bid); build_tab(tabA, S, STAT, 0, 32, 1.f / 1024.f); EpiGlu e{(u16*)(ws + WS_CU), P.in(11), tabA}; RUN_GEMM(EpiGlu, e, A16, WIN, 2048, 1024, 1024, 1024, S); }
    GRID_BAR();
#if PHM & 32
    conv_dw_phase(P, lds, vcu, G);
#endif
    GRID_BAR();
#if !(SKIPMIX & 2)
    { pg8::StaticOrder S; S.init(L, 1024, G, bid); EpiResid e{H, H, A16, STAT, P.in(17)}; RUN_GEMM(EpiResid, e, ws + WS_CL, WOUT, 1024, 1024, 1024, 1024, S); }
#endif
    GRID_BAR();
    MLP_BLOCK();
#if PHM & 1
    convert_layer<2>(P, lds, vcu, G);
#endif
    GRID_BAR();

    { pg8::StaticOrder S; S.init(L, 768, G, bid); build_tab(tabA, S, STAT, 0, 32, 1.f / 1024.f);
      EpiMlaIn e{(u16*)(ws + WS_MP), (u16*)(ws + WS_MKR), STAT2, ROPE, tabA}; RUN_GEMM(EpiMlaIn, e, A16, WIN, 768, 1024, 1024, 1024, S); }
    GRID_BAR();
    { pg8::StaticOrder S; S.init(L, 1536, G, bid); build_tab(tabA, S, STAT2, 0, 12, 1.f / 384.f);
      EpiMlaUq e{(u16*)(ws + WS_MQ), ROPE, tabA}; RUN_GEMM(EpiMlaUq, e, ws + WS_MP, ws + WS_WB, 1536, 384, 640, 384, S); }
    { pg8::StaticOrder S; S.init(L, 2048, G, bid); build_tab(tabB, S, STAT2, 12, 20, 1.f / 256.f);
      EpiMlaUkv e{(u16*)(ws + WS_MKN), (u16*)(ws + WS_MVT), tabB}; RUN_GEMM(EpiMlaUkv, e, (u16*)(ws + WS_MP) + 384, ws + WS_WC, 2048, 256, 640, 256, S); }
    GRID_BAR();
#if PHM & 16
    { const u16* Q = (const u16*)(ws + WS_MQ); const u16* KN = (const u16*)(ws + WS_MKN); const u16* KR = (const u16*)(ws + WS_MKR); const u16* VT = (const u16*)(ws + WS_MVT); u16* O = (u16*)(ws + WS_MO);
      if (G == 256) { const int head = vcu >> 4, s = vcu & 15;
#pragma unroll 1
          for (int i = 0; i < 4; ++i) { const int qb = (i == 0) ? s : (i == 1) ? 31 - s : (i == 2) ? 32 + s : 63 - s;
              attn_unit<96, 64, false>(lds, Q + head * 96, 1536, KN + head * 64, 1024, KR, 32, VT + (size_t)head * 64 * L, nullptr, O + head * 64, 1024, qb); } }
      else { for (int j = vcu; j < 16 * 64; j += G) { const int head = j >> 6, qb = j & 63; attn_unit<96, 64, false>(lds, Q + head * 96, 1536, KN + head * 64, 1024, KR, 32, VT + (size_t)head * 64 * L, nullptr, O + head * 64, 1024, qb); } } }
#endif
    GRID_BAR();
#if !(SKIPMIX & 4)
    { pg8::StaticOrder S; S.init(L, 1024, G, bid); EpiResid e{H, H, A16, STAT, nullptr}; RUN_GEMM(EpiResid, e, ws + WS_MO, WOUT, 1024, 1024, 1024, 1024, S); }
#endif
    GRID_BAR();
    MLP_BLOCK();
#if PHM & 1
    convert_layer<3>(P, lds, vcu, G);
#endif
    GRID_BAR();

    { pg8::StaticOrder S; S.init(L, 3072, G, bid); build_tab(tabA, S, STAT, 0, 32, 1.f / 1024.f);
      EpiScale16 e{(u16*)(ws + WS_GQ), 1024, (size_t)16 * MiB, tabA}; RUN_GEMM(EpiScale16, e, A16, WIN, 3072, 1024, 1024, 1024, S); }
    { pg8::StaticOrder S; S.init(L, 1024, G, bid); build_tab(tabB, S, STAT, 0, 32, 1.f / 1024.f);
      EpiScale16 e{(u16*)(ws + WS_GGATE), 1024, (size_t)0, tabB}; RUN_GEMM(EpiScale16, e, A16, ws + WS_WD, 1024, 1024, 1024, 1024, S); }
    GRID_BAR();
#if PHM & 64
    gdn_pre(P, vcu, G);
#endif
    GRID_BAR();
#if CHECK == 3
    chk_gdn_ref(P, lds, vcu);
    GRID_BAR();
#endif
#if PHM & 128
    gdn_chunk(P, lds, vcu, G);
#endif
    GRID_BAR();
#if CHECK == 3 && defined(CHK_V)
    chk_gdn_qku(P, vcu, G);
    GRID_BAR();
#endif
#if CHECK == 3 && defined(CHK_U)
    chk_gdn_cmp(P, vcu, G, true);
    GRID_BAR();
#endif
#if PHM & 256
    { const int tid_ = opaque_tid(), lane_ = tid_ & 63, wave_ = __builtin_amdgcn_readfirstlane(tid_ >> 6);
      for (int c = 0; c < 64; ++c) if ((4 * c) % G == vcu && (4 * c) / G == wave_) gdn_scan(P, c, lane_); }
#endif
    GRID_BAR();
#if CHECK == 3 && !defined(CHK_U) && !defined(CHK_W)
    chk_gdn_cmp(P, vcu, G, false);
    GRID_BAR();
#endif
#if PHM & 512
    gdn_out(P, lds, vcu, G);
#endif
    GRID_BAR();
#if !(SKIPMIX & 8)
    { pg8::StaticOrder S; S.init(L, 1024, G, bid); EpiResid e{H, H, A16, STAT, nullptr}; RUN_GEMM(EpiResid, e, ws + WS_GGATE, WOUT, 1024, 1024, 1024, 1024, S); }
#endif
    GRID_BAR();
    MLP_BLOCK();
#if PHM & 1
    final_norm(P, vcu, G);
#endif
#if CHECK
    GRID_BAR();
    chk_emit(P, vcu, G);
#endif
}

extern "C" void kernel_launch(void* const* d_in, const int* in_sizes, int n_in, void* d_out, int out_size, void* d_ws, size_t ws_size, hipStream_t stream) {
    static int grid = 0;
    if (grid == 0) {
        if (n_in != 30 || in_sizes[0] != L * D || out_size != L * D || ws_size < WS_END) { fprintf(stderr, "kernel_launch: unexpected shapes (n_in %d, in0 %d, out %d, ws %zu); nothing launched\n", n_in, n_in > 0 ? in_sizes[0] : -1, out_size, ws_size); grid = -1; return; }
        int dev = 0, cus = 0, per_cu = 0;
        if (hipGetDevice(&dev) != hipSuccess || hipDeviceGetAttribute(&cus, hipDeviceAttributeMultiprocessorCount, dev) != hipSuccess) { grid = -1; return; }
        if (hipFuncSetAttribute((const void*)fwd, hipFuncAttributeMaxDynamicSharedMemorySize, LDS_BYTES) != hipSuccess) { fprintf(stderr, "kernel_launch: hipFuncSetAttribute failed\n"); grid = -1; return; }
        if (hipOccupancyMaxActiveBlocksPerMultiprocessor(&per_cu, (const void*)fwd, NTHR, LDS_BYTES) != hipSuccess || per_cu < 1) fprintf(stderr, "kernel_launch: occupancy query reports %d workgroups per CU\n", per_cu);
        (void)hipGetLastError();
        grid = cus;
    }
    if (grid < 0) return;
    if (hipMemsetAsync((char*)d_ws + WS_CTL, 0, CTL_ZERO_BYTES, stream) != hipSuccess) return;
    Args a{};
    for (int i = 0; i < 30; ++i) a.in[i] = (const float*)d_in[i];
    a.out = (float*)d_out; a.ws = (uchar*)d_ws;
    hipLaunchKernelGGL(fwd, dim3(grid), dim3(NTHR), LDS_BYTES, stream, a);
}
```

```cpp
#include <hip/hip_runtime.h>
#include <cstdio>
#include <cstdint>
#ifndef CHREP
#define CHREP 0
#endif
#ifndef IDXREP
#define IDXREP 0
#endif
#ifndef REP
#define REP 0
#endif
#ifndef TIMING
#define TIMING 0
#endif
#ifndef SKIPMIX
#define SKIPMIX 0
#endif

#define GAS __attribute__((address_space(1)))
#define LAS __attribute__((address_space(3)))
typedef unsigned short u16;
typedef unsigned char uchar;
typedef short s16x8 __attribute__((ext_vector_type(8)));
typedef short s16x4 __attribute__((ext_vector_type(4)));
typedef _Float16 h16x8 __attribute__((ext_vector_type(8)));
typedef _Float16 h16x2 __attribute__((ext_vector_type(2)));
typedef float f32x2 __attribute__((ext_vector_type(2)));
typedef float f32x4 __attribute__((ext_vector_type(4)));
typedef float f32x16 __attribute__((ext_vector_type(16)));
typedef unsigned u32x2 __attribute__((ext_vector_type(2)));
typedef unsigned u32x4 __attribute__((ext_vector_type(4)));

__device__ __forceinline__ unsigned pk16(float lo, float hi) { h16x2 v = {(_Float16)lo, (_Float16)hi}; return __builtin_bit_cast(unsigned, v); }
__device__ __forceinline__ u16 f2h(float f) { _Float16 h = (_Float16)f; return __builtin_bit_cast(u16, h); }
__device__ __forceinline__ float h2f(u16 u) { return (float)__builtin_bit_cast(_Float16, u); }
__device__ __forceinline__ f32x4 mfma16(s16x8 a, s16x8 b, f32x4 c) { return __builtin_amdgcn_mfma_f32_16x16x32_f16(__builtin_bit_cast(h16x8, a), __builtin_bit_cast(h16x8, b), c, 0, 0, 0); }
__device__ __forceinline__ f32x16 mfma32(s16x8 a, s16x8 b, f32x16 c) { return __builtin_amdgcn_mfma_f32_32x32x16_f16(__builtin_bit_cast(h16x8, a), __builtin_bit_cast(h16x8, b), c, 0, 0, 0); }
__device__ __forceinline__ u32x4 pack8(f32x4 a, f32x4 b) { u32x4 w; w.x = pk16(a[0], a[1]); w.y = pk16(a[2], a[3]); w.z = pk16(b[0], b[1]); w.w = pk16(b[2], b[3]); return w; }
__device__ __forceinline__ float wave_sum(float v) {
#pragma unroll
    for (int o = 1; o < 64; o <<= 1) v += __shfl_xor(v, o);
    return v;
}
__device__ __forceinline__ float sigmoidf_(float x) { return __builtin_amdgcn_rcpf(1.f + __builtin_amdgcn_exp2f(-1.4426950408889634f * x)); }
__device__ __forceinline__ float siluf_(float x) { return x * __builtin_amdgcn_rcpf(1.f + __builtin_amdgcn_exp2f(-1.4426950408889634f * x)); }

__device__ __forceinline__ int opaque_tid() { int t = threadIdx.x; asm volatile("" : "+v"(t)); return t; }

__device__ __forceinline__ float max3f_(float a, float b, float c) { float r; asm("v_max3_f32 %0, %1, %2, %3" : "=v"(r) : "v"(a), "v"(b), "v"(c)); return r; }

namespace pg8 {
#define PG8_LAS __attribute__((address_space(3)))
typedef unsigned short bf16_t;
typedef short bf16x8 __attribute__((ext_vector_type(8)));
typedef float f32x4 __attribute__((ext_vector_type(4)));
typedef unsigned u32x4 __attribute__((ext_vector_type(4)));
constexpr int BM = 256, BK = 64, HALF = 128, HTB = HALF * BK * 2  , STAGE_BYTES = 8 * HTB, NXCD = 8, WGM = 8;

__host__ __device__ __forceinline__ int lds_byte(int r, int c) { const int st = (r >> 4) * 2 + (c >> 5), rr = r & 15, cc = c & 31, ob = rr * 64 + cc * 2; return st * 1024 + (ob ^ (((ob >> 9) & 1) << 5)); }
__host__ __device__ __forceinline__ void stage_rc(int b, int& R, int& C) { const int st = b / 1024, sb = b % 1024, swz = sb ^ (((sb >> 9) & 1) << 5); R = (st >> 1) * 16 + swz / 64; C = (st & 1) * 32 + (swz % 64) / 2; }
__host__ __device__ __forceinline__ int perm32(int rho) { const int n = rho >> 4, i = rho & 15; return 8 * (i >> 2) + 4 * n + (i & 3); }

struct Unit { int pm, pn; };
struct Gemm { const bf16_t* A; const bf16_t* Bt; int M, N, K, lda, ldb; };

struct StaticOrder {
    int nM, nN, nwg, G, c;
    __host__ __device__ void init(int M, int N, int G_, int c_) { nM = M / BM; nN = N / BM; nwg = nM * nN; G = G_; c = c_; }
    __host__ __device__ bool next(int i, Unit& u) const {
        const long L = (long)i * G + c; if (L >= nwg) return false;
        int wgid = (int)L; { const int q = nwg / NXCD, r = nwg % NXCD, xcd = wgid % NXCD, off = wgid / NXCD; wgid = (xcd < r ? xcd * (q + 1) : r * (q + 1) + (xcd - r) * q) + off; }
        const int nig = WGM * nN, gid = wgid / nig, fm = gid * WGM, gsz = (nM - fm) < WGM ? (nM - fm) : WGM;
        u.pm = fm + ((wgid % nig) % gsz); u.pn = (wgid % nig) / gsz; return true;
    }
    __device__ __forceinline__ void a_ready(const Unit&) const {}
    __device__ __forceinline__ void done(const Unit&) const {}
};

template <class Epi, class Sched, bool ALIGN_EPI = false, bool SP2 = false>
__device__ __forceinline__ void gemm_phase(PG8_LAS unsigned char* lds, const Gemm g, const Sched& S, const Epi& E) {
    int tid = threadIdx.x; asm volatile("" : "+v"(tid));
    const int wid = __builtin_amdgcn_readfirstlane(tid >> 6), lane = tid & 63, wr = wid >> 2, wc = wid & 3, fr = lane & 15, fq = lane >> 4;
    const int K = g.K, nt = K / BK, lda = g.lda, ldb = g.ldb;
    unsigned voffA[2], voffB[2];
#pragma unroll
    for (int i = 0; i < 2; ++i) { int R, C; stage_rc(tid * 16 + i * 8192, R, C); const int Rb = Epi::PERM ? ((R & ~31) + perm32(R & 31)) : R;
        voffA[i] = (unsigned)(R * lda + C) * 2u; voffB[i] = (unsigned)(Rb * ldb + C) * 2u; }
    const size_t kstep = (size_t)(BK * 2);
    const size_t hstepA = (size_t)HALF * lda * 2, hstepB = (size_t)HALF * ldb * 2;
    const size_t tstepA = 2 * hstepA, tstepB = 2 * hstepB;
    const unsigned ldsw = (unsigned)wid * 1024u;
    const int aoff = lds_byte(wr * 64 + fr, fq * 8), boff = lds_byte(wc * 32 + fr, fq * 8);
#define PG8_SA(b, h) (((b) * 2 + (h)) * HTB)
#define PG8_SB(b, h) ((4 + (b) * 2 + (h)) * HTB)
#define PG8_STAGE(bufoff, gbase, voff) do { _Pragma("unroll") for (int _i = 0; _i < 2; ++_i) \
        __builtin_amdgcn_global_load_lds((const unsigned*)((const char*)(gbase) + (voff)[_i]), (PG8_LAS unsigned*)(lds + (bufoff) + ldsw + _i * 8192), 16, 0, 0); } while (0)
#define PG8_LDA(dst, b, h) do { _Pragma("unroll") for (int m = 0; m < 4; ++m) _Pragma("unroll") for (int k = 0; k < 2; ++k) dst[m][k] = *(const PG8_LAS bf16x8*)(lds + PG8_SA(b, h) + aoff + m * 2048 + k * 1024); } while (0)
#define PG8_LDB(dst, b, h) do { _Pragma("unroll") for (int n = 0; n < 2; ++n) _Pragma("unroll") for (int k = 0; k < 2; ++k) dst[n][k] = *(const PG8_LAS bf16x8*)(lds + PG8_SB(b, h) + boff + n * 2048 + k * 1024); } while (0)
#define PG8_MMA(ai, bj, At, Bt) do { __builtin_amdgcn_s_setprio(1); _Pragma("unroll") for (int m = 0; m < 4; ++m) _Pragma("unroll") for (int n = 0; n < 2; ++n) _Pragma("unroll") for (int k = 0; k < 2; ++k) \
        acc[ai][bj][m][n] = mfma16(Bt[n][k], At[m][k], acc[ai][bj][m][n]); __builtin_amdgcn_s_setprio(0); } while (0)
#define PG8_WAIT_V(n) asm volatile("s_waitcnt vmcnt(" #n ")" ::: "memory")
#define PG8_WAIT_L(n) asm volatile("s_waitcnt lgkmcnt(" #n ")" ::: "memory")
#define PG8_BAR __builtin_amdgcn_s_barrier()
#define PG8_SCHED __builtin_amdgcn_sched_barrier(0)
    Unit cur, nxt; int ui = 0;
    if (!S.next(0, cur)) return;
    f32x4 acc[2][2][4][2];
#pragma unroll
    for (int a = 0; a < 2; ++a)
#pragma unroll
        for (int b = 0; b < 2; ++b)
#pragma unroll
            for (int m = 0; m < 4; ++m)
#pragma unroll
                for (int n = 0; n < 2; ++n) acc[a][b][m][n] = (f32x4){0.f, 0.f, 0.f, 0.f};
    bf16x8 At[4][2], B0[2][2], B1[2][2];
    const char* cA = (const char*)g.A + (size_t)cur.pm * tstepA; const char* cB = (const char*)g.Bt + (size_t)cur.pn * tstepB;
    S.a_ready(cur);
    if constexpr (SP2) {
        PG8_STAGE(PG8_SB(0, 0), cB, voffB); PG8_STAGE(PG8_SB(0, 1), cB + hstepB, voffB); PG8_STAGE(PG8_SA(0, 0), cA, voffA); PG8_STAGE(PG8_SA(0, 1), cA + hstepA, voffA);
        if (wr == 1) PG8_BAR;
        PG8_WAIT_V(2); PG8_BAR;
        PG8_STAGE(PG8_SB(1, 0), cB + kstep, voffB); PG8_STAGE(PG8_SA(1, 0), cA + kstep, voffA); PG8_STAGE(PG8_SB(1, 1), cB + hstepB + kstep, voffB);
        PG8_WAIT_V(6); PG8_BAR;
    } else {
        PG8_STAGE(PG8_SB(0, 0), cB, voffB); PG8_STAGE(PG8_SA(0, 0), cA, voffA); PG8_STAGE(PG8_SB(0, 1), cB + hstepB, voffB); PG8_STAGE(PG8_SA(0, 1), cA + hstepA, voffA);
        if (wr == 1) PG8_BAR;
        PG8_WAIT_V(4); PG8_BAR;
        PG8_STAGE(PG8_SB(1, 0), cB + kstep, voffB); PG8_STAGE(PG8_SA(1, 0), cA + kstep, voffA); PG8_STAGE(PG8_SB(1, 1), cB + hstepB + kstep, voffB);
        PG8_WAIT_V(6); PG8_BAR;
    }
    for (;;) {
        const bool has_next = S.next(ui + 1, nxt);
        const char* nA = has_next ? (const char*)g.A + (size_t)nxt.pm * tstepA : cA; const char* nB = has_next ? (const char*)g.Bt + (size_t)nxt.pn * tstepB : cB;
#pragma unroll 1
        for (int t = 0; t < nt; t += 2) {
            const bool last = (t == nt - 2);
            const char* a1 = cA + (size_t)(t + 1) * kstep;
            const char* a2 = last ? nA : cA + (size_t)(t + 2) * kstep; const char* b2 = last ? nB : cB + (size_t)(t + 2) * kstep;
            const char* a3 = a2 + kstep; const char* b3 = b2 + kstep;
            if (last && has_next) S.a_ready(nxt);
            if constexpr (SP2) {
            PG8_LDB(B0, 0, 0); PG8_LDB(B1, 0, 1); PG8_SCHED; PG8_LDA(At, 0, 0); PG8_STAGE(PG8_SA(1, 1), a1 + hstepA, voffA);
            PG8_WAIT_V(8); PG8_WAIT_L(0); PG8_BAR; PG8_MMA(0, 0, At, B0); PG8_MMA(0, 1, At, B1); PG8_BAR; PG8_SCHED;
            PG8_LDA(At, 0, 1); PG8_STAGE(PG8_SB(0, 0), b2, voffB); PG8_STAGE(PG8_SB(0, 1), b2 + hstepB, voffB); PG8_STAGE(PG8_SA(0, 0), a2, voffA);
            PG8_WAIT_V(8); PG8_WAIT_L(0); PG8_BAR; PG8_MMA(1, 0, At, B0); PG8_MMA(1, 1, At, B1); PG8_BAR; PG8_SCHED;
            PG8_LDB(B0, 1, 0); PG8_LDB(B1, 1, 1); PG8_SCHED; PG8_LDA(At, 1, 0); PG8_STAGE(PG8_SA(0, 1), a2 + hstepA, voffA);
            PG8_WAIT_V(8); PG8_WAIT_L(0); PG8_BAR; PG8_MMA(0, 0, At, B0); PG8_MMA(0, 1, At, B1); PG8_BAR; PG8_SCHED;
            PG8_LDA(At, 1, 1); PG8_STAGE(PG8_SB(1, 0), b3, voffB); PG8_STAGE(PG8_SB(1, 1), b3 + hstepB, voffB); PG8_STAGE(PG8_SA(1, 0), a3, voffA);
            PG8_WAIT_V(8); PG8_WAIT_L(0); PG8_BAR; PG8_MMA(1, 0, At, B0); PG8_MMA(1, 1, At, B1); PG8_BAR; PG8_SCHED;
            } else {
            PG8_LDB(B0, 0, 0); PG8_SCHED; PG8_LDA(At, 0, 0); PG8_STAGE(PG8_SA(1, 1), a1 + hstepA, voffA);
            PG8_WAIT_L(8); PG8_BAR; PG8_WAIT_L(0); PG8_MMA(0, 0, At, B0); PG8_BAR; PG8_SCHED;
            PG8_LDB(B1, 0, 1); PG8_STAGE(PG8_SB(0, 0), b2, voffB);
            PG8_BAR; PG8_WAIT_L(0); PG8_MMA(0, 1, At, B1); PG8_BAR;
            PG8_LDA(At, 0, 1); PG8_STAGE(PG8_SA(0, 0), a2, voffA);
            PG8_BAR; PG8_WAIT_L(0); PG8_MMA(1, 0, At, B0); PG8_BAR; PG8_SCHED;
            PG8_STAGE(PG8_SB(0, 1), b2 + hstepB, voffB);
            PG8_WAIT_V(6); PG8_BAR; PG8_MMA(1, 1, At, B1); PG8_BAR;
            PG8_LDB(B0, 1, 0); PG8_SCHED; PG8_LDA(At, 1, 0); PG8_STAGE(PG8_SA(0, 1), a2 + hstepA, voffA);
            PG8_WAIT_L(8); PG8_BAR; PG8_WAIT_L(0); PG8_MMA(0, 0, At, B0); PG8_BAR; PG8_SCHED;
            PG8_LDB(B1, 1, 1); PG8_STAGE(PG8_SB(1, 0), b3, voffB);
            PG8_BAR; PG8_WAIT_L(0); PG8_MMA(0, 1, At, B1); PG8_BAR;
            PG8_LDA(At, 1, 1); PG8_STAGE(PG8_SA(1, 0), a3, voffA);
            PG8_BAR; PG8_WAIT_L(0); PG8_MMA(1, 0, At, B0); PG8_BAR; PG8_SCHED;
            PG8_STAGE(PG8_SB(1, 1), b3 + hstepB, voffB);
            PG8_WAIT_V(6); PG8_BAR; PG8_MMA(1, 1, At, B1); PG8_BAR;
            }
        }
        if constexpr (ALIGN_EPI) { if (wr == 0) PG8_BAR; }
        if constexpr (!Epi::AFTER_DRAIN) { E(acc, cur, ui, wr, wc, fr, fq); S.done(cur); }
        if (!has_next) break;
#pragma unroll
        for (int a = 0; a < 2; ++a)
#pragma unroll
            for (int b = 0; b < 2; ++b)
#pragma unroll
                for (int m = 0; m < 4; ++m)
#pragma unroll
                    for (int n = 0; n < 2; ++n) acc[a][b][m][n] = (f32x4){0.f, 0.f, 0.f, 0.f};
        cur = nxt; cA = nA; cB = nB; ++ui;
        if constexpr (ALIGN_EPI) { if (wr == 1) PG8_BAR; }
    }
    PG8_WAIT_V(0);
    if constexpr (!ALIGN_EPI) { if (wr == 0) PG8_BAR; }
    PG8_BAR;
    if constexpr (Epi::AFTER_DRAIN) { E.fused(acc, cur, wr, wc, fr, fq, lds, wid, lane); S.done(cur); }
#undef PG8_SA
#undef PG8_SB
#undef PG8_STAGE
#undef PG8_LDA
#undef PG8_LDB
#undef PG8_MMA
#undef PG8_WAIT_V
#undef PG8_WAIT_L
#undef PG8_BAR
#undef PG8_SCHED
}
}

using pg8::Unit;
constexpr int L = 16384, D = 1024, FF = 4096, NWAVES = 8, NTHR = 512;
constexpr float EPS = 1e-6f;
constexpr float LOG2E = 1.4426950408889634f;
constexpr float QS_DSA = 0.08838834764831845f * LOG2E;
constexpr float QS_MLA = 0.10206207261596575f * LOG2E;
constexpr float WI_SCALE = 0.04419417382415922f;
constexpr float GDN_QS = 0.08838834764831845f;
#define NEG_INF (-__builtin_inff())

constexpr size_t MiB = 1u << 20;
constexpr size_t WS_CTL = 0, CTL_ZERO_BYTES = 1 * MiB;
constexpr size_t WS_ROPE = 1 * MiB;
constexpr size_t WS_STAT = 3 * MiB;
constexpr size_t WS_STAT2 = 5 * MiB;
constexpr size_t WS_RSTDX = 7 * MiB;
constexpr size_t WS_WIN = 8 * MiB;
constexpr size_t WS_WB = 10 * MiB, WS_WC = 12 * MiB, WS_WD = 14 * MiB;
constexpr size_t WS_WOUT = 16 * MiB;
constexpr size_t WS_W1 = 20 * MiB, WS_W2 = 28 * MiB;
constexpr size_t WS_A16 = 36 * MiB;
constexpr size_t WS_ACT = 68 * MiB;
constexpr size_t WS_HID = WS_ACT;
constexpr size_t WS_DQ = 68 * MiB, WS_DK = 100 * MiB, WS_DVT = 132 * MiB, WS_DQI = 164 * MiB, WS_DKI = 180 * MiB, WS_DWI = 182 * MiB, WS_DBITS = 188 * MiB, WS_DO = 220 * MiB;
constexpr size_t WS_CU = 68 * MiB, WS_CL = 100 * MiB;
constexpr size_t WS_MP = 68 * MiB, WS_MKR = 88 * MiB, WS_MQ = 90 * MiB, WS_MKN = 138 * MiB, WS_MVT = 170 * MiB, WS_MO = 202 * MiB;
constexpr size_t WS_GQ = 68 * MiB, WS_GK = 100 * MiB, WS_GV = 132 * MiB, WS_GW = 164 * MiB, WS_GQK = 196 * MiB, WS_GHALO = 212 * MiB, WS_GG = 217 * MiB, WS_GBETA = WS_GG + 512 * 1024, WS_GGL = 218 * MiB, WS_GGATE = 219 * MiB;
constexpr size_t WS_END = 256 * MiB;
constexpr int CW_TMO = 0, CW_BAR = 4096;

constexpr int RING_BYTES = 131072;
constexpr int TABA_OFF = 131072, TABB_OFF = 139264, MISC_OFF = 147456, LDS_BYTES = 148480;

typedef GAS unsigned gu32;
#define RLX_AGENT __ATOMIC_RELAXED, __HIP_MEMORY_SCOPE_AGENT
#define XB_TMO      128
#define XB_XCNT(j)  (256  + 64 * (j))
#define XB_XSUB(j)  (1280 + 64 * (j))
#define XB_XGEN(j)  (2304 + 64 * (j))
#define XB_TOP      3328
#define XB_TOPGEN   3392
#define XCD_BAR_WORDS 3456
#define XB_SPIN_CAP (1u << 18)

__device__ __forceinline__ unsigned xb_ld(unsigned* p)              { return __hip_atomic_load(p, __ATOMIC_RELAXED, __HIP_MEMORY_SCOPE_AGENT); }
__device__ __forceinline__ unsigned xb_add(unsigned* p, unsigned v) { return __hip_atomic_fetch_add(p, v, __ATOMIC_RELAXED, __HIP_MEMORY_SCOPE_AGENT); }
__device__ __forceinline__ unsigned xb_xcc_id() { return (unsigned)__builtin_amdgcn_s_getreg((3 << 11) | 20) & 0xFu; }
#define XB_SPIN(cond, bar) do { unsigned _sp = 0; while (cond) { __builtin_amdgcn_s_sleep(1); \
    if ((++_sp & 255u) == 0u) { if (xb_ld(&(bar)[XB_TMO])) break; if (_sp > XB_SPIN_CAP) { atomicAdd(&(bar)[XB_TMO], 1u); break; } } } } while (0)

struct XcdBarrier {
    unsigned* bar; unsigned x;
    volatile LAS unsigned* st;
};

__device__ __forceinline__ XcdBarrier xcd_barrier_post(unsigned* bar, volatile LAS unsigned* st) {
    XcdBarrier b; b.bar = bar; b.x = xb_xcc_id(); b.st = st;
    if (threadIdx.x == 0) (void)xb_add(&bar[XB_XCNT(b.x)], 1u);
    return b;
}
__device__ __forceinline__ void xcd_barrier_complete(unsigned* bar, unsigned x, unsigned& nloc, unsigned& nx) {
    const unsigned G = gridDim.x * gridDim.y * gridDim.z;
    unsigned sum, cnt, mine, sp = 0u;
    for (;;) {
        sum = 0u; cnt = 0u; mine = 0u;
#pragma unroll
        for (unsigned j = 0; j < 16; ++j) { const unsigned c = xb_ld(&bar[XB_XCNT(j)]); sum += c; cnt += (c > 0u) ? 1u : 0u; mine = (j == x) ? c : mine; }
        if (sum == G) break;
        __builtin_amdgcn_s_sleep(1);
        if ((++sp & 255u) == 0u) { if (xb_ld(&bar[XB_TMO])) break; if (sp > XB_SPIN_CAP) { atomicAdd(&bar[XB_TMO], 1u); break; } }
    }
    nloc = mine > 0u ? mine : 1u; nx = cnt > 0u ? cnt : 1u;
}

__device__ __forceinline__ void xcd_barrier(const XcdBarrier& b) {
    asm volatile("s_waitcnt vmcnt(0)" ::: "memory");
    __syncthreads();
    if (threadIdx.x == 0) {
        unsigned* bar = b.bar;
        __builtin_amdgcn_s_waitcnt(0);
        unsigned nloc = b.st[0], nx = b.st[1];
        if (nloc == 0u) { xcd_barrier_complete(bar, b.x, nloc, nx); b.st[0] = nloc; b.st[1] = nx; }
        const unsigned old = xb_add(&bar[XB_XSUB(b.x)], 1u);
        const unsigned gen = old / nloc;
        if (old + 1u == (gen + 1u) * nloc) {
            __builtin_amdgcn_fence(__ATOMIC_RELEASE, "agent");
            asm volatile("s_waitcnt vmcnt(0)" ::: "memory");
            const unsigned og = xb_add(&bar[XB_TOP], 1u);
            const unsigned tg = og / nx;
            if (og + 1u == (tg + 1u) * nx) xb_add(&bar[XB_TOPGEN], 1u);
            else XB_SPIN(xb_ld(&bar[XB_TOPGEN]) == tg, bar);
            __builtin_amdgcn_fence(__ATOMIC_ACQUIRE, "agent");
            xb_add(&bar[XB_XGEN(b.x)], 1u);
            asm volatile("s_waitcnt vmcnt(0)" ::: "memory");
        } else {
            XB_SPIN(xb_ld(&bar[XB_XGEN(b.x)]) == gen, bar);
            __builtin_amdgcn_fence(__ATOMIC_ACQUIRE, "agent");
            asm volatile("s_waitcnt vmcnt(0)" ::: "memory");
        }
    }
    __syncthreads();
}

#define EROW(ai, m) (u.pm * 256 + (ai) * 128 + wr * 64 + (m) * 16 + fr)
#define ECOL(bj) ((bj) * 128 + wc * 32 + fq * 8)
#define ETAB(tab, ai, m) ((tab)[ui * 256 + (ai) * 128 + wr * 64 + (m) * 16 + fr])
#define EPI_ARGS const f32x4 (&acc)[2][2][4][2], const Unit& u, int ui, int wr, int wc, int fr, int fq

struct EpiDsaIn {
    static constexpr int ID = 0; static constexpr bool SP2 = true, ALIGN = true; static constexpr bool PERM = true, AFTER_DRAIN = false;
    const float* rstdx; u16 *Q, *K, *Vt, *QI, *KI; float* WI; const float *kg, *kb;
    __device__ __forceinline__ void operator()(EPI_ARGS) const {
        const int pn = u.pn;
        float rsv[2][4];
#pragma unroll
        for (int ai = 0; ai < 2; ++ai)
#pragma unroll
            for (int m = 0; m < 4; ++m) rsv[ai][m] = rstdx[EROW(ai, m)];
        __builtin_amdgcn_sched_barrier(0);
#pragma unroll
        for (int ai = 0; ai < 2; ++ai)
#pragma unroll
        for (int m = 0; m < 4; ++m) {
            const int row = EROW(ai, m); const float rs = rsv[ai][m];
            if (pn < 8) {
                u16* base = (pn < 4 ? Q : K) + (size_t)row * 1024 + (pn & 3) * 256; const float s = pn < 4 ? rs * QS_DSA : rs;
#pragma unroll
                for (int bj = 0; bj < 2; ++bj) *(u32x4*)(base + ECOL(bj)) = pack8(acc[ai][bj][m][0] * s, acc[ai][bj][m][1] * s);
            } else if (pn < 12) {
#pragma unroll
                for (int bj = 0; bj < 2; ++bj)
#pragma unroll
                for (int n = 0; n < 2; ++n)
#pragma unroll
                for (int e = 0; e < 4; ++e) Vt[(size_t)((pn - 8) * 256 + ECOL(bj) + n * 4 + e) * L + row] = f2h(acc[ai][bj][m][n][e] * rs);
            } else if (pn < 14) {
                u16* base = QI + (size_t)row * 512 + (pn - 12) * 256;
#pragma unroll
                for (int bj = 0; bj < 2; ++bj) *(u32x4*)(base + ECOL(bj)) = pack8(acc[ai][bj][m][0] * rs, acc[ai][bj][m][1] * rs);
            } else {
                if (wc == 0) {
                    f32x4 x[2][2]; float s = 0.f;
#pragma unroll
                    for (int bj = 0; bj < 2; ++bj)
#pragma unroll
                    for (int n = 0; n < 2; ++n) { x[bj][n] = acc[ai][bj][m][n] * rs; s += (x[bj][n][0] + x[bj][n][1]) + (x[bj][n][2] + x[bj][n][3]); }
                    s += __shfl_xor(s, 16); s += __shfl_xor(s, 32);
                    const float mean = s * (1.f / 64.f); float v = 0.f;
#pragma unroll
                    for (int bj = 0; bj < 2; ++bj)
#pragma unroll
                    for (int n = 0; n < 2; ++n) { x[bj][n] = x[bj][n] - mean; v += (x[bj][n][0] * x[bj][n][0] + x[bj][n][1] * x[bj][n][1]) + (x[bj][n][2] * x[bj][n][2] + x[bj][n][3] * x[bj][n][3]); }
                    v += __shfl_xor(v, 16); v += __shfl_xor(v, 32);
                    const float r2 = rsqrtf(v * (1.f / 64.f) + EPS);
#pragma unroll
                    for (int bj = 0; bj < 2; ++bj) { const int d0 = bj * 32 + fq * 8;
                        const f32x4 g0 = *(const f32x4*)(kg + d0), g1 = *(const f32x4*)(kg + d0 + 4), b0 = *(const f32x4*)(kb + d0), b1 = *(const f32x4*)(kb + d0 + 4);
                        *(u32x4*)(KI + (size_t)row * 64 + d0) = pack8(x[bj][0] * r2 * g0 + b0, x[bj][1] * r2 * g1 + b1); }
                } else if (wc == 1 && fq == 0) {
                    *(f32x4*)(WI + (size_t)row * 8) = acc[ai][0][m][0] * (rs * WI_SCALE); *(f32x4*)(WI + (size_t)row * 8 + 4) = acc[ai][0][m][1] * (rs * WI_SCALE);
                }
            }
        }
    }
};

struct EpiUp {
    static constexpr int ID = 1; static constexpr bool SP2 = true, ALIGN = true; static constexpr bool PERM = true, AFTER_DRAIN = false;
    u16* H; int ldc; const LAS float* tab;
    __device__ __forceinline__ void operator()(EPI_ARGS) const {
#pragma unroll
        for (int ai = 0; ai < 2; ++ai)
#pragma unroll
        for (int m = 0; m < 4; ++m) { const int row = EROW(ai, m); const float rs = ETAB(tab, ai, m); u16* base = H + (size_t)row * ldc + u.pn * 256;
#pragma unroll
            for (int bj = 0; bj < 2; ++bj) { f32x4 a = acc[ai][bj][m][0] * rs, b = acc[ai][bj][m][1] * rs;
#pragma unroll
                for (int e = 0; e < 4; ++e) { a[e] = fmaxf(a[e], 0.f); a[e] *= a[e]; b[e] = fmaxf(b[e], 0.f); b[e] *= b[e]; }
                *(u32x4*)(base + ECOL(bj)) = pack8(a, b); } }
    }
};

struct EpiScale16 {
    static constexpr int ID = 2; static constexpr bool SP2 = true, ALIGN = true; static constexpr bool PERM = true, AFTER_DRAIN = false;
    u16* O; int ldc; size_t split; const LAS float* tab;
    __device__ __forceinline__ void operator()(EPI_ARGS) const {
        u16* ob = split ? O + (size_t)(u.pn >> 2) * split + (u.pn & 3) * 256 : O + u.pn * 256;
#pragma unroll
        for (int ai = 0; ai < 2; ++ai)
#pragma unroll
        for (int m = 0; m < 4; ++m) { const int row = EROW(ai, m); const float rs = ETAB(tab, ai, m); u16* base = ob + (size_t)row * ldc;
#pragma unroll
            for (int bj = 0; bj < 2; ++bj) *(u32x4*)(base + ECOL(bj)) = pack8(acc[ai][bj][m][0] * rs, acc[ai][bj][m][1] * rs); }
    }
};

struct EpiGlu {
    static constexpr int ID = 3; static constexpr bool SP2 = true, ALIGN = true; static constexpr bool PERM = true, AFTER_DRAIN = false;
    u16* U; const float* bias; const LAS float* tab;
    __device__ __forceinline__ void operator()(EPI_ARGS) const {
        const int col = u.pn * 128 + wc * 32 + fq * 8;
        f32x4 ba[2], bg[2];
#pragma unroll
        for (int n = 0; n < 2; ++n) { ba[n] = *(const f32x4*)(bias + col + 4 * n); bg[n] = *(const f32x4*)(bias + 1024 + col + 4 * n); }
#pragma unroll
        for (int ai = 0; ai < 2; ++ai)
#pragma unroll
        for (int m = 0; m < 4; ++m) { const int row = EROW(ai, m); const float rs = ETAB(tab, ai, m); f32x4 o[2];
#pragma unroll
            for (int n = 0; n < 2; ++n) { const f32x4 a = acc[ai][0][m][n] * rs + ba[n], g = acc[ai][1][m][n] * rs + bg[n];
#pragma unroll
                for (int e = 0; e < 4; ++e) o[n][e] = a[e] * sigmoidf_(g[e]); }
            *(u32x4*)(U + (size_t)row * 1024 + col) = pack8(o[0], o[1]); }
    }
};

struct EpiResid {
    static constexpr int ID = 4; static constexpr bool SP2 = true, ALIGN = true; static constexpr bool PERM = true, AFTER_DRAIN = false;
    const float* hin32; u16* a16; float* part; const float* bias;
    __device__ __forceinline__ void tail(const f32x4& v0, const f32x4& v1, float& ssq, size_t o) const {
        ssq = (v0[0] * v0[0] + v0[1] * v0[1]) + (v0[2] * v0[2] + v0[3] * v0[3]) + (v1[0] * v1[0] + v1[1] * v1[1]) + (v1[2] * v1[2] + v1[3] * v1[3]);
        *(u32x4*)(a16 + o) = pack8(v0, v1); }
    __device__ __forceinline__ void operator()(EPI_ARGS) const {
#pragma unroll
        for (int ai = 0; ai < 2; ++ai) {
            if (hin32) {
                f32x4 rr[4][2][2];
#pragma unroll
                for (int m = 0; m < 4; ++m)
#pragma unroll
                    for (int bj = 0; bj < 2; ++bj) { const size_t o = (size_t)EROW(ai, m) * 1024 + u.pn * 256 + ECOL(bj); rr[m][bj][0] = *(const f32x4*)(hin32 + o); rr[m][bj][1] = *(const f32x4*)(hin32 + o + 4); }
                __builtin_amdgcn_sched_barrier(0);
#pragma unroll
                for (int m = 0; m < 4; ++m) { const int row = EROW(ai, m); float ssq[2];
#pragma unroll
                    for (int bj = 0; bj < 2; ++bj) { const int col = u.pn * 256 + ECOL(bj);
                        f32x4 v0 = acc[ai][bj][m][0] + rr[m][bj][0], v1 = acc[ai][bj][m][1] + rr[m][bj][1];
                        if (bias) { v0 = v0 + *(const f32x4*)(bias + col); v1 = v1 + *(const f32x4*)(bias + col + 4); }
                        tail(v0, v1, ssq[bj], (size_t)row * 1024 + col); }
                    if (part) {
#pragma unroll
                        for (int bj = 0; bj < 2; ++bj) { float s = ssq[bj]; s += __shfl_xor(s, 16); s += __shfl_xor(s, 32); if (fq == 0) part[(size_t)row * 32 + u.pn * 8 + bj * 4 + wc] = s; } } }
            } else {
                u32x4 hw[4][2];
#pragma unroll
                for (int m = 0; m < 4; ++m)
#pragma unroll
                    for (int bj = 0; bj < 2; ++bj) hw[m][bj] = *(const u32x4*)(a16 + (size_t)EROW(ai, m) * 1024 + u.pn * 256 + ECOL(bj));
                __builtin_amdgcn_sched_barrier(0);
#pragma unroll
                for (int m = 0; m < 4; ++m) { const int row = EROW(ai, m); float ssq[2];
#pragma unroll
                    for (int bj = 0; bj < 2; ++bj) { const int col = u.pn * 256 + ECOL(bj);
                        const unsigned w0 = hw[m][bj].x, w1 = hw[m][bj].y, w2 = hw[m][bj].z, w3 = hw[m][bj].w;
                        const h16x2 a = __builtin_bit_cast(h16x2, w0), b = __builtin_bit_cast(h16x2, w1), c = __builtin_bit_cast(h16x2, w2), d = __builtin_bit_cast(h16x2, w3);
                        f32x4 v0 = acc[ai][bj][m][0] + (f32x4){(float)a[0], (float)a[1], (float)b[0], (float)b[1]}, v1 = acc[ai][bj][m][1] + (f32x4){(float)c[0], (float)c[1], (float)d[0], (float)d[1]};
                        if (bias) { v0 = v0 + *(const f32x4*)(bias + col); v1 = v1 + *(const f32x4*)(bias + col + 4); }
                        tail(v0, v1, ssq[bj], (size_t)row * 1024 + col); }
                    if (part) {
#pragma unroll
                        for (int bj = 0; bj < 2; ++bj) { float s = ssq[bj]; s += __shfl_xor(s, 16); s += __shfl_xor(s, 32); if (fq == 0) part[(size_t)row * 32 + u.pn * 8 + bj * 4 + wc] = s; } } }
            }
        }
    }
};

struct EpiMlaIn {
    static constexpr int ID = 5; static constexpr bool SP2 = true, ALIGN = true; static constexpr bool PERM = true, AFTER_DRAIN = false;
    u16* P16; u16* KR; float* part2; const f32x2* rope; const LAS float* tab;
    __device__ __forceinline__ void operator()(EPI_ARGS) const {
#pragma unroll
        for (int ai = 0; ai < 2; ++ai)
#pragma unroll
        for (int m = 0; m < 4; ++m) { const int row = EROW(ai, m); const float rs = ETAB(tab, ai, m);
#pragma unroll
            for (int bj = 0; bj < 2; ++bj) { const int hb = u.pn * 2 + bj; const f32x4 v0 = acc[ai][bj][m][0] * rs, v1 = acc[ai][bj][m][1] * rs;
                if (hb < 5) {
                    *(u32x4*)(P16 + (size_t)row * 640 + hb * 128 + wc * 32 + fq * 8) = pack8(v0, v1);
                    float s = (v0[0] * v0[0] + v0[1] * v0[1]) + (v0[2] * v0[2] + v0[3] * v0[3]) + (v1[0] * v1[0] + v1[1] * v1[1]) + (v1[2] * v1[2] + v1[3] * v1[3]);
                    s += __shfl_xor(s, 16); s += __shfl_xor(s, 32);
                    if (fq == 0) part2[(size_t)row * 32 + hb * 4 + wc] = s;
                } else if (hb == 5 && wc == 0) {
                    const f32x2* rp = rope + (size_t)row * 16 + 4 * fq;
                    const f32x2 c0 = rp[0], c1 = rp[1], c2 = rp[2], c3 = rp[3];
                    f32x4 o0, o1;
                    o0[0] = v0[0] * c0.x - v0[1] * c0.y; o0[1] = v0[1] * c0.x + v0[0] * c0.y; o0[2] = v0[2] * c1.x - v0[3] * c1.y; o0[3] = v0[3] * c1.x + v0[2] * c1.y;
                    o1[0] = v1[0] * c2.x - v1[1] * c2.y; o1[1] = v1[1] * c2.x + v1[0] * c2.y; o1[2] = v1[2] * c3.x - v1[3] * c3.y; o1[3] = v1[3] * c3.x + v1[2] * c3.y;
                    *(u32x4*)(KR + (size_t)row * 32 + fq * 8) = pack8(o0, o1);
                } }
        }
    }
};

struct EpiMlaUq {
    static constexpr int ID = 6; static constexpr bool SP2 = true, ALIGN = true; static constexpr bool PERM = true, AFTER_DRAIN = false;
    u16* QM; const f32x2* rope; const LAS float* tab;
    __device__ __forceinline__ void operator()(EPI_ARGS) const {
        const unsigned cg0 = u.pn * 256 + ECOL(0), cg1 = u.pn * 256 + ECOL(1); const int d00 = (int)(cg0 % 96u), d01 = (int)(cg1 % 96u);
#pragma unroll
        for (int ai = 0; ai < 2; ++ai) {
            f32x2 rp[4][2][4];
#pragma unroll
            for (int m = 0; m < 4; ++m) { const unsigned row = EROW(ai, m);
#pragma unroll
                for (int bj = 0; bj < 2; ++bj) { const int d0 = bj ? d01 : d00; if (d0 >= 64) { const f32x2* p = rope + (row * 16u + (unsigned)((d0 - 64) >> 1)); rp[m][bj][0] = p[0]; rp[m][bj][1] = p[1]; rp[m][bj][2] = p[2]; rp[m][bj][3] = p[3]; } } }
            __builtin_amdgcn_sched_barrier(0);
#pragma unroll
            for (int m = 0; m < 4; ++m) { const unsigned row = EROW(ai, m); const float rs = ETAB(tab, ai, m) * QS_MLA;
#pragma unroll
                for (int bj = 0; bj < 2; ++bj) { const unsigned cg = bj ? cg1 : cg0; const int d0 = bj ? d01 : d00; f32x4 v0 = acc[ai][bj][m][0] * rs, v1 = acc[ai][bj][m][1] * rs;
                    if (d0 >= 64) {
                        { const f32x2 c0 = rp[m][bj][0], c1 = rp[m][bj][1]; const f32x4 t = v0; v0[0] = t[0] * c0.x - t[1] * c0.y; v0[1] = t[1] * c0.x + t[0] * c0.y; v0[2] = t[2] * c1.x - t[3] * c1.y; v0[3] = t[3] * c1.x + t[2] * c1.y; }
                        { const f32x2 c2 = rp[m][bj][2], c3 = rp[m][bj][3]; const f32x4 t = v1; v1[0] = t[0] * c2.x - t[1] * c2.y; v1[1] = t[1] * c2.x + t[0] * c2.y; v1[2] = t[2] * c3.x - t[3] * c3.y; v1[3] = t[3] * c3.x + t[2] * c3.y; } }
                    *(u32x4*)((char*)QM + (size_t)((row * 1536u + cg) * 2u)) = pack8(v0, v1); }
            }
        }
    }
};

struct EpiMlaUkv {
    static constexpr int ID = 7; static constexpr bool SP2 = true, ALIGN = true; static constexpr bool PERM = true, AFTER_DRAIN = false;
    u16* KN; u16* Vt; const LAS float* tab;
    __device__ __forceinline__ void operator()(EPI_ARGS) const {
#pragma unroll
        for (int ai = 0; ai < 2; ++ai)
#pragma unroll
        for (int m = 0; m < 4; ++m) { const unsigned row = EROW(ai, m); const float rs = ETAB(tab, ai, m);
#pragma unroll
            for (int bj = 0; bj < 2; ++bj) { const unsigned head = u.pn * 2 + bj;
                if (wc < 2) *(u32x4*)((char*)KN + (size_t)((row * 1024u + head * 64u + wc * 32 + fq * 8) * 2u)) = pack8(acc[ai][bj][m][0] * rs, acc[ai][bj][m][1] * rs);
                else { unsigned off = ((head * 64u + (wc - 2) * 32 + fq * 8) * (unsigned)L + row) * 2u;
#pragma unroll
                    for (int n = 0; n < 2; ++n)
#pragma unroll
                    for (int e = 0; e < 4; ++e) { *(u16*)((char*)Vt + (size_t)off) = f2h(acc[ai][bj][m][n][e] * rs); off += (unsigned)L * 2u; } } }
            asm volatile("" ::: "memory");
        }
    }
};

template <class Sched> __device__ __forceinline__ void build_tab(LAS float* tab, const Sched& S, const float* part, int g0, int g1, float inv_n) {
    Unit u;
    for (int i = 0; i < 8 && S.next(i, u); ++i)
        for (int r = opaque_tid(); r < 256; r += NTHR) { const float* p = part + (size_t)(u.pm * 256 + r) * 32; float s = 0.f; for (int g = g0; g < g1; ++g) s += p[g]; tab[i * 256 + r] = rsqrtf(s * inv_n + EPS); }
    __syncthreads();
}

__device__ const float INV_FREQ[16] = {1.0f, 0.5623413324356079f, 0.3162277638912201f, 0.17782793939113617f, 0.10000000149011612f, 0.05623413249850273f, 0.03162277489900589f, 0.017782794311642647f,
    0.009999999776482582f, 0.005623413249850273f, 0.003162277629598975f, 0.0017782794311642647f, 0.0010000000474974513f, 0.000562341301701963f, 0.0003162277571391314f, 0.00017782794020604342f};

template <class Map> __device__ __forceinline__ void tr_item(const float* W, int K, int N, const float* gain, u16* WT, const Map& map, LAS float* scr, int item, int lane) {
    const int nblk = (N + 31) / 32, kb = item / nblk, nb = item % nblk, k0 = 64 * kb, n0 = 32 * nb;
    float wv_[32];
#pragma unroll
    for (int i = 0; i < 32; ++i) { const int kk = 2 * i + (lane >> 5), n = n0 + (lane & 31); wv_[i] = (n < N) ? W[(size_t)(k0 + kk) * N + n] : 0.f; }
#pragma unroll
    for (int i = 0; i < 32; ++i) { const int kk = 2 * i + (lane >> 5); float v = wv_[i]; if (gain) v *= gain[k0 + kk]; scr[kk * 33 + (lane & 31)] = v; }
    asm volatile("s_waitcnt lgkmcnt(0)" ::: "memory");
    const int c = lane & 7;
#pragma unroll
    for (int j = 0; j < 4; ++j) { const int nl = (lane >> 3) + 8 * j, n = n0 + nl; const int dr = (n < N) ? map(n) : -1; const LAS float* s = scr + (8 * c) * 33 + nl;
        if (dr >= 0) { u32x4 o; o.x = pk16(s[0 * 33], s[1 * 33]); o.y = pk16(s[2 * 33], s[3 * 33]); o.z = pk16(s[4 * 33], s[5 * 33]); o.w = pk16(s[6 * 33], s[7 * 33]);
            *(u32x4*)(WT + (size_t)dr * K + k0 + 8 * c) = o; } }
    asm volatile("s_waitcnt lgkmcnt(0)" ::: "memory");
}
template <class Map> __device__ __forceinline__ void conv_mat(int& base, int gw, int NGW, const float* W, int K, int N, const float* gain, u16* WT, const Map& map, LAS float* scr, int lane) {
    const int nitems = (K / 64) * ((N + 31) / 32);
    int first = (gw - base) % NGW; if (first < 0) first += NGW;
    for (int it = first; it < nitems; it += NGW) tr_item(W, K, N, gain, WT, map, scr, it, lane);
    base += nitems;
}
__device__ __forceinline__ void zero_rows(u16* WT, int K, int r0, int r1, int gw, int NGW, int lane) {
    const int per_row = K / 8;
    const long total = (long)(r1 - r0) * per_row;
    for (long c = (long)gw * 64 + lane; c < total; c += (long)NGW * 64) *(u32x4*)(WT + (size_t)r0 * K + c * 8) = (u32x4){0u, 0u, 0u, 0u};
}
struct MapId { int off; __device__ __forceinline__ int operator()(int n) const { return n + off; } };
struct MapDsaIn { __device__ __forceinline__ int operator()(int n) const { if (n < 3584) return n; if (n < 3648) { const int d = n - 3584; return d < 32 ? 3584 + d : 3584 + 128 + (d - 32); } return 3584 + 32 + (n - 3648); } };
struct MapPw1 { __device__ __forceinline__ int operator()(int n) const { return n < 1024 ? 256 * (n >> 7) + (n & 127) : 256 * ((n - 1024) >> 7) + 128 + (n & 127); } };
struct MapMlaIn { __device__ __forceinline__ int operator()(int n) const { if (n < 640) return n; const int d = n - 640; return 640 + 2 * (d & 15) + (d >> 4); } };
struct MapMlaUq { __device__ __forceinline__ int operator()(int n) const { const int h = n / 96, d = n % 96; if (d < 64) return n; const int r = d - 64; return h * 96 + 64 + 2 * (r & 15) + (r >> 4); } };
struct MapGdnQkv { __device__ __forceinline__ int operator()(int n) const { return n < 3072 ? n : -1; } };
struct MapGdnGate { __device__ __forceinline__ int operator()(int n) const { return (n >= 3072 && n < 4096) ? n - 3072 : -1; } };

struct Args { const float* in[30]; float* out; uchar* ws; };
typedef const __attribute__((address_space(4))) Args* KArgs;
struct Ptrs {
    KArgs ka; float* out; uchar* ws;
    __device__ __forceinline__ const float* in(int k) const { KArgs p = ka; asm volatile("" : "+s"(p)); return p->in[k]; }
};

template <int LAYER> __device__ __forceinline__ void convert_layer(const Ptrs& P, LAS uchar* lds, int vcu, int G) {
    const int tid_ = opaque_tid(), lane = tid_ & 63, wave = __builtin_amdgcn_readfirstlane(tid_ >> 6);
    LAS float* scr = (LAS float*)(lds + wave * 16384);
    const int gw = vcu * NWAVES + wave, NGW = G * NWAVES; int base = 0;
    uchar* ws = P.ws;
    const float* gmix = P.in(1) + LAYER * 1024; const float* gmlp = P.in(2) + LAYER * 1024;
    conv_mat(base, gw, NGW, P.in(4) + (size_t)LAYER * 1024 * 4096, 1024, 4096, gmlp, (u16*)(ws + WS_W1), MapId{0}, scr, lane);
    conv_mat(base, gw, NGW, P.in(5) + (size_t)LAYER * 4096 * 1024, 4096, 1024, nullptr, (u16*)(ws + WS_W2), MapId{0}, scr, lane);
    if (LAYER == 0) {
        conv_mat(base, gw, NGW, P.in(6), 1024, 3656, gmix, (u16*)(ws + WS_WIN), MapDsaIn{}, scr, lane);
        if (SKIPMIX & 1) zero_rows((u16*)(ws + WS_WOUT), 1024, 0, 1024, gw, NGW, lane); else conv_mat(base, gw, NGW, P.in(9), 1024, 1024, nullptr, (u16*)(ws + WS_WOUT), MapId{0}, scr, lane);
        zero_rows((u16*)(ws + WS_WIN), 1024, 3624, 3712, gw, NGW, lane); zero_rows((u16*)(ws + WS_WIN), 1024, 3744, 3840, gw, NGW, lane);
    } else if (LAYER == 1) {
        conv_mat(base, gw, NGW, P.in(10), 1024, 2048, gmix, (u16*)(ws + WS_WIN), MapPw1{}, scr, lane);
        conv_mat(base, gw, NGW, P.in(16), 1024, 1024, nullptr, (u16*)(ws + WS_WOUT), MapId{0}, scr, lane);
    } else if (LAYER == 2) {
        conv_mat(base, gw, NGW, P.in(18), 1024, 672, gmix, (u16*)(ws + WS_WIN), MapMlaIn{}, scr, lane);
        conv_mat(base, gw, NGW, P.in(20), 384, 1536, P.in(19), (u16*)(ws + WS_WB), MapMlaUq{}, scr, lane);
        conv_mat(base, gw, NGW, P.in(22), 256, 2048, P.in(21), (u16*)(ws + WS_WC), MapId{0}, scr, lane);
        conv_mat(base, gw, NGW, P.in(23), 1024, 1024, nullptr, (u16*)(ws + WS_WOUT), MapId{0}, scr, lane);
        zero_rows((u16*)(ws + WS_WIN), 1024, 672, 768, gw, NGW, lane);
    } else {
        conv_mat(base, gw, NGW, P.in(24), 1024, 4112, gmix, (u16*)(ws + WS_WIN), MapGdnQkv{}, scr, lane);
        conv_mat(base, gw, NGW, P.in(24), 1024, 4112, gmix, (u16*)(ws + WS_WD), MapGdnGate{}, scr, lane);
        conv_mat(base, gw, NGW, P.in(29), 1024, 1024, nullptr, (u16*)(ws + WS_WOUT), MapId{0}, scr, lane);
    }
}

__device__ __forceinline__ void prologue_x(const Ptrs& P, int vcu, int G) {
    const int tid_ = opaque_tid(), lane = tid_ & 63, wave = __builtin_amdgcn_readfirstlane(tid_ >> 6);
    const int gw = vcu * NWAVES + wave, NGW = G * NWAVES;
    const float* x = P.in(0); u16* a16 = (u16*)(P.ws + WS_A16); float* rstdx = (float*)(P.ws + WS_RSTDX);
    f32x4 vn[4];
#pragma unroll
    for (int j = 0; j < 4; ++j) vn[j] = ((const f32x4*)(x + (size_t)(gw < L ? gw : 0) * D) + lane)[64 * j];
    for (int m = gw; m < L; m += NGW) {
        f32x4 v[4]; float s = 0.f;
#pragma unroll
        for (int j = 0; j < 4; ++j) v[j] = vn[j];
        { const int mn = (m + NGW < L) ? m + NGW : m; const f32x4* xn_ = (const f32x4*)(x + (size_t)mn * D) + lane;
#pragma unroll
          for (int j = 0; j < 4; ++j) vn[j] = xn_[64 * j]; }
#pragma unroll
        for (int j = 0; j < 4; ++j) s += (v[j][0] * v[j][0] + v[j][1] * v[j][1]) + (v[j][2] * v[j][2] + v[j][3] * v[j][3]);
        s = wave_sum(s);
        if (lane == 0) rstdx[m] = rsqrtf(s * (1.f / D) + EPS);
        u32x2* o = (u32x2*)(a16 + (size_t)m * D) + lane;
#pragma unroll
        for (int j = 0; j < 4; ++j) { u32x2 w; w.x = pk16(v[j][0], v[j][1]); w.y = pk16(v[j][2], v[j][3]); o[64 * j] = w; }
    }
    f32x2* rope = (f32x2*)(P.ws + WS_ROPE);
    for (int i = gw * 64 + lane; i < L * 16; i += NGW * 64) {
        const int t = i >> 4, k = i & 15; const float ang = (float)t * INV_FREQ[k];
        const double rev = (double)ang * 0.15915494309189535; const float fr = (float)(rev - floor(rev));
        f32x2 cs; cs.x = __builtin_amdgcn_cosf(fr); cs.y = __builtin_amdgcn_sinf(fr); rope[i] = cs;
    }
}

template <int DQK, int DV, bool BITS>
__device__ __forceinline__ void attn_unit(LAS uchar* lds, const u16* __restrict__ Qh, int ldq, const u16* __restrict__ Kh, int ldk, const u16* __restrict__ Kr, int ldkr,
                                          const u16* __restrict__ Vth, const unsigned* __restrict__ bits, u16* Oh, int ldo, int qb) {
    constexpr int KPB = (DQK + 8) * 2, VPB = 144, KBYTES = 64 * KPB, VBYTES = DV * VPB, BUF = KBYTES + VBYTES;
    constexpr int NS = DQK / 16, NDB = DV / 32, KCH = DQK / 8, NKC = 64 * KCH, NVC = DV * 8, KIT = (NKC + 511) / 512, VIT = (NVC + 511) / 512;
    const int tid = opaque_tid(), lane = tid & 63, wid = __builtin_amdgcn_readfirstlane(tid >> 6), r32 = lane & 31, hi = lane >> 5;
    constexpr int NSTG = (DV == 64) ? 5 : 3, DST = (DV == 64) ? 3 : 2;
    LAS float* wsc = (LAS float*)(lds + NSTG * BUF) + wid * 32;
    const int q0 = qb * 256, q0w = q0 + wid * 32, tq = q0w + r32, NT = (q0 + 256) / 64;
    s16x8 qf[NS];
#pragma unroll
    for (int s = 0; s < NS; ++s) qf[s] = *(const s16x8*)(Qh + (size_t)tq * ldq + 16 * s + 8 * hi);
    f32x16 o[NDB];
#pragma unroll
    for (int db = 0; db < NDB; ++db)
#pragma unroll
        for (int r = 0; r < 16; ++r) o[db][r] = 0.f;
    float mrun = -1e30f, lrun = 0.f;
    u32x4 kst[KIT], vst[VIT];
#define ATT_LOAD(t) do { _Pragma("unroll") for (int i_ = 0; i_ < KIT; ++i_) { const int c_ = tid + 512 * i_; if (c_ < NKC) { const int row_ = c_ / KCH, cc_ = c_ % KCH; \
            const u16* src_ = (DQK == 96 && cc_ >= 8) ? Kr + (size_t)((t) * 64 + row_) * ldkr + (cc_ - 8) * 8 : Kh + (size_t)((t) * 64 + row_) * ldk + cc_ * 8; kst[i_] = *(const u32x4*)src_; } } \
        _Pragma("unroll") for (int i_ = 0; i_ < VIT; ++i_) { const int c_ = tid + 512 * i_; if (c_ < NVC) { const int d_ = c_ >> 3, cc_ = c_ & 7; vst[i_] = *(const u32x4*)(Vth + (size_t)d_ * L + (t) * 64 + cc_ * 8); } } } while (0)
#define ATT_STORE(b) do { _Pragma("unroll") for (int i_ = 0; i_ < KIT; ++i_) { const int c_ = tid + 512 * i_; if (c_ < NKC) { const int row_ = c_ / KCH, cc_ = c_ % KCH; *(LAS u32x4*)(lds + (b) * BUF + row_ * KPB + cc_ * 16) = kst[i_]; } } \
        _Pragma("unroll") for (int i_ = 0; i_ < VIT; ++i_) { const int c_ = tid + 512 * i_; if (c_ < NVC) { const int d_ = c_ >> 3, cc_ = c_ & 7; LAS uchar* p_ = lds + (b) * BUF + KBYTES + d_ * VPB + (cc_ >> 1) * 32 + (cc_ & 1) * 8; \
            *(LAS u32x2*)p_ = (u32x2){vst[i_].x, vst[i_].y}; *(LAS u32x2*)(p_ + 16) = (u32x2){vst[i_].z, vst[i_].w}; } } } while (0)
#define ATT_QK(SA, SB, st_) do { const LAS uchar* Kl_ = lds + (st_) * BUF; _Pragma("unroll") for (int r = 0; r < 16; ++r) { SA[r] = 0.f; SB[r] = 0.f; } \
        _Pragma("unroll") for (int s = 0; s < NS; ++s) { const s16x8 a0_ = *(const LAS s16x8*)(Kl_ + r32 * KPB + 32 * s + 16 * hi), a1_ = *(const LAS s16x8*)(Kl_ + (32 + r32) * KPB + 32 * s + 16 * hi); \
            SA = mfma32(a0_, qf[s], SA); SB = mfma32(a1_, qf[s], SB); } } while (0)
    ATT_LOAD(0); ATT_STORE(0); if (NT > 1) { ATT_LOAD(1); ATT_STORE(1); } if (DST == 3) { ATT_LOAD(2); ATT_STORE(2); } __syncthreads();
    f32x16 S0, S1, T0, T1;
    unsigned bw0 = 0u, bw1 = 0u; if (BITS) { bw0 = bits[tq]; bw1 = bits[(size_t)L + tq]; }
    ATT_QK(S0, S1, 0);
    if (NT > DST) ATT_LOAD(DST);
    int st_cur = 0, st_nxt = 1, st_fill = DST;
    constexpr int PREK = (DQK == 96) ? 2 * NS : 4, PREV = (DV == 64) ? 4 * NDB : 0;
#define ATT_TILE(SA_, SB_, TA_, TB_, t, BAR_) do { \
        const int kv0 = t * 64; \
        if (t + DST < NT) { ATT_STORE(st_fill); if (t + DST + 1 < NT) ATT_LOAD(t + DST + 1); } \
        const LAS uchar* Vl = lds + st_cur * BUF + KBYTES; const LAS uchar* Kn = lds + st_nxt * BUF; \
        s16x8 kf[PREK > 0 ? PREK : 1]; \
_Pragma("unroll") \
        for (int i_ = 0; i_ < PREK; ++i_) kf[i_] = *(const LAS s16x8*)(Kn + ((i_ & 1) * 32 + r32) * KPB + 32 * (i_ >> 1) + 16 * hi); \
        __builtin_amdgcn_sched_barrier(0); \
        if (BITS) { \
            const unsigned w0 = bw0, w1 = bw1; { const int tn_ = (t + 1 < NT) ? t + 1 : t; bw0 = bits[(size_t)(2 * tn_) * L + tq]; bw1 = bits[(size_t)(2 * tn_ + 1) * L + tq]; } \
            const unsigned wa_ = w0 >> (4 * hi), wb_ = w1 >> (4 * hi); \
_Pragma("unroll") \
            for (int r = 0; r < 16; ++r) { const int c_ = (r & 3) + 8 * (r >> 2); \
                const unsigned ta_ = (unsigned)__builtin_amdgcn_sbfe((int)wa_, c_, 1), tb_ = (unsigned)__builtin_amdgcn_sbfe((int)wb_, c_, 1);     \
                SA_[r] = __uint_as_float((__float_as_uint(SA_[r]) & ta_) | (~ta_ & 0xff800000u)); SB_[r] = __uint_as_float((__float_as_uint(SB_[r]) & tb_) | (~tb_ & 0xff800000u)); } \
        } \
        if (kv0 + 63 > q0w) { \
_Pragma("unroll") \
            for (int r = 0; r < 16; ++r) { const int key = kv0 + (r & 3) + 8 * (r >> 2) + 4 * hi; if (key > tq) SA_[r] = NEG_INF; if (key + 32 > tq) SB_[r] = NEG_INF; } \
        } \
        float rm = max3f_(SA_[0], SB_[0], SA_[1]), rm2_ = max3f_(SB_[1], SA_[2], SB_[2]); \
_Pragma("unroll") \
        for (int r = 3; r < 15; r += 2) { rm = max3f_(rm, SA_[r], SB_[r]); rm2_ = max3f_(rm2_, SA_[r + 1], SB_[r + 1]); } \
        rm = max3f_(rm, SA_[15], SB_[15]); rm = fmaxf(rm, rm2_); \
        { const unsigned rb_ = __float_as_uint(rm); const auto sw_ = __builtin_amdgcn_permlane32_swap(rb_, rb_, false, false); rm = fmaxf(__uint_as_float(sw_[0]), __uint_as_float(sw_[1])); }        \
        if (__any(rm > mrun + 8.f)) { \
            const float mn = fmaxf(mrun, rm), al = __builtin_amdgcn_exp2f(mrun - mn); lrun *= al; mrun = mn; \
            if (hi == 0) wsc[r32] = al; \
            asm volatile("s_waitcnt lgkmcnt(0)" ::: "memory"); \
_Pragma("unroll") \
            for (int g = 0; g < 4; ++g) { const f32x4 a4 = *(const LAS f32x4*)(wsc + 8 * g + 4 * hi); \
_Pragma("unroll") \
                for (int db = 0; db < NDB; ++db) { o[db][4 * g] *= a4[0]; o[db][4 * g + 1] *= a4[1]; o[db][4 * g + 2] *= a4[2]; o[db][4 * g + 3] *= a4[3]; } } \
            asm volatile("s_waitcnt lgkmcnt(0)" ::: "memory"); \
        } \
        s16x8 vf[PREV > 0 ? PREV : 1]; \
_Pragma("unroll") \
        for (int i_ = 0; i_ < PREV; ++i_) vf[i_] = *(const LAS s16x8*)(Vl + (32 * (i_ >> 2) + r32) * VPB + 32 * (i_ & 3) + 16 * hi); \
        __builtin_amdgcn_sched_barrier(0); \
_Pragma("unroll") \
        for (int r = 0; r < 16; ++r) { TA_[r] = 0.f; TB_[r] = 0.f; } \
_Pragma("unroll") \
        for (int s_ = 0; s_ < NS; ++s_) { \
            const s16x8 a0_ = (2 * s_ < PREK) ? kf[2 * s_] : *(const LAS s16x8*)(Kn + r32 * KPB + 32 * s_ + 16 * hi); \
            const s16x8 a1_ = (2 * s_ + 1 < PREK) ? kf[2 * s_ + 1] : *(const LAS s16x8*)(Kn + (32 + r32) * KPB + 32 * s_ + 16 * hi); \
            TA_ = mfma32(a0_, qf[s_], TA_); TB_ = mfma32(a1_, qf[s_], TB_); } \
        f32x2 ls2 = {0.f, 0.f}; const f32x2 m2 = {mrun, mrun};        \
_Pragma("unroll") \
        for (int r = 0; r < 16; r += 2) { f32x2 da = (f32x2){SA_[r], SA_[r + 1]} - m2, db = (f32x2){SB_[r], SB_[r + 1]} - m2; \
            da[0] = __builtin_amdgcn_exp2f(da[0]); da[1] = __builtin_amdgcn_exp2f(da[1]); db[0] = __builtin_amdgcn_exp2f(db[0]); db[1] = __builtin_amdgcn_exp2f(db[1]); \
            SA_[r] = da[0]; SA_[r + 1] = da[1]; SB_[r] = db[0]; SB_[r + 1] = db[1]; ls2 += da; ls2 += db; } \
        lrun += ls2[0] + ls2[1]; \
        s16x8 pf[4]; \
        { u32x4 w; \
          w.x = pk16(SA_[0], SA_[1]); w.y = pk16(SA_[2], SA_[3]); w.z = pk16(SA_[4], SA_[5]); w.w = pk16(SA_[6], SA_[7]); pf[0] = __builtin_bit_cast(s16x8, w); \
          w.x = pk16(SA_[8], SA_[9]); w.y = pk16(SA_[10], SA_[11]); w.z = pk16(SA_[12], SA_[13]); w.w = pk16(SA_[14], SA_[15]); pf[1] = __builtin_bit_cast(s16x8, w); \
          w.x = pk16(SB_[0], SB_[1]); w.y = pk16(SB_[2], SB_[3]); w.z = pk16(SB_[4], SB_[5]); w.w = pk16(SB_[6], SB_[7]); pf[2] = __builtin_bit_cast(s16x8, w); \
          w.x = pk16(SB_[8], SB_[9]); w.y = pk16(SB_[10], SB_[11]); w.z = pk16(SB_[12], SB_[13]); w.w = pk16(SB_[14], SB_[15]); pf[3] = __builtin_bit_cast(s16x8, w); } \
_Pragma("unroll") \
        for (int i_ = 0; i_ < 2 * NS; ++i_) { __builtin_amdgcn_sched_group_barrier(0x008, 1, 0); \
            __builtin_amdgcn_sched_group_barrier(0x002, (64 + 2 * NS - 1) / (2 * NS), 0); __builtin_amdgcn_sched_group_barrier(0x400, (32 + 2 * NS - 1) / (2 * NS), 0); \
            if (i_ < 2 * NS - PREK) __builtin_amdgcn_sched_group_barrier(0x100, 1, 0); }        \
        __builtin_amdgcn_sched_barrier(0); \
_Pragma("unroll") \
        for (int db = 0; db < NDB; ++db) \
_Pragma("unroll") \
            for (int sp = 0; sp < 4; ++sp) { const s16x8 v_ = (db * 4 + sp < PREV) ? vf[db * 4 + sp] : *(const LAS s16x8*)(Vl + (32 * db + r32) * VPB + 32 * sp + 16 * hi); \
                o[db] = mfma32(pf[sp], v_, o[db]); } \
        if (4 * NDB - PREV > 3) { __builtin_amdgcn_sched_group_barrier(0x100, 3, 0);        \
_Pragma("unroll") \
            for (int i_ = 0; i_ < 4 * NDB; ++i_) { __builtin_amdgcn_sched_group_barrier(0x008, 1, 0); if (i_ < 4 * NDB - PREV - 3) __builtin_amdgcn_sched_group_barrier(0x100, 1, 0); } } \
        if (BAR_) __syncthreads(); \
        st_cur = st_nxt; st_nxt = (st_nxt + 1 == NSTG) ? 0 : st_nxt + 1; st_fill = (st_fill + 1 == NSTG) ? 0 : st_fill + 1; \
    } while (0)
    if (DV == 64) {
        for (int t2_ = 0; t2_ < NT; t2_ += 2) { ATT_TILE(S0, S1, T0, T1, t2_, 0); ATT_TILE(T0, T1, S0, S1, (t2_ + 1), 1); }
    } else {
        for (int t_ = 0; t_ < NT; ++t_) { ATT_TILE(S0, S1, T0, T1, t_, 1); S0 = T0; S1 = T1; }
    }
#undef ATT_TILE

#undef ATT_QK
#undef ATT_LOAD
#undef ATT_STORE
    lrun += __shfl_xor(lrun, 32);
    if (hi == 0) wsc[r32] = 1.f / lrun;
    asm volatile("s_waitcnt lgkmcnt(0)" ::: "memory");
#pragma unroll
    for (int g = 0; g < 4; ++g) { const f32x4 a4 = *(const LAS f32x4*)(wsc + 8 * g + 4 * hi);
#pragma unroll
        for (int e = 0; e < 4; ++e) { const int r = 4 * g + e; const int qrow = q0w + 8 * g + 4 * hi + e;
#pragma unroll
            for (int db = 0; db < NDB; ++db) Oh[(size_t)qrow * ldo + 32 * db + r32] = f2h(o[db][r] * a4[e]); } }
    asm volatile("s_waitcnt lgkmcnt(0)" ::: "memory");
    __syncthreads();
}

__device__ __forceinline__ unsigned okey(float f) { const unsigned u = __float_as_uint(f); return (u & 0x80000000u) ? ~u : (u | 0x80000000u); }
#define LDS_FENCE() asm volatile("s_waitcnt lgkmcnt(0)" ::: "memory")

template <int NE, int TOP> __device__ __forceinline__ unsigned radix_kth(const unsigned (&ek)[NE], unsigned vmask, int m, LAS unsigned* hist, int lane, int& m_rem) {
    unsigned prefix = 0; int mm = m;
#pragma unroll
    for (int sh = TOP; sh >= 0; sh -= 8) {
        hist[lane] = 0u; hist[lane + 64] = 0u; hist[lane + 128] = 0u; hist[lane + 192] = 0u;
        LDS_FENCE();
#pragma unroll
        for (int e = 0; e < NE; ++e) { const bool ok = ((vmask >> e) & 1u) && (sh == TOP || (ek[e] >> ((sh + 8) & 31)) == (prefix >> ((sh + 8) & 31)));
            if (ok) __hip_atomic_fetch_add(&hist[(ek[e] >> sh) & 255u], 1u, __ATOMIC_RELAXED, __HIP_MEMORY_SCOPE_WORKGROUP); }
        LDS_FENCE();
        const unsigned c0 = hist[255 - 4 * lane], c1 = hist[254 - 4 * lane], c2 = hist[253 - 4 * lane], c3 = hist[252 - 4 * lane];
        LDS_FENCE();
        const int T = (int)(c0 + c1 + c2 + c3); int I = T;
#pragma unroll
        for (int o = 1; o < 64; o <<= 1) { const int t = __shfl_up(I, o); if (lane >= o) I += t; }
        const int E = I - T; const bool mine = (E < mm) && (mm <= I);
        int dsel = 0, mnew = 0;
        if (mine) { int r = E;
            if (mm <= r + (int)c0) { dsel = 255 - 4 * lane; mnew = mm - r; }
            else { r += (int)c0; if (mm <= r + (int)c1) { dsel = 254 - 4 * lane; mnew = mm - r; }
                else { r += (int)c1; if (mm <= r + (int)c2) { dsel = 253 - 4 * lane; mnew = mm - r; } else { r += (int)c2; dsel = 252 - 4 * lane; mnew = mm - r; } } } }
        const unsigned long long b = __ballot(mine); const int src = b ? (__ffsll((long long)b) - 1) : 0;
        dsel = __shfl(dsel, src); mnew = __shfl(mnew, src);
        prefix |= (unsigned)dsel << sh; mm = mnew;
    }
    m_rem = mm; return prefix;
}

template <int NE, int NBITS> __device__ __forceinline__ unsigned kth_bisect(const unsigned (&ek)[NE], int m, int& m_rem) {
    unsigned v = 0u;
#pragma unroll 1
    for (int bit = NBITS - 1; bit >= 0; --bit) { const unsigned cand = v | (1u << bit); int cnt = 0;
#pragma unroll
        for (int e = 0; e < NE; ++e) cnt += __popcll(__ballot(ek[e] >= cand));
        if (cnt >= m) v = cand; }
    int gt = 0;
#pragma unroll
    for (int e = 0; e < NE; ++e) gt += __popcll(__ballot(ek[e] > v));
    m_rem = m - gt; return v;
}

__device__ __forceinline__ void dsa_indexer(const Ptrs& P, LAS uchar* lds, int vcu, int G) {
    const int tid = opaque_tid(), lane = tid & 63, wid = __builtin_amdgcn_readfirstlane(tid >> 6), r32 = lane & 31, hi = lane >> 5;
    const u16* QI = (const u16*)(P.ws + WS_DQI); const u16* KI = (const u16*)(P.ws + WS_DKI); const float* WI = (const float*)(P.ws + WS_DWI);
    unsigned* bitsg = (unsigned*)(P.ws + WS_DBITS);
    float* listf = (float*)(P.ws + WS_A16 + (size_t)vcu * 131072); u16* lists = (u16*)listf;
    float* candS = (float*)P.out + (size_t)vcu * 32768; u16* candI = (u16*)((uchar*)P.out + 32 * MiB) + (size_t)vcu * 32768;
    LAS unsigned* lbits = (LAS unsigned*)lds;
    LAS unsigned* hist = (LAS unsigned*)(lds + 65536) + wid * 256;
    LAS unsigned* cnt = (LAS unsigned*)(lds + 65536 + 8192);
    LAS unsigned* tau = cnt + 32;
    LAS uchar* qlds = lds + 65536 + 8192 + 256;
    LAS float* wlds = (LAS float*)(qlds + 32 * 1168);
    constexpr int CAP = 1024, MSAMP = 64;
    for (int blk0 = vcu; blk0 < 256; blk0 += G) for (int side = 0; side < 2; ++side) {
        const int blk = side ? 511 - blk0 : blk0;
        const int t0 = 32 * blk, NT = blk + 1, tq = t0 + r32;
        const int tid2 = opaque_tid();
        for (int c = tid2; c < 2048; c += NTHR) { const int row = c >> 6, cc = c & 63; *(LAS u32x4*)(qlds + row * 1168 + cc * 16) = *(const u32x4*)(QI + (size_t)(t0 + row) * 512 + cc * 8); }
        if (tid2 < 64) *(LAS f32x4*)(wlds + tid2 * 4) = *(const f32x4*)(WI + (size_t)t0 * 8 + tid2 * 4) * 0.5f;
        const LAS uchar* qrow = qlds + r32 * 1168 + 16 * hi; const LAS float* wrow = wlds + r32 * 8;
#define IDX_LOADK(keyrow) do { _Pragma("unroll") for (int s = 0; s < 4; ++s) afn[s] = *(const s16x8*)(KI + (size_t)(keyrow) * 64 + 16 * s + 8 * hi); } while (0)
#define IDX_RD(Q, hp_) do { const LAS uchar* qp_ = qrow_ + (hp_) * 256; _Pragma("unroll") for (int s = 0; s < 4; ++s) { Q[2 * s] = *(const LAS s16x8*)(qp_ + s * 32); Q[2 * s + 1] = *(const LAS s16x8*)(qp_ + 128 + s * 32); } } while (0)
#define IDX_MM(A_, B_, Q) do { _Pragma("unroll") for (int r = 0; r < 16; ++r) { A_[r] = 0.f; B_[r] = 0.f; } _Pragma("unroll") for (int s = 0; s < 4; ++s) { A_ = mfma32(af[s], Q[2 * s], A_); B_ = mfma32(af[s], Q[2 * s + 1], B_); } } while (0)
#define IDX_VA(A_, B_, hp_) do { const f32x2 w2_ = *(const LAS f32x2*)(wrow + 2 * (hp_)); _Pragma("unroll") for (int r = 0; r < 16; ++r) { sc[r] = __builtin_fmaf(w2_.x, __builtin_fabsf(A_[r]), sc[r]); sc[r] = __builtin_fmaf(w2_.y, __builtin_fabsf(B_[r]), sc[r]); } } while (0)
#define IDX_SCORES(nextrow) s16x8 af[4]; _Pragma("unroll") for (int s = 0; s < 4; ++s) af[s] = afn[s]; IDX_LOADK(nextrow);     \
        float sc[16]; \
        { const LAS uchar* qrow_ = qrow; asm volatile("" : "+v"(qrow_));        \
          s16x8 qa_[8]; f32x16 a0_, b0_, a1_, b1_; \
          _Pragma("unroll") for (int s = 0; s < 4; ++s) qa_[s] = *(const LAS s16x8*)(qrow_ + 1024 + s * 32); \
          __builtin_amdgcn_sched_barrier(0); \
          { f32x16 l_; _Pragma("unroll") for (int r = 0; r < 16; ++r) l_[r] = 0.f; _Pragma("unroll") for (int s = 0; s < 4; ++s) l_ = mfma32(af[s], qa_[s], l_); \
            __builtin_amdgcn_sched_barrier(0); IDX_RD(qa_, 0); __builtin_amdgcn_sched_barrier(0); IDX_MM(a0_, b0_, qa_); __builtin_amdgcn_sched_barrier(0); \
            _Pragma("unroll") for (int r = 0; r < 16; ++r) sc[r] = l_[r]; } \
          IDX_RD(qa_, 1); __builtin_amdgcn_sched_barrier(0); \
          IDX_MM(a1_, b1_, qa_); __builtin_amdgcn_sched_barrier(0); IDX_RD(qa_, 2); __builtin_amdgcn_sched_barrier(0); IDX_VA(a0_, b0_, 0); __builtin_amdgcn_sched_barrier(0); \
          IDX_MM(a0_, b0_, qa_); __builtin_amdgcn_sched_barrier(0); IDX_RD(qa_, 3); __builtin_amdgcn_sched_barrier(0); IDX_VA(a1_, b1_, 1); __builtin_amdgcn_sched_barrier(0); \
          IDX_MM(a1_, b1_, qa_); __builtin_amdgcn_sched_barrier(0); IDX_VA(a0_, b0_, 2); __builtin_amdgcn_sched_barrier(0); IDX_VA(a1_, b1_, 3); } \
          \
        asm volatile("; afn retired" : "+v"(afn[0]), "+v"(afn[1]), "+v"(afn[2]), "+v"(afn[3]));
        for (int i = tid2; i < NT * 32; i += NTHR) lbits[i] = 0u;
        if (tid2 < 32) cnt[tid2] = 0u;
        __syncthreads();
        for (int c = tid2; c < 2048; c += NTHR) { const int q_ = c >> 6, d_ = c & 63; const LAS u16* qh_ = (const LAS u16*)(qlds + q_ * 1168) + d_; float a_ = 0.f;
#pragma unroll
            for (int hh = 0; hh < 8; ++hh) a_ += wlds[q_ * 8 + hh] * h2f(qh_[hh * 64]);
            ((LAS u16*)(qlds + q_ * 1168))[512 + d_] = f2h(a_); }
        __syncthreads();
        const bool exact = (t0 + 32 <= 1024);
        if (exact) {
            {
            s16x8 afn[4]; IDX_LOADK(32 * min(wid, NT - 1) + r32);
#pragma unroll 1
            for (int jt = wid; jt < NT; jt += 8) { IDX_SCORES(32 * min(jt + 8, NT - 1) + r32)
                int r32l = r32; asm volatile("" : "+v"(r32l));
#pragma unroll
                for (int r = 0; r < 16; ++r) { const int key = 32 * jt + (r & 3) + 8 * (r >> 2) + 4 * hi; if (key <= tq) listf[(size_t)r32l * 1024 + key] = sc[r]; } } }
            __syncthreads();
            for (int q = wid; q < 32; q += 8) { const int t = t0 + q, n = t + 1; int lanel = lane; asm volatile("" : "+v"(lanel));
                unsigned ek[16]; unsigned vmask = 0u;
#pragma unroll
                for (int e = 0; e < 16; ++e) { const int p = e * 64 + lanel; const bool v = p < n; ek[e] = v ? okey(listf[(size_t)q * 1024 + p]) : 0u; vmask |= (v ? 1u : 0u) << e; }
                unsigned thr = 0u; int mrem = 0x7fffffff;
                if (n > 256) thr = radix_kth<16, 24>(ek, vmask, 256, hist, lane, mrem);
                int eqbase = 0;
#pragma unroll
                for (int e = 0; e < 16; ++e) { const bool v = (vmask >> e) & 1u; const bool gt = v && ek[e] > thr, eq = v && ek[e] == thr;
                    const unsigned long long be = __ballot(eq); const int ord = eqbase + __popcll(be & ((1ull << lane) - 1ull)); eqbase += __popcll(be);
                    if (gt || (eq && ord < mrem)) { const int p = e * 64 + lane; __hip_atomic_fetch_or(&lbits[(p >> 5) * 32 + q], 1u << (p & 31), __ATOMIC_RELAXED, __HIP_MEMORY_SCOPE_WORKGROUP); } }
            }
        } else {
            const int NTS = (t0 + 32 + 255) / 256;
            for (int rp_ = 0; rp_ < ((IDXREP & 1) ? 2 : 1); ++rp_) {
            s16x8 afn[4]; IDX_LOADK(8 * (32 * min(wid, NTS - 1) + r32));
#pragma unroll 1
            for (int js = wid; js < NTS; js += 8) { IDX_SCORES(8 * (32 * min(js + 8, NTS - 1) + r32))
                int r32l = r32; asm volatile("" : "+v"(r32l));
#pragma unroll
                for (int r = 0; r < 16; ++r) { const int so = 32 * js + (r & 3) + 8 * (r >> 2) + 4 * hi; if (8 * so <= tq) lists[(size_t)r32l * 2048 + so] = (u16)(okey(sc[r]) >> 16); } } }
            __syncthreads();
            for (int rp_ = 0; rp_ < ((IDXREP & 2) ? 2 : 1); ++rp_)
            for (int q = wid; q < 32; q += 8) { const int t = t0 + q, ns = (t >> 3) + 1; int lanel = lane; asm volatile("" : "+v"(lanel));
                unsigned ek[32]; unsigned vmask = 0u;
#pragma unroll
                for (int e = 0; e < 32; ++e) { const int p = e * 64 + lanel; const bool v = p < ns; ek[e] = v ? (unsigned)lists[(size_t)q * 2048 + p] : 0u; vmask |= (v ? 1u : 0u) << e; }
                int mrem; const unsigned thr = radix_kth<32, 8>(ek, vmask, MSAMP, hist, lane, mrem);
                if (lane == 0) tau[q] = thr;
            }
            __syncthreads();
            const unsigned tq16 = tau[r32];
            const unsigned tk_ = tq16 << 16; const float tauf = __uint_as_float((tk_ & 0x80000000u) ? (tk_ ^ 0x80000000u) : ~tk_);
            {
            LAS u32x2* stg = (LAS u32x2*)(lds + 112384) + wid * 128; int nst = 0;
#define IDX_FLUSH(n_) do { asm volatile("" ::: "memory"); if (lane < (n_)) { const u32x2 e_ = stg[lane]; const unsigned q_ = e_.y >> 16; \
                const unsigned pos_ = __hip_atomic_fetch_add(&cnt[q_], 1u, __ATOMIC_RELAXED, __HIP_MEMORY_SCOPE_WORKGROUP); \
                if (pos_ < (unsigned)CAP) { candS[(size_t)q_ * CAP + pos_] = __uint_as_float(e_.x); candI[(size_t)q_ * CAP + pos_] = (u16)(e_.y & 0xffffu); } } } while (0)
            s16x8 afn[4]; IDX_LOADK(32 * min(wid, NT - 1) + r32);
#pragma unroll 1
            for (int jt = wid; jt < NT; jt += 8) { IDX_SCORES(32 * min(jt + 8, NT - 1) + r32)
#define IDX_CAND(CAUS_) do { const unsigned kw_ = ((unsigned)r32 << 16) | (unsigned)(32 * jt + 4 * hi); \
                _Pragma("unroll") for (int r = 0; r < 16; ++r) { const unsigned kwr_ = kw_ | (unsigned)((r & 3) + 8 * (r >> 2)); \
                    bool p_ = sc[r] >= tauf; if (CAUS_) p_ = p_ && ((int)(kwr_ & 0xffffu) <= tq); \
                    const unsigned long long bal_ = __ballot(p_); \
                    if (bal_) { \
                        if (p_) { const int slot_ = (int)__builtin_amdgcn_mbcnt_hi((unsigned)(bal_ >> 32), __builtin_amdgcn_mbcnt_lo((unsigned)bal_, (unsigned)nst)); stg[slot_] = (u32x2){__float_as_uint(sc[r]), kwr_}; } \
                        nst += __popcll(bal_); \
                        if (nst >= 64) { IDX_FLUSH(64); asm volatile("" ::: "memory"); \
                            const int rem_ = nst - 64; u32x2 mv_ = {0u, 0u}; if (lane < rem_) mv_ = stg[64 + lane]; asm volatile("" ::: "memory"); if (lane < rem_) stg[lane] = mv_; nst = rem_; __builtin_amdgcn_s_waitcnt(0xc07f);   } \
                    } } } while (0)
                if (jt == NT - 1) IDX_CAND(1); else IDX_CAND(0);
#undef IDX_CAND
            }
            IDX_FLUSH(nst);
#undef IDX_FLUSH
            }
            __syncthreads();
            for (int rp_ = 0; rp_ < ((IDXREP & 8) ? 2 : 1); ++rp_)
            for (int q = wid; q < 32; q += 8) { const int n = min((int)cnt[q], CAP); int lanel = lane; asm volatile("" : "+v"(lanel));
                unsigned ek[16]; unsigned ei[16]; unsigned vmask = 0u;
#pragma unroll
                for (int e = 0; e < 16; ++e) { const int p = e * 64 + lanel; const bool v = p < n; ek[e] = v ? okey(candS[(size_t)q * CAP + p]) : 0u; ei[e] = v ? (unsigned)candI[(size_t)q * CAP + p] : 0u; vmask |= (v ? 1u : 0u) << e; }
                unsigned thr = 0u; int mrem = 0x7fffffff;
                if (n > 256) thr = radix_kth<16, 24>(ek, vmask, 256, hist, lane, mrem);
                int eqbase = 0;
#pragma unroll
                for (int e = 0; e < 16; ++e) { const bool v = (vmask >> e) & 1u; const bool gt = v && ek[e] > thr, eq = v && ek[e] == thr;
                    const unsigned long long be = __ballot(eq); const int ord = eqbase + __popcll(be & ((1ull << lane) - 1ull)); eqbase += __popcll(be);
                    if (gt || (eq && ord < mrem)) { const unsigned p = ei[e]; __hip_atomic_fetch_or(&lbits[(p >> 5) * 32 + q], 1u << (p & 31), __ATOMIC_RELAXED, __HIP_MEMORY_SCOPE_WORKGROUP); } }
            }
        }
        __syncthreads();
        { const int tid3 = opaque_tid(); for (int i = tid3; i < NT * 32; i += NTHR) bitsg[(size_t)(i >> 5) * L + t0 + (i & 31)] = lbits[i]; }
        __syncthreads();
#undef IDX_SCORES
#undef IDX_LOADK
#undef IDX_RD
#undef IDX_MM
#undef IDX_VA
    }
}

__device__ __forceinline__ void conv_dw_phase(const Ptrs& P, LAS uchar* lds, int vcu, int G) {
    const int tid = opaque_tid(), lane = tid & 63, wid = __builtin_amdgcn_readfirstlane(tid >> 6);
    const u16* U = (const u16*)(P.ws + WS_CU); u16* CL = (u16*)(P.ws + WS_CL);
    const float* wdw = P.in(12); const float* bdw = P.in(13); const float* lng = P.in(14); const float* lnb = P.in(15);
    LAS float* co = (LAS float*)lds;
    for (int it = vcu; it < L / 32; it += G) {
        const int t0 = it * 32;
        { const int ch = 2 * tid;
            f32x2 w[31];
#pragma unroll
            for (int j = 0; j < 31; ++j) w[j] = *(const f32x2*)(wdw + j * 1024 + ch);
            const f32x2 bb = *(const f32x2*)(bdw + ch);
#pragma unroll 1
            for (int hf = 0; hf < 2; ++hf) {
                unsigned wr[46];
#pragma unroll
                for (int i = 0; i < 46; ++i) { const int t = t0 - 30 + 16 * hf + i; const unsigned uu = *(const unsigned*)(U + (size_t)(t > 0 ? t : 0) * 1024 + ch); wr[i] = (t >= 0) ? uu : 0u; }
                f32x2 acc[16];
#pragma unroll
                for (int tt = 0; tt < 16; ++tt) acc[tt] = bb;
#pragma unroll
                for (int i = 0; i < 46; ++i) { const unsigned uu = wr[i]; const h16x2 hh = __builtin_bit_cast(h16x2, uu); const f32x2 wi = {(float)hh[0], (float)hh[1]};
#pragma unroll
                    for (int tt = 0; tt < 16; ++tt) { if (i - tt >= 0 && i - tt <= 30) acc[tt] += w[i - tt] * wi; } }
#pragma unroll
                for (int tt = 0; tt < 16; ++tt) *(LAS f32x2*)(co + (16 * hf + tt) * 1024 + ch) = acc[tt];
            }
        }
        __syncthreads();
#pragma unroll 1
        for (int k = 0; k < 4; ++k) { const int tt = wid * 4 + k; float v[16]; float s = 0.f;
#pragma unroll
            for (int i = 0; i < 16; ++i) { v[i] = co[tt * 1024 + lane + 64 * i]; s += v[i]; }
            const float mean = wave_sum(s) * (1.f / 1024.f); float q = 0.f;
#pragma unroll
            for (int i = 0; i < 16; ++i) { v[i] -= mean; q += v[i] * v[i]; }
            const float rstd = rsqrtf(wave_sum(q) * (1.f / 1024.f) + EPS);
#pragma unroll
            for (int i = 0; i < 16; ++i) { const int ch = lane + 64 * i; const float y = v[i] * rstd * lng[ch] + lnb[ch]; CL[(size_t)(t0 + tt) * 1024 + ch] = f2h(siluf_(y)); }
        }
        __syncthreads();
    }
}

__device__ __forceinline__ void gdn_pre(const Ptrs& P, int vcu, int G) {
    const int tid_ = opaque_tid(), lane = tid_ & 63, wave = __builtin_amdgcn_readfirstlane(tid_ >> 6);
    const int gw = vcu * NWAVES + wave, NGW = G * NWAVES;
    const u16* RQ = (const u16*)(P.ws + WS_GQ); u16* HALO = (u16*)(P.ws + WS_GHALO);
    for (long c = (long)gw * 64 + lane; c < 256L * 9 * 128; c += (long)NGW * 64) {
        const int it = (int)(c >> 7), ch = (int)(c & 127); const int n = it / 9, r = it % 9, j = r / 3, which = r % 3;
        if (n == 0) continue;
        const u16* src = RQ + (size_t)which * (16 * MiB) + (size_t)(64 * n - 3 + j) * 1024 + ch * 8;
        *(u32x4*)(HALO + ((size_t)(n * 3 + j) * 3 + which) * 1024 + ch * 8) = *(const u32x4*)src;
    }
    const u16* h = (const u16*)(P.ws + WS_A16); const float* W = P.in(24); const float* gmix = P.in(1) + 3 * 1024;
    float* Gd = (float*)(P.ws + WS_GG); float* Bt = (float*)(P.ws + WS_GBETA);
    const float* alog = P.in(26); const float* dtb = P.in(27);
    for (int pass = 0; pass < 4; ++pass) {
        float wr[16][4];
#pragma unroll
        for (int i = 0; i < 16; ++i) { const int k = 16 * lane + i; const float g = gmix[k]; const f32x4 a = *(const f32x4*)(W + (size_t)k * 4112 + 4096 + 4 * pass);
            wr[i][0] = a[0] * g; wr[i][1] = a[1] * g; wr[i][2] = a[2] * g; wr[i][3] = a[3] * g; }
        u32x4 xn[2];
#pragma unroll
        for (int j = 0; j < 2; ++j) xn[j] = ((const u32x4*)(h + (size_t)(gw < L ? gw : 0) * 1024) + 2 * lane)[j];
        for (int m = gw; m < L; m += NGW) {
            u32x4 xw[2] = {xn[0], xn[1]};
            { const int mn = (m + NGW < L) ? m + NGW : m;
#pragma unroll
              for (int j = 0; j < 2; ++j) xn[j] = ((const u32x4*)(h + (size_t)mn * 1024) + 2 * lane)[j]; }
            float acc[4] = {0.f, 0.f, 0.f, 0.f}, ss = 0.f;
#pragma unroll
            for (int j = 0; j < 2; ++j) { const unsigned ww[4] = {xw[j].x, xw[j].y, xw[j].z, xw[j].w};
#pragma unroll
                for (int k = 0; k < 4; ++k) { const unsigned wk = ww[k]; const h16x2 hh = __builtin_bit_cast(h16x2, wk); const float x0 = (float)hh[0], x1 = (float)hh[1]; const int i0 = 8 * j + 2 * k;
                    ss += x0 * x0 + x1 * x1;
#pragma unroll
                    for (int c = 0; c < 4; ++c) acc[c] += x0 * wr[i0][c] + x1 * wr[i0 + 1][c]; } }
            ss = wave_sum(ss); const float rs = rsqrtf(ss * (1.f / 1024.f) + EPS);
#pragma unroll
            for (int c = 0; c < 4; ++c) acc[c] = wave_sum(acc[c]) * rs;
            if (lane < 4) { const float v = lane == 0 ? acc[0] : lane == 1 ? acc[1] : lane == 2 ? acc[2] : acc[3]; const int col = 4 * (pass & 1) + lane;
                if (pass < 2) Bt[(size_t)m * 8 + col] = sigmoidf_(v);
                else { const float xx = v + dtb[col]; const float sp = xx > 20.f ? xx : log1pf(__expf(xx)); Gd[(size_t)m * 8 + col] = -__expf(alog[col]) * sp; } }
        }
    }
}

__device__ __forceinline__ s16x8 pk2blk(f32x4 a, f32x4 b) { return __builtin_bit_cast(s16x8, pack8(a, b)); }
__device__ __forceinline__ void gdn_chunk(const Ptrs& P, LAS uchar* lds, int vcu, int G) {
    u16* RQ = (u16*)(P.ws + WS_GQ); u16* RK = (u16*)(P.ws + WS_GK); u16* RV = (u16*)(P.ws + WS_GV); u16* WB = (u16*)(P.ws + WS_GW); u16* QK = (u16*)(P.ws + WS_GQK);
    const u16* HALO = (const u16*)(P.ws + WS_GHALO); const float* Gd = (const float*)(P.ws + WS_GG); const float* Bt = (const float*)(P.ws + WS_GBETA); float* GL = (float*)(P.ws + WS_GGL);
    const float* cw = P.in(25);
    constexpr int PT = 132;
    LAS float* Am = (LAS float*)lds; LAS float* gcs = Am + 4096; LAS float* egc = gcs + 64; LAS float* bet = egc + 64;
    LAS float* qs = bet + 64; LAS float* ks = qs + 64 * PT; LAS float* vs = ks + 64 * PT;
    LAS u16* xw = (LAS u16*)(vs + 64 * PT);
    for (int it = vcu; it < 2048; it += G) {
        const int n = it >> 3, hd = it & 7;
        const int tid = opaque_tid(), lane = tid & 63, wid = __builtin_amdgcn_readfirstlane(tid >> 6);
        for (int rp_ = 0; rp_ < ((CHREP & 1) ? 2 : 1); ++rp_)
        if (tid < 384) { const int which = tid >> 7, ch = tid & 127, col = hd * 128 + ch;
            const u16* src = (which == 0 ? RQ : which == 1 ? RK : RV) + col; LAS float* dst = (which == 0 ? qs : which == 1 ? ks : vs) + ch;
            const float c0 = cw[0 * 3072 + which * 1024 + col], c1 = cw[1 * 3072 + which * 1024 + col], c2 = cw[2 * 3072 + which * 1024 + col], c3 = cw[3 * 3072 + which * 1024 + col];
            float x0 = 0.f, x1 = 0.f, x2 = 0.f;
            if (n > 0) { const u16* hp = HALO + ((size_t)(n * 3) * 3 + which) * 1024 + col; x0 = h2f(hp[0]); x1 = h2f(hp[3 * 1024]); x2 = h2f(hp[6 * 1024]); }
            u16 xr[64];
#pragma unroll
            for (int c = 0; c < 64; ++c) xr[c] = src[(size_t)(64 * n + c) * 1024];
#pragma unroll
            for (int c = 0; c < 64; ++c) { const float x3 = h2f(xr[c]); const float y = c0 * x0 + c1 * x1 + c2 * x2 + c3 * x3; dst[c * PT] = siluf_(y); x0 = x1; x1 = x2; x2 = x3; }
        } else if (tid < 448) { const int c = tid - 384; float g = Gd[(size_t)(64 * n + c) * 8 + hd];
#pragma unroll
            for (int o = 1; o < 64; o <<= 1) { const float t = __int_as_float(__builtin_amdgcn_ds_bpermute((lane - o) * 4, __float_as_int(g))); if (lane >= o) g += t; }
            gcs[c] = g; egc[c] = __expf(g); bet[c] = Bt[(size_t)(64 * n + c) * 8 + hd];
        }
        __syncthreads();
        { const int r = tid >> 2, pq = tid & 3; LAS float* row = (r < 64 ? qs + r * PT : ks + (r - 64) * PT) + 32 * pq;
          f32x4 e[8]; float s = 0.f;
#pragma unroll
          for (int k = 0; k < 8; ++k) { e[k] = *(const LAS f32x4*)(row + 4 * ((k + 2 * pq) & 7)); s += (e[k][0] * e[k][0] + e[k][1] * e[k][1]) + (e[k][2] * e[k][2] + e[k][3] * e[k][3]); }
          s += __shfl_xor(s, 1); s += __shfl_xor(s, 2);
          const float rn = rsqrtf(s + EPS) * (r < 64 ? GDN_QS : 1.f);
#pragma unroll
          for (int k = 0; k < 8; ++k) *(LAS f32x4*)(row + 4 * ((k + 2 * pq) & 7)) = e[k] * rn; }
        __syncthreads();
        { const int ib = wid & 3, r = lane & 15, g = lane >> 4, i = 16 * ib + r; const bool isq = wid >= 4;
          const LAS float* X = isq ? qs : ks;
          s16x8 bf[4];
#pragma unroll
          for (int k4 = 0; k4 < 4; ++k4) bf[k4] = pk2blk(*(const LAS f32x4*)(X + i * PT + 32 * k4 + 8 * g), *(const LAS f32x4*)(X + i * PT + 32 * k4 + 8 * g + 4));
          const float gi = gcs[i], bi = bet[i];
          f32x4 dv[4];
#pragma unroll
          for (int jb = 0; jb < 4; ++jb) { dv[jb] = (f32x4){0.f, 0.f, 0.f, 0.f};
              if (jb <= ib) {
                  f32x4 acc = {0.f, 0.f, 0.f, 0.f};
#pragma unroll
                  for (int k4 = 0; k4 < 4; ++k4) { const s16x8 af = pk2blk(*(const LAS f32x4*)(ks + (16 * jb + r) * PT + 32 * k4 + 8 * g), *(const LAS f32x4*)(ks + (16 * jb + r) * PT + 32 * k4 + 8 * g + 4));
                      acc = mfma16(af, bf[k4], acc); }
                  const f32x4 gj = *(const LAS f32x4*)(gcs + 16 * jb + 4 * g);
#pragma unroll
                  for (int e = 0; e < 4; ++e) { const int j = 16 * jb + 4 * g + e; const float dec = __expf(gi - gj[e]);
                      dv[jb][e] = isq ? ((j <= i) ? acc[e] * dec : 0.f) : ((j < i) ? bi * acc[e] * dec : 0.f); }
                  if (!isq) *(LAS f32x4*)(Am + i * 64 + 16 * jb + 4 * g) = dv[jb];
              } }
          if (isq) {
#pragma unroll
              for (int k2 = 0; k2 < 2; ++k2) *(u32x4*)(QK + (size_t)it * 4096 + (ib * 2 + k2) * 512 + lane * 8) = pack8(dv[2 * k2], dv[2 * k2 + 1]); }
        }
        __syncthreads();
        for (int rp_ = 0; rp_ < ((CHREP & 8) ? 2 : 1); ++rp_)
        if (tid < 256) {
            const int col = tid; f32x2 xv[32];
            if (col < 128) {
#pragma unroll
                for (int m = 0; m < 32; ++m) xv[m] = (f32x2){bet[2 * m] * vs[(2 * m) * PT + col], bet[2 * m + 1] * vs[(2 * m + 1) * PT + col]};
            } else {
#pragma unroll
                for (int m = 0; m < 32; ++m) xv[m] = (f32x2){bet[2 * m] * egc[2 * m] * ks[(2 * m) * PT + col - 128], bet[2 * m + 1] * egc[2 * m + 1] * ks[(2 * m + 1) * PT + col - 128]};
            }
            f32x4 ra[8], rb[8], rc[8];
            ra[0] = *(const LAS f32x4*)(Am + 1 * 64);
#pragma unroll
            for (int i = 1; i < 64; ++i) {
#pragma unroll
                for (int jq = 8; jq < (i + 3) / 4; ++jq) rc[jq - 8] = *(const LAS f32x4*)(Am + i * 64 + 4 * jq);
                if (i + 1 < 64) {
#pragma unroll
                    for (int jq = 0; jq < ((i + 4) / 4 < 8 ? (i + 4) / 4 : 8); ++jq) { if (i & 1) rb[jq] = *(const LAS f32x4*)(Am + (i + 1) * 64 + 4 * jq); else ra[jq] = *(const LAS f32x4*)(Am + (i + 1) * 64 + 4 * jq); }
                }
                f32x2 s01 = {xv[i >> 1][i & 1], 0.f}, s23 = {0.f, 0.f};
#pragma unroll
                for (int jq = 0; jq < (i + 3) / 4; ++jq) { const f32x4 a4 = (jq < 8) ? ((i & 1) ? ra[jq] : rb[jq]) : rc[jq - 8];
                    if (4 * jq + 1 < i) s01 -= (f32x2){a4[0], a4[1]} * xv[2 * jq]; else s01[0] -= a4[0] * xv[2 * jq][0];
                    if (4 * jq + 3 < i) s23 -= (f32x2){a4[2], a4[3]} * xv[2 * jq + 1]; else if (4 * jq + 2 < i) s23[0] -= a4[2] * xv[2 * jq + 1][0]; }
                xv[i >> 1][i & 1] = (s01[0] + s01[1]) + (s23[0] + s23[1]);
                __builtin_amdgcn_sched_barrier(0);
            }
            if (col < 128) { u16* dst = RV + (size_t)(64 * n + (col >> 1)) * 1024 + hd * 128 + (col & 1) * 64;
#pragma unroll
                for (int c8 = 0; c8 < 8; ++c8) { u32x4 w; w.x = pk16(xv[4 * c8][0], xv[4 * c8][1]); w.y = pk16(xv[4 * c8 + 1][0], xv[4 * c8 + 1][1]); w.z = pk16(xv[4 * c8 + 2][0], xv[4 * c8 + 2][1]); w.w = pk16(xv[4 * c8 + 3][0], xv[4 * c8 + 3][1]); *(u32x4*)(dst + 8 * c8) = w; }
            } else {
#pragma unroll
                for (int c = 0; c < 64; ++c) xw[c * 136 + (col - 128)] = f2h(xv[c >> 1][c & 1]); }
        } else { const int t2 = tid - 256; const float gl = gcs[63];
            for (int idx = t2; idx < 1024; idx += 256) { const int c = idx >> 4, ksx = (idx >> 2) & 3, g = idx & 3; const float e = egc[c];
                const f32x4 a = *(const LAS f32x4*)(qs + c * PT + 32 * ksx + 4 * g) * e, b = *(const LAS f32x4*)(qs + c * PT + 32 * ksx + 16 + 4 * g) * e;
                const int f = (c >> 4) * 4 + ksx;
                *(u32x4*)(RQ + (size_t)(64 * n + 4 * f + g) * 1024 + hd * 128 + (c & 15) * 8) = pack8(a, b); }
            for (int idx = t2; idx < 1024; idx += 256) { const int dk = idx >> 3, k2 = (idx >> 2) & 1, g = idx & 3; f32x4 a, b;
#pragma unroll
                for (int jj = 0; jj < 4; ++jj) { const int c0 = 32 * k2 + 4 * g + jj, c1 = c0 + 16; a[jj] = ks[c0 * PT + dk] * __expf(gl - gcs[c0]); b[jj] = ks[c1 * PT + dk] * __expf(gl - gcs[c1]); }
                const int f = (dk >> 4) * 2 + k2;
                *(u32x4*)(RK + (size_t)(64 * n + 4 * f + g) * 1024 + hd * 128 + (dk & 15) * 8) = pack8(a, b); }
            if (t2 == 0) GL[it] = __expf(gl);
        }
        __syncthreads();
        for (int rp_ = 0; rp_ < ((CHREP & 16) ? 2 : 1); ++rp_)
        for (int idx = tid; idx < 1024; idx += NTHR) { const int f = idx >> 6, ln = idx & 63, lo = ln & 15, g = ln >> 4, c = (f >> 2) * 16 + lo, ksx = f & 3;
            const u32x2 a = *(const LAS u32x2*)(xw + c * 136 + 32 * ksx + 4 * g), b = *(const LAS u32x2*)(xw + c * 136 + 32 * ksx + 16 + 4 * g);
            *(u32x4*)(WB + (size_t)it * 8192 + f * 512 + ln * 8) = (u32x4){a.x, a.y, b.x, b.y}; }
        __syncthreads();
    }
}

__device__ __forceinline__ s16x8 ld2x8(const u16* p) { const u32x2 a = *(const u32x2*)p, b = *(const u32x2*)(p + 16); const u32x4 w = {a.x, a.y, b.x, b.y}; return __builtin_bit_cast(s16x8, w); }

constexpr int SC_STAGE = 32768, SC_HBS = 2 * SC_STAGE, SC_HBV = SC_HBS + 3 * 4096;
#define SC_BAR() do { asm volatile("s_waitcnt lgkmcnt(0)" ::: "memory"); __builtin_amdgcn_s_barrier(); asm volatile("" ::: "memory"); } while (0)
__device__ __forceinline__ void gdn_scan2(const Ptrs& P, LAS uchar* lds, int chain) {
    const int tid = opaque_tid(), lane = tid & 63, wave = __builtin_amdgcn_readfirstlane(tid >> 6);
    const int hd = chain >> 3, lo = lane & 15, g = lane >> 4, dv = (chain & 7) * 16 + lo;
    const uchar* RQb = (const uchar*)(P.ws + WS_GQ); const uchar* RKb = (const uchar*)(P.ws + WS_GK); const u16* RV = (const u16*)(P.ws + WS_GV);
    const uchar* WBb = (const uchar*)(P.ws + WS_GW); const uchar* QKb = (const uchar*)(P.ws + WS_GQK); const float* GL = (const float*)(P.ws + WS_GGL);
    if (wave >= 2 && wave <= 5) {
        const int lw = wave - 2, kind = lw >> 1, f0 = (lw & 1) * 8;
        const uchar* src; size_t chunk_stride, frag_stride;
        if (kind == 0) { src = WBb + (size_t)hd * 16384 + (size_t)f0 * 1024 + lane * 16; chunk_stride = (size_t)8 * 16384; frag_stride = 1024; }
        else { src = RKb + ((size_t)(4 * f0 + g) * 1024 + hd * 128) * 2 + lo * 16; chunk_stride = (size_t)64 * 2048; frag_stride = 8192; }
        LAS uchar* dst = lds + (kind * 16 + f0) * 1024 + lane * 16;
        u32x4 r0[8], r1[8], r2[8], r3[8];
#define SC_LD(R, n_) do { const uchar* p_ = src + (size_t)((n_) < 256 ? (n_) : 255) * chunk_stride; _Pragma("unroll") for (int i_ = 0; i_ < 8; ++i_) R[i_] = *(const u32x4*)(p_ + i_ * frag_stride); } while (0)
#define SC_ST(R, st_) do { _Pragma("unroll") for (int i_ = 0; i_ < 8; ++i_) *(LAS u32x4*)(dst + (st_) * SC_STAGE + i_ * 1024) = R[i_]; } while (0)
        SC_LD(r0, 0); asm volatile("s_waitcnt vmcnt(0)" ::: "memory"); SC_ST(r0, 0);
        SC_LD(r1, 1); SC_LD(r2, 2); SC_LD(r3, 3); SC_LD(r0, 4);
        for (int n = 0; n < 256; n += 4) {
            SC_BAR(); asm volatile("s_waitcnt vmcnt(24)" ::: "memory"); SC_ST(r1, 1); SC_LD(r1, n + 5);
            SC_BAR(); asm volatile("s_waitcnt vmcnt(24)" ::: "memory"); SC_ST(r2, 0); SC_LD(r2, n + 6);
            SC_BAR(); asm volatile("s_waitcnt vmcnt(24)" ::: "memory"); SC_ST(r3, 1); SC_LD(r3, n + 7);
            SC_BAR(); asm volatile("s_waitcnt vmcnt(24)" ::: "memory"); SC_ST(r0, 0); SC_LD(r0, n + 8);
        }
        SC_BAR();
        asm volatile("s_waitcnt vmcnt(0)" ::: "memory");
#undef SC_LD
#undef SC_ST
    } else if (wave == 0) {
        f32x4 Sb[8];
#pragma unroll
        for (int b = 0; b < 8; ++b) Sb[b] = (f32x4){0.f, 0.f, 0.f, 0.f};
        { const u32x4 z = {0u, 0u, 0u, 0u};
#pragma unroll
          for (int ks = 0; ks < 4; ++ks) *(LAS u32x4*)(lds + SC_HBS + ks * 1024 + lane * 16) = z; }
        const u16* ub = RV + (size_t)hd * 128 + (size_t)(dv >> 1) * 1024 + (dv & 1) * 64 + 4 * g;
        u32x2 un[4];
#pragma unroll
        for (int mb = 0; mb < 4; ++mb) un[mb] = *(const u32x2*)(ub + 16 * mb);
        float gln = GL[hd];
        s16x8 Bs[4];
#pragma unroll
        for (int ks = 0; ks < 4; ++ks) Bs[ks] = (s16x8){0, 0, 0, 0, 0, 0, 0, 0};
        int hb = 1;
        for (int n = 0; n < 256; ++n) {
            const LAS uchar* st = lds + (n & 1) * SC_STAGE + lane * 16;
            u32x2 uc[4];
#pragma unroll
            for (int mb = 0; mb < 4; ++mb) uc[mb] = un[mb];
            const float gl = gln;
            { const int nn = n < 255 ? n + 1 : 255; const u16* up = ub + (size_t)(64 * nn) * 1024;
#pragma unroll
              for (int mb = 0; mb < 4; ++mb) un[mb] = *(const u32x2*)(up + 16 * mb);
              gln = GL[nn * 8 + hd]; }
            SC_BAR();
            s16x8 wf[16], kf[16];
#pragma unroll
            for (int i_ = 0; i_ < 16; ++i_) wf[i_] = *(const LAS s16x8*)(st + i_ * 1024);
#pragma unroll
            for (int i_ = 0; i_ < 16; ++i_) kf[i_] = *(const LAS s16x8*)(st + (16 + i_) * 1024);
            __builtin_amdgcn_sched_barrier(0);
            f32x4 vn[4];
#pragma unroll
            for (int mb = 0; mb < 4; ++mb) { f32x4 a = {0.f, 0.f, 0.f, 0.f};
#pragma unroll
                for (int ks = 0; ks < 4; ++ks) a = mfma16(wf[mb * 4 + ks], Bs[ks], a);
                const unsigned ux_ = uc[mb].x, uy_ = uc[mb].y; const h16x2 u01 = __builtin_bit_cast(h16x2, ux_), u23 = __builtin_bit_cast(h16x2, uy_);
                vn[mb][0] = (float)u01[0] - a[0]; vn[mb][1] = (float)u01[1] - a[1]; vn[mb][2] = (float)u23[0] - a[2]; vn[mb][3] = (float)u23[1] - a[3]; }
            s16x8 Bv[2];
#pragma unroll
            for (int k2 = 0; k2 < 2; ++k2) { Bv[k2] = pk2blk(vn[2 * k2], vn[2 * k2 + 1]); *(LAS s16x8*)(lds + SC_HBV + (n & 1) * 2048 + k2 * 1024 + lane * 16) = Bv[k2]; }
#pragma unroll
            for (int b = 0; b < 8; ++b) { f32x4 a = Sb[b] * gl;
#pragma unroll
                for (int k2 = 0; k2 < 2; ++k2) a = mfma16(kf[b * 2 + k2], Bv[k2], a);
                Sb[b] = a; }
#pragma unroll
            for (int ks = 0; ks < 4; ++ks) { Bs[ks] = pk2blk(Sb[2 * ks], Sb[2 * ks + 1]); *(LAS s16x8*)(lds + SC_HBS + hb * 4096 + ks * 1024 + lane * 16) = Bs[ks]; }
            hb = (hb == 2) ? 0 : hb + 1;
        }
        SC_BAR();
    } else if (wave == 1 || wave == 6) {
        const int mb0 = (wave == 1) ? 0 : 2;
        const uchar* qdp = RQb + ((size_t)(16 * mb0 + g) * 1024 + hd * 128) * 2 + lo * 16;
        const uchar* qkp = QKb + (size_t)hd * 8192 + (size_t)(mb0 * 2) * 1024 + lane * 16;
        u16* ob = (u16*)P.out + (size_t)hd * 128 + (size_t)(dv >> 1) * 1024 + (dv & 1) * 64 + 4 * g + 16 * mb0;
        u32x4 q0[12], q1[12];
#define SC_LQ(R, n_) do { const int c_ = (n_) < 256 ? (n_) : 255; const uchar* p_ = qdp + (size_t)c_ * 131072; const uchar* k_ = qkp + (size_t)c_ * 65536; \
            _Pragma("unroll") for (int i_ = 0; i_ < 8; ++i_) R[i_] = *(const u32x4*)(p_ + i_ * 8192); _Pragma("unroll") for (int i_ = 0; i_ < 4; ++i_) R[8 + i_] = *(const u32x4*)(k_ + i_ * 1024); } while (0)
#define SC_BSTEP(R, n_) do { SC_BAR();     \
            s16x8 Bs[4], Bv[2]; _Pragma("unroll") for (int ks = 0; ks < 4; ++ks) Bs[ks] = *(const LAS s16x8*)(lds + SC_HBS + hbr * 4096 + ks * 1024 + lane * 16); \
            _Pragma("unroll") for (int k2 = 0; k2 < 2; ++k2) Bv[k2] = *(const LAS s16x8*)(lds + SC_HBV + ((n_) & 1) * 2048 + k2 * 1024 + lane * 16); \
            u16* op_ = ob + (size_t)(64 * (n_)) * 1024; \
            _Pragma("unroll") for (int m_ = 0; m_ < 2; ++m_) { f32x4 a = {0.f, 0.f, 0.f, 0.f}; \
                _Pragma("unroll") for (int ks = 0; ks < 4; ++ks) a = mfma16(__builtin_bit_cast(s16x8, R[m_ * 4 + ks]), Bs[ks], a); \
                _Pragma("unroll") for (int k2 = 0; k2 < 2; ++k2) a = mfma16(__builtin_bit_cast(s16x8, R[8 + m_ * 2 + k2]), Bv[k2], a); \
                u32x2 w; w.x = pk16(a[0], a[1]); w.y = pk16(a[2], a[3]); *(u32x2*)(op_ + 16 * m_) = w; } \
            hbr = (hbr == 2) ? 0 : hbr + 1; } while (0)
        int hbr = 0;
        SC_LQ(q0, 0); SC_LQ(q1, 1);
        SC_BAR();
        for (int n = 0; n < 256; n += 2) {
            SC_BSTEP(q0, n); SC_LQ(q0, n + 2);
            SC_BSTEP(q1, n + 1); SC_LQ(q1, n + 3);
        }
#undef SC_LQ
#undef SC_BSTEP
    } else {
        for (int n = 0; n < 257; ++n) SC_BAR();
    }
    asm volatile("s_waitcnt vmcnt(0) lgkmcnt(0)" ::: "memory");
    __syncthreads();
}

__device__ __forceinline__ void gdn_out(const Ptrs& P, LAS uchar* lds, int vcu, int G) {
    const int tid = opaque_tid(), lane = tid & 63, wid = __builtin_amdgcn_readfirstlane(tid >> 6);
    const u16* RV = (const u16*)P.out; u16* GATE = (u16*)(P.ws + WS_GGATE); const float* og = P.in(28);
    LAS u16* ot = (LAS u16*)lds;
    u32x4 wn[2]; u16 gn0[8], gn1[8]; const float og0 = og[lane], og1 = og[lane + 64];
#define GO_LOAD(it_) do { const int n_ = (it_) >> 3, hd_ = (it_) & 7; \
        _Pragma("unroll") for (int i_ = 0; i_ < 2; ++i_) { const int idx = tid + 512 * i_, row = idx >> 4, cc = idx & 15; wn[i_] = *(const u32x4*)(RV + (size_t)(64 * n_ + row) * 1024 + hd_ * 128 + cc * 8); } \
        _Pragma("unroll") for (int k = 0; k < 8; ++k) { const u16* gp = GATE + (size_t)(64 * n_ + wid * 8 + k) * 1024 + hd_ * 128; gn0[k] = gp[lane]; gn1[k] = gp[lane + 64]; } } while (0)
    if (vcu < 2048) GO_LOAD(vcu);
    for (int it = vcu; it < 2048; it += G) { const int n = it >> 3, hd = it & 7;
        u16 gv0[8], gv1[8];
#pragma unroll
        for (int i_ = 0; i_ < 2; ++i_) { const int idx = tid + 512 * i_, row = idx >> 4, cc = idx & 15; const u32x4 w = wn[i_];
            const int e0 = row * 128 + cc * 8, dvv = e0 >> 6, c0 = e0 & 63; const unsigned ww[4] = {w.x, w.y, w.z, w.w};
#pragma unroll
            for (int k = 0; k < 4; ++k) { ot[(c0 + 2 * k) * 130 + dvv] = (u16)(ww[k] & 0xffffu); ot[(c0 + 2 * k + 1) * 130 + dvv] = (u16)(ww[k] >> 16); } }
#pragma unroll
        for (int k = 0; k < 8; ++k) { gv0[k] = gn0[k]; gv1[k] = gn1[k]; }
        if (it + G < 2048) GO_LOAD(it + G);
        __syncthreads();
#pragma unroll
        for (int k = 0; k < 8; ++k) { const int c = wid * 8 + k; const float o0 = h2f(ot[c * 130 + lane]), o1 = h2f(ot[c * 130 + lane + 64]);
            const float rs = rsqrtf(wave_sum(o0 * o0 + o1 * o1) * (1.f / 128.f) + EPS);
            u16* gp = GATE + (size_t)(64 * n + c) * 1024 + hd * 128;
            gp[lane] = f2h(o0 * rs * og0 * siluf_(h2f(gv0[k]))); gp[lane + 64] = f2h(o1 * rs * og1 * siluf_(h2f(gv1[k]))); }
        __syncthreads();
    }
#undef GO_LOAD
}

__device__ __forceinline__ void final_norm(const Ptrs& P, int vcu, int G) {
    const int tid_ = opaque_tid(), lane = tid_ & 63, wave = __builtin_amdgcn_readfirstlane(tid_ >> 6);
    asm volatile("" : "+s"(vcu), "+s"(G));
    const int gw = vcu * NWAVES + wave, NGW = G * NWAVES; const float* fg = P.in(3); const u16* hs = (const u16*)(P.ws + WS_A16);
    u32x4 vn[2];
#pragma unroll
    for (int j = 0; j < 2; ++j) vn[j] = ((const u32x4*)(hs + (size_t)(gw < L ? gw : 0) * D) + lane)[64 * j];
    for (int m = gw; m < L; m += NGW) { u32x4 w[2]; float s = 0.f;
#pragma unroll
        for (int j = 0; j < 2; ++j) w[j] = vn[j];
        { const int mn = (m + NGW < L) ? m + NGW : m; const u32x4* xn_ = (const u32x4*)(hs + (size_t)mn * D) + lane;
#pragma unroll
          for (int j = 0; j < 2; ++j) vn[j] = xn_[64 * j]; }
        float v[2][8];
#pragma unroll
        for (int j = 0; j < 2; ++j) { const unsigned ww[4] = {w[j].x, w[j].y, w[j].z, w[j].w};
#pragma unroll
            for (int k = 0; k < 4; ++k) { const unsigned wk = ww[k]; const h16x2 hh = __builtin_bit_cast(h16x2, wk); v[j][2 * k] = (float)hh[0]; v[j][2 * k + 1] = (float)hh[1]; s += v[j][2 * k] * v[j][2 * k] + v[j][2 * k + 1] * v[j][2 * k + 1]; } }
        const float rs = rsqrtf(wave_sum(s) * (1.f / D) + EPS);
#pragma unroll
        for (int j = 0; j < 2; ++j) { const int c0 = 8 * (lane + 64 * j); const f32x4 g0 = *(const f32x4*)(fg + c0), g1 = *(const f32x4*)(fg + c0 + 4);
            float* o = P.out + (size_t)m * D + c0;
            *(f32x4*)o = (f32x4){v[j][0] * rs * g0[0], v[j][1] * rs * g0[1], v[j][2] * rs * g0[2], v[j][3] * rs * g0[3]};
            *(f32x4*)(o + 4) = (f32x4){v[j][4] * rs * g1[0], v[j][5] * rs * g1[1], v[j][6] * rs * g1[2], v[j][7] * rs * g1[3]}; } }
}

#ifndef CHECK
#define CHECK 0
#endif
constexpr size_t WS_CHK = 251 * MiB;
constexpr int CW_CHK = 2048;
__device__ __forceinline__ void chk_accum(const Ptrs& P, float num, float den) {
    num = wave_sum(num); den = wave_sum(den);
    if ((opaque_tid() & 63) == 0) { float* c = (float*)(P.ws + WS_CTL) + CW_CHK; atomicAdd(c, num); atomicAdd(c + 1, den); }
}
__device__ __forceinline__ void chk_emit(const Ptrs& P, int vcu, int G) {
    const float* c = (const float*)(P.ws + WS_CTL) + CW_CHK; const float num = __hip_atomic_load(c, __ATOMIC_RELAXED, __HIP_MEMORY_SCOPE_AGENT), den = __hip_atomic_load(c + 1, __ATOMIC_RELAXED, __HIP_MEMORY_SCOPE_AGENT);
    const float v = 1000.f * sqrtf(num / fmaxf(den, 1e-30f));
    for (size_t i = (size_t)vcu * NTHR + opaque_tid(); i < (size_t)L * D; i += (size_t)G * NTHR) P.out[i] = v;
}
#if CHECK == 3
constexpr int CHK_T = 2048;
__device__ __forceinline__ void chk_gdn_ref(const Ptrs& P, LAS uchar* lds, int vcu) {
    if (vcu >= 8) return;
    const int tid = opaque_tid(), hd = vcu;
    const u16* RQ = (const u16*)(P.ws + WS_GQ); const float* Gd = (const float*)(P.ws + WS_GG); const float* Bt = (const float*)(P.ws + WS_GBETA);
    const float* cw = P.in(25); u16* ref = (u16*)(P.ws + WS_CHK);
    LAS float* buf = (LAS float*)lds;
    LAS float* sst = buf + 512;
    for (int i = tid; i < 128 * 128; i += NTHR) sst[i] = 0.f;
    __syncthreads();
    const int which = tid >> 7, ch = tid & 127, col = hd * 128 + ch;
    float c0 = 0, c1 = 0, c2 = 0, c3 = 0, x0 = 0, x1 = 0, x2 = 0;
    if (tid < 384) { c0 = cw[0 * 3072 + which * 1024 + col]; c1 = cw[1 * 3072 + which * 1024 + col]; c2 = cw[2 * 3072 + which * 1024 + col]; c3 = cw[3 * 3072 + which * 1024 + col]; }
    const u16* src = RQ + (size_t)which * (16 * MiB) + col;
    for (int t = 0; t < CHK_T; ++t) {
        if (tid < 384) { const float x3 = h2f(src[(size_t)t * 1024]); buf[which * 128 + ch] = siluf_(c0 * x0 + c1 * x1 + c2 * x2 + c3 * x3); x0 = x1; x1 = x2; x2 = x3; }
        __syncthreads();
        if (tid < 128) { const int w = tid >> 6, l = tid & 63; const float a = buf[w * 128 + l], b = buf[w * 128 + l + 64]; const float ss = wave_sum(a * a + b * b); if (l == 0) buf[384 + w] = rsqrtf(ss + EPS); }
        __syncthreads();
        if (tid < 128) { const float rq = buf[384] * GDN_QS, rk = buf[385]; const float eg = __expf(Gd[(size_t)t * 8 + hd]), be = Bt[(size_t)t * 8 + hd];
            float r = 0.f;
            for (int d = 0; d < 128; ++d) { const float sv = sst[d * 128 + tid] * eg; sst[d * 128 + tid] = sv; r += sv * (buf[128 + d] * rk); }
            r = buf[256 + tid] - r; float o = 0.f;
            for (int d = 0; d < 128; ++d) { const float sv = sst[d * 128 + tid] + be * (buf[128 + d] * rk) * r; sst[d * 128 + tid] = sv; o += sv * (buf[d] * rq); }
            ref[((size_t)t * 8 + hd) * 128 + tid] = f2h(o); ((u16*)(P.ws + WS_STAT2))[((size_t)t * 8 + hd) * 128 + tid] = f2h(be * r); }
        __syncthreads();
    }
}
__device__ __forceinline__ void chk_gdn_cmp(const Ptrs& P, int vcu, int G, bool umode) {
    const u16* RV = (const u16*)(P.ws + WS_GV); const u16* ref = (const u16*)(P.ws + (umode ? WS_STAT2 : WS_CHK));
    float num = 0.f, den = 0.f;
    for (int i = vcu * NTHR + opaque_tid(); i < CHK_T * 1024; i += G * NTHR) { const int t = i >> 10, hd = (i >> 7) & 7, dv = i & 127, n = t >> 6, c = t & 63;
        const float mine = h2f(RV[(size_t)(64 * n + (dv >> 1)) * 1024 + hd * 128 + (dv & 1) * 64 + c]), r = h2f(ref[i]); num += (mine - r) * (mine - r); den += r * r; }
    chk_accum(P, num, den);
}
#endif

#if CHECK == 3
__device__ __forceinline__ void chk_gdn_qku(const Ptrs& P, int vcu, int G) {
    const u16* RV = (const u16*)(P.ws + WS_GV); const u16* QK = (const u16*)(P.ws + WS_GQK); u16* ref = (u16*)(P.ws + WS_CHK);
    float num = 0.f, den = 0.f;
    for (int i = vcu * NTHR + opaque_tid(); i < 64 * 1024; i += G * NTHR) { const int t = i >> 10, hd = (i >> 7) & 7, dv = i & 127; float o = 0.f;
        for (int j = 0; j < 64; ++j) o += h2f(QK[(size_t)hd * 4096 + t * 64 + j]) * h2f(RV[(size_t)(dv >> 1) * 1024 + hd * 128 + (dv & 1) * 64 + j]);
#ifdef CHK_W
        { const float r = h2f(ref[i]); num += (o - r) * (o - r); den += r * r; }
#else
        ref[i] = f2h(o);
#endif
    }
#ifdef CHK_W
    chk_accum(P, num, den);
#endif
}
#endif
#if CHECK == 9
__device__ __forceinline__ void chk_mfma(const Ptrs& P) {
    const int lane = opaque_tid() & 63, lo = lane & 15, g = lane >> 4;
    float bad = 0.f;
    { s16x8 a = {0,0,0,0,0,0,0,0}, b = {0,0,0,0,0,0,0,0};
      if (g == 0) { a[0] = (short)f2h((float)lo); b[0] = (short)f2h(1.f); }
      f32x4 d = {0.f, 0.f, 0.f, 0.f}; d = mfma16(a, b, d);
      for (int r = 0; r < 4; ++r) if (d[r] != (float)(4 * g + r)) bad += 1.f; }
    for (int J = 0; J < 32; ++J) {
        f32x4 v0, v1;
        for (int r = 0; r < 4; ++r) { v0[r] = (float)(4 * g + r); v1[r] = (float)(16 + 4 * g + r); }
        const s16x8 Bv = pk2blk(v0, v1);
        s16x8 a = {0,0,0,0,0,0,0,0};
        for (int e = 0; e < 8; ++e) { const int j = 16 * (e >> 2) + 4 * g + (e & 3); a[e] = (j == J) ? (short)f2h(1.f) : (short)0; }
        f32x4 d = {0.f, 0.f, 0.f, 0.f}; d = mfma16(a, Bv, d);
        for (int r = 0; r < 4; ++r) if (d[r] != (float)J) bad += 1000.f;
    }
    bad = wave_sum(bad);
    if (lane == 0) { float* c = (float*)(P.ws + WS_CTL) + CW_CHK; atomicAdd(c, bad); atomicAdd(c + 1, 1.f); }
}
#endif
#ifndef PHM
#define PHM 0xffff
#endif

__global__ void __launch_bounds__(NTHR, 2) fwd(Args args) {
    extern __shared__ __attribute__((aligned(16))) unsigned char lds_[];
    LAS uchar* lds = (LAS uchar*)lds_;
    const int tid = threadIdx.x;
    const int G = gridDim.x, bid = blockIdx.x; const int vcu = (G % 8 == 0) ? (bid % 8) * (G / 8) + bid / 8 : bid;
    Ptrs P; P.ka = (KArgs)__builtin_amdgcn_kernarg_segment_ptr(); P.out = args.out; P.ws = args.ws;
    uchar* ws = args.ws;
    volatile LAS unsigned* MISC = (volatile LAS unsigned*)(lds + MISC_OFF);
    for (int u = tid; u < (LDS_BYTES - MISC_OFF) / 4; u += NTHR) MISC[u] = 0u;
    __syncthreads();
    unsigned* ctl = (unsigned*)(ws + WS_CTL);
    XcdBarrier bar = xcd_barrier_post(ctl + CW_BAR, MISC + 8);
#if TIMING
    unsigned long long* ts_ = (unsigned long long*)(ws + WS_CTL + 65536); int nst_ = 1;
    if (bid == 0 && tid == 0) ts_[0] = __builtin_amdgcn_s_memrealtime();
#define GRID_BAR() do { xcd_barrier(bar); if (bid == 0 && tid == 0) ts_[nst_] = __builtin_amdgcn_s_memrealtime(); ++nst_; } while (0)
#else
#define GRID_BAR() xcd_barrier(bar)
#endif
    LAS float* tabA = (LAS float*)(lds + TABA_OFF); LAS float* tabB = (LAS float*)(lds + TABB_OFF);
    u16* A16 = (u16*)(ws + WS_A16); float* STAT = (float*)(ws + WS_STAT); float* STAT2 = (float*)(ws + WS_STAT2);
    u16* WIN = (u16*)(ws + WS_WIN); u16* WOUT = (u16*)(ws + WS_WOUT); u16* W1 = (u16*)(ws + WS_W1); u16* W2 = (u16*)(ws + WS_W2); u16* HID = (u16*)(ws + WS_HID);
    const f32x2* ROPE = (const f32x2*)(ws + WS_ROPE);
    float* H = args.out;

#if PHM & 1024
#ifndef GMASK
#define GMASK 0xffff
#endif
#define RUN_GEMM(EPI, e_, A_, B_, N_, K_, lda_, ldb_, S_) do { if constexpr ((GMASK >> EPI::ID) & 1) { pg8::Gemm g_{(const u16*)(A_), (const u16*)(B_), L, (N_), (K_), (lda_), (ldb_)}; \
        pg8::gemm_phase<EPI, pg8::StaticOrder, EPI::ALIGN, EPI::SP2>(lds, g_, S_, e_); } } while (0)
#else
#define RUN_GEMM(EPI, e_, A_, B_, N_, K_, lda_, ldb_, S_) do { (void)e_; } while (0)
#endif
#define MLP_UP() { pg8::StaticOrder S; S.init(L, 4096, G, bid); build_tab(tabA, S, STAT, 0, 32, 1.f / 1024.f); EpiUp e{HID, 4096, tabA}; RUN_GEMM(EpiUp, e, A16, W1, 4096, 1024, 1024, 1024, S); } GRID_BAR()
#if REP == 12
#define MLP_UP_REP() MLP_UP()
#else
#define MLP_UP_REP() do {} while (0)
#endif
#if REP == 14
#define MLP_DOWN_REP() { pg8::StaticOrder S; S.init(L, 1024, G, bid); EpiResid e{nullptr, (u16*)(ws + 196 * MiB), nullptr, nullptr}; RUN_GEMM(EpiResid, e, HID, W2, 1024, 4096, 4096, 4096, S); } GRID_BAR()
#else
#define MLP_DOWN_REP() do {} while (0)
#endif
#define MLP_BLOCK() do { \
        MLP_UP(); MLP_UP_REP(); MLP_DOWN_REP(); \
        { pg8::StaticOrder S; S.init(L, 1024, G, bid); EpiResid e{nullptr, A16, STAT, nullptr}; RUN_GEMM(EpiResid, e, HID, W2, 1024, 4096, 4096, 4096, S); } GRID_BAR(); } while (0)

#if CHECK == 9
    if (bid == 0 && tid < 64) chk_mfma(P);
#endif
#if PHM & 1
    prologue_x(P, vcu, G);
    convert_layer<0>(P, lds, vcu, G);
#endif
    GRID_BAR();

    { pg8::StaticOrder S; S.init(L, 3840, G, bid);
      EpiDsaIn e{(const float*)(ws + WS_RSTDX), (u16*)(ws + WS_DQ), (u16*)(ws + WS_DK), (u16*)(ws + WS_DVT), (u16*)(ws + WS_DQI), (u16*)(ws + WS_DKI), (float*)(ws + WS_DWI), P.in(7), P.in(8)};
      RUN_GEMM(EpiDsaIn, e, A16, WIN, 3840, 1024, 1024, 1024, S); }
#if REP == 1
    GRID_BAR();
    { pg8::StaticOrder S; S.init(L, 3840, G, bid);
      EpiDsaIn e{(const float*)(ws + WS_RSTDX), (u16*)(ws + WS_DQ), (u16*)(ws + WS_DK), (u16*)(ws + WS_DVT), (u16*)(ws + WS_DQI), (u16*)(ws + WS_DKI), (float*)(ws + WS_DWI), P.in(7), P.in(8)};
      RUN_GEMM(EpiDsaIn, e, A16, WIN, 3840, 1024, 1024, 1024, S); }
#endif

    GRID_BAR();
#if PHM & 4
    dsa_indexer(P, lds, vcu, G);
#endif
#if REP == 2
    GRID_BAR();
#if PHM & 4
    dsa_indexer(P, lds, vcu, G);
#endif
#endif

    GRID_BAR();
#if PHM & 8
    { const u16* Q = (const u16*)(ws + WS_DQ); const u16* K = (const u16*)(ws + WS_DK); const u16* VT = (const u16*)(ws + WS_DVT); const unsigned* BITS = (const unsigned*)(ws + WS_DBITS); u16* O = (u16*)(ws + WS_DO);
      if (G == 256) { const int head = vcu >> 5, s = vcu & 31;
#pragma unroll 1
          for (int i = 0; i < 2; ++i) { const int qb = i ? 63 - s : s; attn_unit<128, 128, true>(lds, Q + head * 128, 1024, K + head * 128, 1024, nullptr, 0, VT + (size_t)head * 128 * L, BITS, O + head * 128, 1024, qb); } }
      else { for (int j = vcu; j < 8 * 64; j += G) { const int head = j >> 6, qb = j & 63; attn_unit<128, 128, true>(lds, Q + head * 128, 1024, K + head * 128, 1024, nullptr, 0, VT + (size_t)head * 128 * L, BITS, O + head * 128, 1024, qb); } } }
#endif
#if REP == 3
    GRID_BAR();
#if PHM & 8
    { const u16* Q = (const u16*)(ws + WS_DQ); const u16* K = (const u16*)(ws + WS_DK); const u16* VT = (const u16*)(ws + WS_DVT); const unsigned* BITS = (const unsigned*)(ws + WS_DBITS); u16* O = (u16*)(ws + WS_DO);
      if (G == 256) { const int head = vcu >> 5, s = vcu & 31;
#pragma unroll 1
          for (int i = 0; i < 2; ++i) { const int qb = i ? 63 - s : s; attn_unit<128, 128, true>(lds, Q + head * 128, 1024, K + head * 128, 1024, nullptr, 0, VT + (size_t)head * 128 * L, BITS, O + head * 128, 1024, qb); } }
      else { for (int j = vcu; j < 8 * 64; j += G) { const int head = j >> 6, qb = j & 63; attn_unit<128, 128, true>(lds, Q + head * 128, 1024, K + head * 128, 1024, nullptr, 0, VT + (size_t)head * 128 * L, BITS, O + head * 128, 1024, qb); } } }
#endif
#endif

    GRID_BAR();
    { pg8::StaticOrder S; S.init(L, 1024, G, bid); EpiResid e{P.in(0), A16, STAT, nullptr}; RUN_GEMM(EpiResid, e, ws + WS_DO, WOUT, 1024, 1024, 1024, 1024, S); }
#if REP == 4
    GRID_BAR();
    { pg8::StaticOrder S; S.init(L, 1024, G, bid); EpiResid e{P.in(0), A16, STAT, nullptr}; RUN_GEMM(EpiResid, e, ws + WS_DO, WOUT, 1024, 1024, 1024, 1024, S); }
#endif

    GRID_BAR();
    MLP_BLOCK();
#if PHM & 1
    convert_layer<1>(P, lds, vcu, G);
#endif
#if REP == 13
    GRID_BAR();
#if PHM & 1
    convert_layer<1>(P, lds, vcu, G);
#endif
#endif
    GRID_BAR();

#if REP == 20
    GRID_BAR(); GRID_BAR(); GRID_BAR(); GRID_BAR(); GRID_BAR(); GRID_BAR(); GRID_BAR(); GRID_BAR(); GRID_BAR(); GRID_BAR();
#endif
    { pg8::StaticOrder S; S.init(L, 2048, G, bid); build_tab(tabA, S, STAT, 0, 32, 1.f / 1024.f); EpiGlu e{(u16*)(ws + WS_CU), P.in(11), tabA}; RUN_GEMM(EpiGlu, e, A16, WIN, 2048, 1024, 1024, 1024, S); }
#if REP == 5
    GRID_BAR();
    { pg8::StaticOrder S; S.init(L, 2048, G, bid); build_tab(tabA, S, STAT, 0, 32, 1.f / 1024.f); EpiGlu e{(u16*)(ws + WS_CU), P.in(11), tabA}; RUN_GEMM(EpiGlu, e, A16, WIN, 2048, 1024, 1024, 1024, S); }
#endif

    GRID_BAR();
#if PHM & 32
    conv_dw_phase(P, lds, vcu, G);
#endif
#if REP == 6
    GRID_BAR();
#if PHM & 32
    conv_dw_phase(P, lds, vcu, G);
#endif
#endif

    GRID_BAR();
#if !(SKIPMIX & 2)
    { pg8::StaticOrder S; S.init(L, 1024, G, bid); EpiResid e{nullptr, A16, STAT, P.in(17)}; RUN_GEMM(EpiResid, e, ws + WS_CL, WOUT, 1024, 1024, 1024, 1024, S); }
#endif
    GRID_BAR();
    MLP_BLOCK();
#if PHM & 1
    convert_layer<2>(P, lds, vcu, G);
#endif
    GRID_BAR();

    { pg8::StaticOrder S; S.init(L, 768, G, bid); build_tab(tabA, S, STAT, 0, 32, 1.f / 1024.f);
      EpiMlaIn e{(u16*)(ws + WS_MP), (u16*)(ws + WS_MKR), STAT2, ROPE, tabA}; RUN_GEMM(EpiMlaIn, e, A16, WIN, 768, 1024, 1024, 1024, S); }
#if REP == 7
    GRID_BAR();
    { pg8::StaticOrder S; S.init(L, 768, G, bid); build_tab(tabA, S, STAT, 0, 32, 1.f / 1024.f);
      EpiMlaIn e{(u16*)(ws + WS_MP), (u16*)(ws + WS_MKR), STAT2, ROPE, tabA}; RUN_GEMM(EpiMlaIn, e, A16, WIN, 768, 1024, 1024, 1024, S); }
#endif

    GRID_BAR();
    { pg8::StaticOrder S; S.init(L, 1536, G, bid); build_tab(tabA, S, STAT2, 0, 12, 1.f / 384.f);
      EpiMlaUq e{(u16*)(ws + WS_MQ), ROPE, tabA}; RUN_GEMM(EpiMlaUq, e, ws + WS_MP, ws + WS_WB, 1536, 384, 640, 384, S); }
    { pg8::StaticOrder S; S.init(L, 2048, G, bid); build_tab(tabB, S, STAT2, 12, 20, 1.f / 256.f);
      EpiMlaUkv e{(u16*)(ws + WS_MKN), (u16*)(ws + WS_MVT), tabB}; RUN_GEMM(EpiMlaUkv, e, (u16*)(ws + WS_MP) + 384, ws + WS_WC, 2048, 256, 640, 256, S); }
#if REP == 8
    GRID_BAR();
    { pg8::StaticOrder S; S.init(L, 1536, G, bid); build_tab(tabA, S, STAT2, 0, 12, 1.f / 384.f);
      EpiMlaUq e{(u16*)(ws + WS_MQ), ROPE, tabA}; RUN_GEMM(EpiMlaUq, e, ws + WS_MP, ws + WS_WB, 1536, 384, 640, 384, S); }
    { pg8::StaticOrder S; S.init(L, 2048, G, bid); build_tab(tabB, S, STAT2, 12, 20, 1.f / 256.f);
      EpiMlaUkv e{(u16*)(ws + WS_MKN), (u16*)(ws + WS_MVT), tabB}; RUN_GEMM(EpiMlaUkv, e, (u16*)(ws + WS_MP) + 384, ws + WS_WC, 2048, 256, 640, 256, S); }
#endif

    GRID_BAR();
#if PHM & 16
    { const u16* Q = (const u16*)(ws + WS_MQ); const u16* KN = (const u16*)(ws + WS_MKN); const u16* KR = (const u16*)(ws + WS_MKR); const u16* VT = (const u16*)(ws + WS_MVT); u16* O = (u16*)(ws + WS_MO);
      if (G == 256) { const int head = vcu >> 4, s = vcu & 15;
#pragma unroll 1
          for (int i = 0; i < 4; ++i) { const int qb = (i == 0) ? s : (i == 1) ? 31 - s : (i == 2) ? 32 + s : 63 - s;
              attn_unit<96, 64, false>(lds, Q + head * 96, 1536, KN + head * 64, 1024, KR, 32, VT + (size_t)head * 64 * L, nullptr, O + head * 64, 1024, qb); } }
      else { for (int j = vcu; j < 16 * 64; j += G) { const int head = j >> 6, qb = j & 63; attn_unit<96, 64, false>(lds, Q + head * 96, 1536, KN + head * 64, 1024, KR, 32, VT + (size_t)head * 64 * L, nullptr, O + head * 64, 1024, qb); } } }
#endif
#if REP == 9
    GRID_BAR();
#if PHM & 16
    { const u16* Q = (const u16*)(ws + WS_MQ); const u16* KN = (const u16*)(ws + WS_MKN); const u16* KR = (const u16*)(ws + WS_MKR); const u16* VT = (const u16*)(ws + WS_MVT); u16* O = (u16*)(ws + WS_MO);
      if (G == 256) { const int head = vcu >> 4, s = vcu & 15;
#pragma unroll 1
          for (int i = 0; i < 4; ++i) { const int qb = (i == 0) ? s : (i == 1) ? 31 - s : (i == 2) ? 32 + s : 63 - s;
              attn_unit<96, 64, false>(lds, Q + head * 96, 1536, KN + head * 64, 1024, KR, 32, VT + (size_t)head * 64 * L, nullptr, O + head * 64, 1024, qb); } }
      else { for (int j = vcu; j < 16 * 64; j += G) { const int head = j >> 6, qb = j & 63; attn_unit<96, 64, false>(lds, Q + head * 96, 1536, KN + head * 64, 1024, KR, 32, VT + (size_t)head * 64 * L, nullptr, O + head * 64, 1024, qb); } } }
#endif
#endif

    GRID_BAR();
#if !(SKIPMIX & 4)
    { pg8::StaticOrder S; S.init(L, 1024, G, bid); EpiResid e{nullptr, A16, STAT, nullptr}; RUN_GEMM(EpiResid, e, ws + WS_MO, WOUT, 1024, 1024, 1024, 1024, S); }
#endif
    GRID_BAR();
    MLP_BLOCK();
#if PHM & 1
    convert_layer<3>(P, lds, vcu, G);
#endif
    GRID_BAR();

    { pg8::StaticOrder S; S.init(L, 3072, G, bid); build_tab(tabA, S, STAT, 0, 32, 1.f / 1024.f);
      EpiScale16 e{(u16*)(ws + WS_GQ), 1024, (size_t)16 * MiB, tabA}; RUN_GEMM(EpiScale16, e, A16, WIN, 3072, 1024, 1024, 1024, S); }
    { pg8::StaticOrder S; S.init(L, 1024, G, bid); build_tab(tabB, S, STAT, 0, 32, 1.f / 1024.f);
      EpiScale16 e{(u16*)(ws + WS_GGATE), 1024, (size_t)0, tabB}; RUN_GEMM(EpiScale16, e, A16, ws + WS_WD, 1024, 1024, 1024, 1024, S); }
#if REP == 10
    GRID_BAR();
    { pg8::StaticOrder S; S.init(L, 3072, G, bid); build_tab(tabA, S, STAT, 0, 32, 1.f / 1024.f);
      EpiScale16 e{(u16*)(ws + WS_GQ), 1024, (size_t)16 * MiB, tabA}; RUN_GEMM(EpiScale16, e, A16, WIN, 3072, 1024, 1024, 1024, S); }
    { pg8::StaticOrder S; S.init(L, 1024, G, bid); build_tab(tabB, S, STAT, 0, 32, 1.f / 1024.f);
      EpiScale16 e{(u16*)(ws + WS_GGATE), 1024, (size_t)0, tabB}; RUN_GEMM(EpiScale16, e, A16, ws + WS_WD, 1024, 1024, 1024, 1024, S); }
#endif

    GRID_BAR();
#if PHM & 64
    gdn_pre(P, vcu, G);
#endif
#if REP == 11
    GRID_BAR();
#if PHM & 64
    gdn_pre(P, vcu, G);
#endif
#endif

    GRID_BAR();
#if CHECK == 3
    chk_gdn_ref(P, lds, vcu);
    GRID_BAR();
#endif
#if PHM & 128
    gdn_chunk(P, lds, vcu, G);
#endif
    GRID_BAR();
#if CHECK == 3 && defined(CHK_V)
    chk_gdn_qku(P, vcu, G);
    GRID_BAR();
#endif
#if CHECK == 3 && defined(CHK_U)
    chk_gdn_cmp(P, vcu, G, true);
    GRID_BAR();
#endif
#if PHM & 256
    for (int c = 0; c < 64; ++c) if ((4 * c) % G == vcu) gdn_scan2(P, lds, c);
#if REP == 15
    GRID_BAR();
    for (int c = 0; c < 64; ++c) if ((4 * c) % G == vcu) gdn_scan2(P, lds, c);
#endif
#endif
    GRID_BAR();
#if CHECK == 3 && !defined(CHK_U) && !defined(CHK_W)
    chk_gdn_cmp(P, vcu, G, false);
    GRID_BAR();
#endif
#if PHM & 512
    gdn_out(P, lds, vcu, G);
#endif
    GRID_BAR();
#if !(SKIPMIX & 8)
    { pg8::StaticOrder S; S.init(L, 1024, G, bid); EpiResid e{nullptr, A16, STAT, nullptr}; RUN_GEMM(EpiResid, e, ws + WS_GGATE, WOUT, 1024, 1024, 1024, 1024, S); }
#endif
    GRID_BAR();
    MLP_BLOCK();
#if PHM & 1
    final_norm(P, vcu, G);
#endif
#if CHECK
    GRID_BAR();
    chk_emit(P, vcu, G);
#endif
#if TIMING
    GRID_BAR();
    { float ta = (float)(long long)(ts_[TA1] - ts_[TA0]) * 0.01f, tb = (float)(long long)(ts_[TB1] - ts_[TB0]) * 0.01f;
      ta = floorf((ta + TQOFF) / TQ) * TQ; tb = floorf((tb + TQOFF) / TQ) * TQ;
      const float ca = sqrtf(ta * 0.1f), cb = tb;
      for (size_t i = (size_t)vcu * NTHR + opaque_tid(); i < (size_t)L * D; i += (size_t)G * NTHR) H[i] = (i == 12345) ? cb : ca; }
#endif
}

extern "C" void kernel_launch(void* const* d_in, const int* in_sizes, int n_in, void* d_out, int out_size, void* d_ws, size_t ws_size, hipStream_t stream) {
    static int grid = 0;
    if (grid == 0) {
        if (n_in != 30 || in_sizes[0] != L * D || out_size != L * D || ws_size < WS_END) { fprintf(stderr, "kernel_launch: unexpected shapes (n_in %d, in0 %d, out %d, ws %zu); nothing launched\n", n_in, n_in > 0 ? in_sizes[0] : -1, out_size, ws_size); grid = -1; return; }
        int dev = 0, cus = 0, per_cu = 0;
        if (hipGetDevice(&dev) != hipSuccess || hipDeviceGetAttribute(&cus, hipDeviceAttributeMultiprocessorCount, dev) != hipSuccess) { grid = -1; return; }
        if (hipFuncSetAttribute((const void*)fwd, hipFuncAttributeMaxDynamicSharedMemorySize, LDS_BYTES) != hipSuccess) { fprintf(stderr, "kernel_launch: hipFuncSetAttribute failed\n"); grid = -1; return; }
        if (hipOccupancyMaxActiveBlocksPerMultiprocessor(&per_cu, (const void*)fwd, NTHR, LDS_BYTES) != hipSuccess || per_cu < 1) fprintf(stderr, "kernel_launch: occupancy query reports %d workgroups per CU\n", per_cu);
        (void)hipGetLastError();
        grid = cus;
    }
    if (grid < 0) return;
    if (hipMemsetAsync((char*)d_ws + WS_CTL, 0, CTL_ZERO_BYTES, stream) != hipSuccess) return;
    Args a{};
    for (int i = 0; i < 30; ++i) a.in[i] = (const float*)d_in[i];
    a.out = (float*)d_out; a.ws = (uchar*)d_ws;
    hipLaunchKernelGGL(fwd, dim3(grid), dim3(NTHR), LDS_BYTES, stream, a);
}
```

```cpp
#include <hip/hip_runtime.h>
#include <cstdio>
#include <cstdint>
#ifndef CHREP
#define CHREP 0
#endif
#ifndef IDXREP
#define IDXREP 0
#endif
#ifndef REP
#define REP 0
#endif
#ifndef TIMING
#define TIMING 0
#endif
#ifndef SKIPMIX
#define SKIPMIX 0
#endif

#define GAS __attribute__((address_space(1)))
#define LAS __attribute__((address_space(3)))
typedef unsigned short u16;
typedef unsigned char uchar;
typedef short s16x8 __attribute__((ext_vector_type(8)));
typedef short s16x4 __attribute__((ext_vector_type(4)));
typedef _Float16 h16x8 __attribute__((ext_vector_type(8)));
typedef _Float16 h16x2 __attribute__((ext_vector_type(2)));
typedef float f32x2 __attribute__((ext_vector_type(2)));
typedef float f32x4 __attribute__((ext_vector_type(4)));
typedef float f32x16 __attribute__((ext_vector_type(16)));
typedef unsigned u32x2 __attribute__((ext_vector_type(2)));
typedef unsigned u32x4 __attribute__((ext_vector_type(4)));

__device__ __forceinline__ unsigned pk16(float lo, float hi) { h16x2 v = {(_Float16)lo, (_Float16)hi}; return __builtin_bit_cast(unsigned, v); }
__device__ __forceinline__ u16 f2h(float f) { _Float16 h = (_Float16)f; return __builtin_bit_cast(u16, h); }
__device__ __forceinline__ float h2f(u16 u) { return (float)__builtin_bit_cast(_Float16, u); }
__device__ __forceinline__ f32x4 mfma16(s16x8 a, s16x8 b, f32x4 c) { return __builtin_amdgcn_mfma_f32_16x16x32_f16(__builtin_bit_cast(h16x8, a), __builtin_bit_cast(h16x8, b), c, 0, 0, 0); }
__device__ __forceinline__ f32x16 mfma32(s16x8 a, s16x8 b, f32x16 c) { return __builtin_amdgcn_mfma_f32_32x32x16_f16(__builtin_bit_cast(h16x8, a), __builtin_bit_cast(h16x8, b), c, 0, 0, 0); }
__device__ __forceinline__ u32x4 pack8(f32x4 a, f32x4 b) { u32x4 w; w.x = pk16(a[0], a[1]); w.y = pk16(a[2], a[3]); w.z = pk16(b[0], b[1]); w.w = pk16(b[2], b[3]); return w; }
__device__ __forceinline__ float wave_sum(float v) {
#pragma unroll
    for (int o = 1; o < 64; o <<= 1) v += __shfl_xor(v, o);
    return v;
}
__device__ __forceinline__ float sigmoidf_(float x) { return __builtin_amdgcn_rcpf(1.f + __builtin_amdgcn_exp2f(-1.4426950408889634f * x)); }
__device__ __forceinline__ float siluf_(float x) { return x * __builtin_amdgcn_rcpf(1.f + __builtin_amdgcn_exp2f(-1.4426950408889634f * x)); }

__device__ __forceinline__ int opaque_tid() { int t = threadIdx.x; asm volatile("" : "+v"(t)); return t; }

__device__ __forceinline__ float max3f_(float a, float b, float c) { float r; asm("v_max3_f32 %0, %1, %2, %3" : "=v"(r) : "v"(a), "v"(b), "v"(c)); return r; }

namespace pg8 {
#define PG8_LAS __attribute__((address_space(3)))
typedef unsigned short bf16_t;
typedef short bf16x8 __attribute__((ext_vector_type(8)));
typedef float f32x4 __attribute__((ext_vector_type(4)));
typedef unsigned u32x4 __attribute__((ext_vector_type(4)));
constexpr int BM = 256, BK = 64, HALF = 128, HTB = HALF * BK * 2  , STAGE_BYTES = 8 * HTB, NXCD = 8, WGM = 8;

__host__ __device__ __forceinline__ int lds_byte(int r, int c) { const int st = (r >> 4) * 2 + (c >> 5), rr = r & 15, cc = c & 31, ob = rr * 64 + cc * 2; return st * 1024 + (ob ^ (((ob >> 9) & 1) << 5)); }
__host__ __device__ __forceinline__ void stage_rc(int b, int& R, int& C) { const int st = b / 1024, sb = b % 1024, swz = sb ^ (((sb >> 9) & 1) << 5); R = (st >> 1) * 16 + swz / 64; C = (st & 1) * 32 + (swz % 64) / 2; }
__host__ __device__ __forceinline__ int perm32(int rho) { const int n = rho >> 4, i = rho & 15; return 8 * (i >> 2) + 4 * n + (i & 3); }

struct Unit { int pm, pn; };
struct Gemm { const bf16_t* A; const bf16_t* Bt; int M, N, K, lda, ldb; };

struct StaticOrder {
    int nM, nN, nwg, G, c;
    __host__ __device__ void init(int M, int N, int G_, int c_) { nM = M / BM; nN = N / BM; nwg = nM * nN; G = G_; c = c_; }
    __host__ __device__ bool next(int i, Unit& u) const {
        const long L = (long)i * G + c; if (L >= nwg) return false;
        int wgid = (int)L; { const int q = nwg / NXCD, r = nwg % NXCD, xcd = wgid % NXCD, off = wgid / NXCD; wgid = (xcd < r ? xcd * (q + 1) : r * (q + 1) + (xcd - r) * q) + off; }
        const int nig = WGM * nN, gid = wgid / nig, fm = gid * WGM, gsz = (nM - fm) < WGM ? (nM - fm) : WGM;
        u.pm = fm + ((wgid % nig) % gsz); u.pn = (wgid % nig) / gsz; return true;
    }
    __device__ __forceinline__ void a_ready(const Unit&) const {}
    __device__ __forceinline__ void done(const Unit&) const {}
};

template <class Epi, class Sched, bool ALIGN_EPI = false, bool SP2 = false>
__device__ __forceinline__ void gemm_phase(PG8_LAS unsigned char* lds, const Gemm g, const Sched& S, const Epi& E) {
    int tid = threadIdx.x; asm volatile("" : "+v"(tid));
    const int wid = __builtin_amdgcn_readfirstlane(tid >> 6), lane = tid & 63, wr = wid >> 2, wc = wid & 3, fr = lane & 15, fq = lane >> 4;
    const int K = g.K, nt = K / BK, lda = g.lda, ldb = g.ldb;
    unsigned voffA[2], voffB[2];
#pragma unroll
    for (int i = 0; i < 2; ++i) { int R, C; stage_rc(tid * 16 + i * 8192, R, C); const int Rb = Epi::PERM ? ((R & ~31) + perm32(R & 31)) : R;
        voffA[i] = (unsigned)(R * lda + C) * 2u; voffB[i] = (unsigned)(Rb * ldb + C) * 2u; }
    const size_t kstep = (size_t)(BK * 2);
    const size_t hstepA = (size_t)HALF * lda * 2, hstepB = (size_t)HALF * ldb * 2;
    const size_t tstepA = 2 * hstepA, tstepB = 2 * hstepB;
    const unsigned ldsw = (unsigned)wid * 1024u;
    const int aoff = lds_byte(wr * 64 + fr, fq * 8), boff = lds_byte(wc * 32 + fr, fq * 8);
#define PG8_SA(b, h) (((b) * 2 + (h)) * HTB)
#define PG8_SB(b, h) ((4 + (b) * 2 + (h)) * HTB)
#define PG8_STAGE(bufoff, gbase, voff) do { _Pragma("unroll") for (int _i = 0; _i < 2; ++_i) \
        __builtin_amdgcn_global_load_lds((const unsigned*)((const char*)(gbase) + (voff)[_i]), (PG8_LAS unsigned*)(lds + (bufoff) + ldsw + _i * 8192), 16, 0, 0); } while (0)
#define PG8_LDA(dst, b, h) do { _Pragma("unroll") for (int m = 0; m < 4; ++m) _Pragma("unroll") for (int k = 0; k < 2; ++k) dst[m][k] = *(const PG8_LAS bf16x8*)(lds + PG8_SA(b, h) + aoff + m * 2048 + k * 1024); } while (0)
#define PG8_LDB(dst, b, h) do { _Pragma("unroll") for (int n = 0; n < 2; ++n) _Pragma("unroll") for (int k = 0; k < 2; ++k) dst[n][k] = *(const PG8_LAS bf16x8*)(lds + PG8_SB(b, h) + boff + n * 2048 + k * 1024); } while (0)
#define PG8_MMA(ai, bj, At, Bt) do { __builtin_amdgcn_s_setprio(1); _Pragma("unroll") for (int m = 0; m < 4; ++m) _Pragma("unroll") for (int n = 0; n < 2; ++n) _Pragma("unroll") for (int k = 0; k < 2; ++k) \
        acc[ai][bj][m][n] = mfma16(Bt[n][k], At[m][k], acc[ai][bj][m][n]); __builtin_amdgcn_s_setprio(0); } while (0)
#define PG8_WAIT_V(n) asm volatile("s_waitcnt vmcnt(" #n ")" ::: "memory")
#define PG8_WAIT_L(n) asm volatile("s_waitcnt lgkmcnt(" #n ")" ::: "memory")
#define PG8_BAR __builtin_amdgcn_s_barrier()
#define PG8_SCHED __builtin_amdgcn_sched_barrier(0)
    Unit cur, nxt; int ui = 0;
    if (!S.next(0, cur)) return;
    f32x4 acc[2][2][4][2];
#pragma unroll
    for (int a = 0; a < 2; ++a)
#pragma unroll
        for (int b = 0; b < 2; ++b)
#pragma unroll
            for (int m = 0; m < 4; ++m)
#pragma unroll
                for (int n = 0; n < 2; ++n) acc[a][b][m][n] = (f32x4){0.f, 0.f, 0.f, 0.f};
    bf16x8 At[4][2], B0[2][2], B1[2][2];
    const char* cA = (const char*)g.A + (size_t)cur.pm * tstepA; const char* cB = (const char*)g.Bt + (size_t)cur.pn * tstepB;
    S.a_ready(cur);
    if constexpr (SP2) {
        PG8_STAGE(PG8_SB(0, 0), cB, voffB); PG8_STAGE(PG8_SB(0, 1), cB + hstepB, voffB); PG8_STAGE(PG8_SA(0, 0), cA, voffA); PG8_STAGE(PG8_SA(0, 1), cA + hstepA, voffA);
        if (wr == 1) PG8_BAR;
        PG8_WAIT_V(2); PG8_BAR;
        PG8_STAGE(PG8_SB(1, 0), cB + kstep, voffB); PG8_STAGE(PG8_SA(1, 0), cA + kstep, voffA); PG8_STAGE(PG8_SB(1, 1), cB + hstepB + kstep, voffB);
        PG8_WAIT_V(6); PG8_BAR;
    } else {
        PG8_STAGE(PG8_SB(0, 0), cB, voffB); PG8_STAGE(PG8_SA(0, 0), cA, voffA); PG8_STAGE(PG8_SB(0, 1), cB + hstepB, voffB); PG8_STAGE(PG8_SA(0, 1), cA + hstepA, voffA);
        if (wr == 1) PG8_BAR;
        PG8_WAIT_V(4); PG8_BAR;
        PG8_STAGE(PG8_SB(1, 0), cB + kstep, voffB); PG8_STAGE(PG8_SA(1, 0), cA + kstep, voffA); PG8_STAGE(PG8_SB(1, 1), cB + hstepB + kstep, voffB);
        PG8_WAIT_V(6); PG8_BAR;
    }
    for (;;) {
        const bool has_next = S.next(ui + 1, nxt);
        const char* nA = has_next ? (const char*)g.A + (size_t)nxt.pm * tstepA : cA; const char* nB = has_next ? (const char*)g.Bt + (size_t)nxt.pn * tstepB : cB;
#pragma unroll 1
        for (int t = 0; t < nt; t += 2) {
            const bool last = (t == nt - 2);
            const char* a1 = cA + (size_t)(t + 1) * kstep;
            const char* a2 = last ? nA : cA + (size_t)(t + 2) * kstep; const char* b2 = last ? nB : cB + (size_t)(t + 2) * kstep;
            const char* a3 = a2 + kstep; const char* b3 = b2 + kstep;
            if (last && has_next) S.a_ready(nxt);
            if constexpr (SP2) {
            PG8_LDB(B0, 0, 0); PG8_LDB(B1, 0, 1); PG8_SCHED; PG8_LDA(At, 0, 0); PG8_STAGE(PG8_SA(1, 1), a1 + hstepA, voffA);
            PG8_WAIT_V(8); PG8_WAIT_L(0); PG8_BAR; PG8_MMA(0, 0, At, B0); PG8_MMA(0, 1, At, B1); PG8_BAR; PG8_SCHED;
            PG8_LDA(At, 0, 1); PG8_STAGE(PG8_SB(0, 0), b2, voffB); PG8_STAGE(PG8_SB(0, 1), b2 + hstepB, voffB); PG8_STAGE(PG8_SA(0, 0), a2, voffA);
            PG8_WAIT_V(8); PG8_WAIT_L(0); PG8_BAR; PG8_MMA(1, 0, At, B0); PG8_MMA(1, 1, At, B1); PG8_BAR; PG8_SCHED;
            PG8_LDB(B0, 1, 0); PG8_LDB(B1, 1, 1); PG8_SCHED; PG8_LDA(At, 1, 0); PG8_STAGE(PG8_SA(0, 1), a2 + hstepA, voffA);
            PG8_WAIT_V(8); PG8_WAIT_L(0); PG8_BAR; PG8_MMA(0, 0, At, B0); PG8_MMA(0, 1, At, B1); PG8_BAR; PG8_SCHED;
            PG8_LDA(At, 1, 1); PG8_STAGE(PG8_SB(1, 0), b3, voffB); PG8_STAGE(PG8_SB(1, 1), b3 + hstepB, voffB); PG8_STAGE(PG8_SA(1, 0), a3, voffA);
            PG8_WAIT_V(8); PG8_WAIT_L(0); PG8_BAR; PG8_MMA(1, 0, At, B0); PG8_MMA(1, 1, At, B1); PG8_BAR; PG8_SCHED;
            } else {
            PG8_LDB(B0, 0, 0); PG8_SCHED; PG8_LDA(At, 0, 0); PG8_STAGE(PG8_SA(1, 1), a1 + hstepA, voffA);
            PG8_WAIT_L(8); PG8_BAR; PG8_WAIT_L(0); PG8_MMA(0, 0, At, B0); PG8_BAR; PG8_SCHED;
            PG8_LDB(B1, 0, 1); PG8_STAGE(PG8_SB(0, 0), b2, voffB);
            PG8_BAR; PG8_WAIT_L(0); PG8_MMA(0, 1, At, B1); PG8_BAR;
            PG8_LDA(At, 0, 1); PG8_STAGE(PG8_SA(0, 0), a2, voffA);
            PG8_BAR; PG8_WAIT_L(0); PG8_MMA(1, 0, At, B0); PG8_BAR; PG8_SCHED;
            PG8_STAGE(PG8_SB(0, 1), b2 + hstepB, voffB);
            PG8_WAIT_V(6); PG8_BAR; PG8_MMA(1, 1, At, B1); PG8_BAR;
            PG8_LDB(B0, 1, 0); PG8_SCHED; PG8_LDA(At, 1, 0); PG8_STAGE(PG8_SA(0, 1), a2 + hstepA, voffA);
            PG8_WAIT_L(8); PG8_BAR; PG8_WAIT_L(0); PG8_MMA(0, 0, At, B0); PG8_BAR; PG8_SCHED;
            PG8_LDB(B1, 1, 1); PG8_STAGE(PG8_SB(1, 0), b3, voffB);
            PG8_BAR; PG8_WAIT_L(0); PG8_MMA(0, 1, At, B1); PG8_BAR;
            PG8_LDA(At, 1, 1); PG8_STAGE(PG8_SA(1, 0), a3, voffA);
            PG8_BAR; PG8_WAIT_L(0); PG8_MMA(1, 0, At, B0); PG8_BAR; PG8_SCHED;
            PG8_STAGE(PG8_SB(1, 1), b3 + hstepB, voffB);
            PG8_WAIT_V(6); PG8_BAR; PG8_MMA(1, 1, At, B1); PG8_BAR;
            }
        }
        if constexpr (ALIGN_EPI) { if (wr == 0) PG8_BAR; }
        if constexpr (!Epi::AFTER_DRAIN) { E(acc, cur, ui, wr, wc, fr, fq); S.done(cur); }
        if (!has_next) break;
#pragma unroll
        for (int a = 0; a < 2; ++a)
#pragma unroll
            for (int b = 0; b < 2; ++b)
#pragma unroll
                for (int m = 0; m < 4; ++m)
#pragma unroll
                    for (int n = 0; n < 2; ++n) acc[a][b][m][n] = (f32x4){0.f, 0.f, 0.f, 0.f};
        cur = nxt; cA = nA; cB = nB; ++ui;
        if constexpr (ALIGN_EPI) { if (wr == 1) PG8_BAR; }
    }
    PG8_WAIT_V(0);
    if constexpr (!ALIGN_EPI) { if (wr == 0) PG8_BAR; }
    PG8_BAR;
    if constexpr (Epi::AFTER_DRAIN) { E.fused(acc, cur, wr, wc, fr, fq, lds, wid, lane); S.done(cur); }
#undef PG8_SA
#undef PG8_SB
#undef PG8_STAGE
#undef PG8_LDA
#undef PG8_LDB
#undef PG8_MMA
#undef PG8_WAIT_V
#undef PG8_WAIT_L
#undef PG8_BAR
#undef PG8_SCHED
}
}

using pg8::Unit;
constexpr int L = 16384, D = 1024, FF = 4096, NWAVES = 8, NTHR = 512;
constexpr float EPS = 1e-6f;
constexpr float LOG2E = 1.4426950408889634f;
constexpr float QS_DSA = 0.08838834764831845f * LOG2E;
constexpr float QS_MLA = 0.10206207261596575f * LOG2E;
constexpr float WI_SCALE = 0.04419417382415922f;
constexpr float GDN_QS = 0.08838834764831845f;
#define NEG_INF (-__builtin_inff())

constexpr size_t MiB = 1u << 20;
constexpr size_t WS_CTL = 0, CTL_ZERO_BYTES = 1 * MiB;
constexpr size_t WS_ROPE = 1 * MiB;
constexpr size_t WS_STAT = 3 * MiB;
constexpr size_t WS_STAT2 = 5 * MiB;
constexpr size_t WS_RSTDX = 7 * MiB;
constexpr size_t WS_WIN = 8 * MiB;
constexpr size_t WS_WB = 10 * MiB, WS_WC = 12 * MiB, WS_WD = 14 * MiB;
constexpr size_t WS_WOUT = 16 * MiB;
constexpr size_t WS_W1 = 20 * MiB, WS_W2 = 28 * MiB;
constexpr size_t WS_A16 = 36 * MiB;
constexpr size_t WS_ACT = 68 * MiB;
constexpr size_t WS_HID = WS_ACT;
constexpr size_t WS_DQ = 68 * MiB, WS_DK = 100 * MiB, WS_DVT = 132 * MiB, WS_DQI = 164 * MiB, WS_DKI = 180 * MiB, WS_DWI = 182 * MiB, WS_DBITS = 188 * MiB, WS_DO = 220 * MiB;
constexpr size_t WS_CU = 68 * MiB, WS_CL = 100 * MiB;
constexpr size_t WS_MP = 68 * MiB, WS_MKR = 88 * MiB, WS_MQ = 90 * MiB, WS_MKN = 138 * MiB, WS_MVT = 170 * MiB, WS_MO = 202 * MiB;
constexpr size_t WS_GQ = 68 * MiB, WS_GK = 100 * MiB, WS_GV = 132 * MiB, WS_GW = 164 * MiB, WS_GQK = 196 * MiB, WS_GHALO = 212 * MiB, WS_GG = 217 * MiB, WS_GBETA = WS_GG + 512 * 1024, WS_GGL = 218 * MiB, WS_GGATE = 219 * MiB;
constexpr size_t WS_END = 256 * MiB;
constexpr int CW_TMO = 0, CW_BAR = 4096;

constexpr int RING_BYTES = 131072;
constexpr int TABA_OFF = 131072, TABB_OFF = 139264, MISC_OFF = 147456, LDS_BYTES = 148480;

typedef GAS unsigned gu32;
#define RLX_AGENT __ATOMIC_RELAXED, __HIP_MEMORY_SCOPE_AGENT
#define XB_TMO      128
#define XB_XCNT(j)  (256  + 64 * (j))
#define XB_XSUB(j)  (1280 + 64 * (j))
#define XB_XGEN(j)  (2304 + 64 * (j))
#define XB_TOP      3328
#define XB_TOPGEN   3392
#define XCD_BAR_WORDS 3456
#define XB_SPIN_CAP (1u << 18)

__device__ __forceinline__ unsigned xb_ld(unsigned* p)              { return __hip_atomic_load(p, __ATOMIC_RELAXED, __HIP_MEMORY_SCOPE_AGENT); }
__device__ __forceinline__ unsigned xb_add(unsigned* p, unsigned v) { return __hip_atomic_fetch_add(p, v, __ATOMIC_RELAXED, __HIP_MEMORY_SCOPE_AGENT); }
__device__ __forceinline__ unsigned xb_xcc_id() { return (unsigned)__builtin_amdgcn_s_getreg((3 << 11) | 20) & 0xFu; }
#define XB_SPIN(cond, bar) do { unsigned _sp = 0; while (cond) { __builtin_amdgcn_s_sleep(1); \
    if ((++_sp & 255u) == 0u) { if (xb_ld(&(bar)[XB_TMO])) break; if (_sp > XB_SPIN_CAP) { atomicAdd(&(bar)[XB_TMO], 1u); break; } } } } while (0)

struct XcdBarrier {
    unsigned* bar; unsigned x;
    volatile LAS unsigned* st;
};

__device__ __forceinline__ XcdBarrier xcd_barrier_post(unsigned* bar, volatile LAS unsigned* st) {
    XcdBarrier b; b.bar = bar; b.x = xb_xcc_id(); b.st = st;
    if (threadIdx.x == 0) (void)xb_add(&bar[XB_XCNT(b.x)], 1u);
    return b;
}
__device__ __forceinline__ void xcd_barrier_complete(unsigned* bar, unsigned x, unsigned& nloc, unsigned& nx) {
    const unsigned G = gridDim.x * gridDim.y * gridDim.z;
    unsigned sum, cnt, mine, sp = 0u;
    for (;;) {
        sum = 0u; cnt = 0u; mine = 0u;
#pragma unroll
        for (unsigned j = 0; j < 16; ++j) { const unsigned c = xb_ld(&bar[XB_XCNT(j)]); sum += c; cnt += (c > 0u) ? 1u : 0u; mine = (j == x) ? c : mine; }
        if (sum == G) break;
        __builtin_amdgcn_s_sleep(1);
        if ((++sp & 255u) == 0u) { if (xb_ld(&bar[XB_TMO])) break; if (sp > XB_SPIN_CAP) { atomicAdd(&bar[XB_TMO], 1u); break; } }
    }
    nloc = mine > 0u ? mine : 1u; nx = cnt > 0u ? cnt : 1u;
}

__device__ __forceinline__ void xcd_barrier(const XcdBarrier& b) {
    asm volatile("s_waitcnt vmcnt(0)" ::: "memory");
    __syncthreads();
    if (threadIdx.x == 0) {
        unsigned* bar = b.bar;
        __builtin_amdgcn_s_waitcnt(0);
        unsigned nloc = b.st[0], nx = b.st[1];
        if (nloc == 0u) { xcd_barrier_complete(bar, b.x, nloc, nx); b.st[0] = nloc; b.st[1] = nx; }
        const unsigned old = xb_add(&bar[XB_XSUB(b.x)], 1u);
        const unsigned gen = old / nloc;
        if (old + 1u == (gen + 1u) * nloc) {
            __builtin_amdgcn_fence(__ATOMIC_RELEASE, "agent");
            asm volatile("s_waitcnt vmcnt(0)" ::: "memory");
            const unsigned og = xb_add(&bar[XB_TOP], 1u);
            const unsigned tg = og / nx;
            if (og + 1u == (tg + 1u) * nx) xb_add(&bar[XB_TOPGEN], 1u);
            else XB_SPIN(xb_ld(&bar[XB_TOPGEN]) == tg, bar);
            __builtin_amdgcn_fence(__ATOMIC_ACQUIRE, "agent");
            xb_add(&bar[XB_XGEN(b.x)], 1u);
            asm volatile("s_waitcnt vmcnt(0)" ::: "memory");
        } else {
            XB_SPIN(xb_ld(&bar[XB_XGEN(b.x)]) == gen, bar);
            __builtin_amdgcn_fence(__ATOMIC_ACQUIRE, "agent");
            asm volatile("s_waitcnt vmcnt(0)" ::: "memory");
        }
    }
    __syncthreads();
}

#define EROW(ai, m) (u.pm * 256 + (ai) * 128 + wr * 64 + (m) * 16 + fr)
#define ECOL(bj) ((bj) * 128 + wc * 32 + fq * 8)
#define ETAB(tab, ai, m) ((tab)[ui * 256 + (ai) * 128 + wr * 64 + (m) * 16 + fr])
#define EPI_ARGS const f32x4 (&acc)[2][2][4][2], const Unit& u, int ui, int wr, int wc, int fr, int fq

struct EpiDsaIn {
    static constexpr int ID = 0; static constexpr bool SP2 = true, ALIGN = true; static constexpr bool PERM = true, AFTER_DRAIN = false;
    const float* rstdx; u16 *Q, *K, *Vt, *QI, *KI; float* WI; const float *kg, *kb;
    __device__ __forceinline__ void operator()(EPI_ARGS) const {
        const int pn = u.pn;
        float rsv[2][4];
#pragma unroll
        for (int ai = 0; ai < 2; ++ai)
#pragma unroll
            for (int m = 0; m < 4; ++m) rsv[ai][m] = rstdx[EROW(ai, m)];
        __builtin_amdgcn_sched_barrier(0);
#pragma unroll
        for (int ai = 0; ai < 2; ++ai)
#pragma unroll
        for (int m = 0; m < 4; ++m) {
            const int row = EROW(ai, m); const float rs = rsv[ai][m];
            if (pn < 8) {
                u16* base = (pn < 4 ? Q : K) + (size_t)row * 1024 + (pn & 3) * 256; const float s = pn < 4 ? rs * QS_DSA : rs;
#pragma unroll
                for (int bj = 0; bj < 2; ++bj) *(u32x4*)(base + ECOL(bj)) = pack8(acc[ai][bj][m][0] * s, acc[ai][bj][m][1] * s);
            } else if (pn < 12) {
#pragma unroll
                for (int bj = 0; bj < 2; ++bj)
#pragma unroll
                for (int n = 0; n < 2; ++n)
#pragma unroll
                for (int e = 0; e < 4; ++e) Vt[(size_t)((pn - 8) * 256 + ECOL(bj) + n * 4 + e) * L + row] = f2h(acc[ai][bj][m][n][e] * rs);
            } else if (pn < 14) {
                u16* base = QI + (size_t)row * 512 + (pn - 12) * 256;
#pragma unroll
                for (int bj = 0; bj < 2; ++bj) *(u32x4*)(base + ECOL(bj)) = pack8(acc[ai][bj][m][0] * rs, acc[ai][bj][m][1] * rs);
            } else {
                if (wc == 0) {
                    f32x4 x[2][2]; float s = 0.f;
#pragma unroll
                    for (int bj = 0; bj < 2; ++bj)
#pragma unroll
                    for (int n = 0; n < 2; ++n) { x[bj][n] = acc[ai][bj][m][n] * rs; s += (x[bj][n][0] + x[bj][n][1]) + (x[bj][n][2] + x[bj][n][3]); }
                    s += __shfl_xor(s, 16); s += __shfl_xor(s, 32);
                    const float mean = s * (1.f / 64.f); float v = 0.f;
#pragma unroll
                    for (int bj = 0; bj < 2; ++bj)
#pragma unroll
                    for (int n = 0; n < 2; ++n) { x[bj][n] = x[bj][n] - mean; v += (x[bj][n][0] * x[bj][n][0] + x[bj][n][1] * x[bj][n][1]) + (x[bj][n][2] * x[bj][n][2] + x[bj][n][3] * x[bj][n][3]); }
                    v += __shfl_xor(v, 16); v += __shfl_xor(v, 32);
                    const float r2 = rsqrtf(v * (1.f / 64.f) + EPS);
#pragma unroll
                    for (int bj = 0; bj < 2; ++bj) { const int d0 = bj * 32 + fq * 8;
                        const f32x4 g0 = *(const f32x4*)(kg + d0), g1 = *(const f32x4*)(kg + d0 + 4), b0 = *(const f32x4*)(kb + d0), b1 = *(const f32x4*)(kb + d0 + 4);
                        *(u32x4*)(KI + (size_t)row * 64 + d0) = pack8(x[bj][0] * r2 * g0 + b0, x[bj][1] * r2 * g1 + b1); }
                } else if (wc == 1 && fq == 0) {
                    *(f32x4*)(WI + (size_t)row * 8) = acc[ai][0][m][0] * (rs * WI_SCALE); *(f32x4*)(WI + (size_t)row * 8 + 4) = acc[ai][0][m][1] * (rs * WI_SCALE);
                }
            }
        }
    }
};

struct EpiUp {
    static constexpr int ID = 1; static constexpr bool SP2 = true, ALIGN = true; static constexpr bool PERM = true, AFTER_DRAIN = false;
    u16* H; int ldc; const LAS float* tab;
    __device__ __forceinline__ void operator()(EPI_ARGS) const {
#pragma unroll
        for (int ai = 0; ai < 2; ++ai)
#pragma unroll
        for (int m = 0; m < 4; ++m) { const int row = EROW(ai, m); const float rs = ETAB(tab, ai, m); u16* base = H + (size_t)row * ldc + u.pn * 256;
#pragma unroll
            for (int bj = 0; bj < 2; ++bj) { f32x4 a = acc[ai][bj][m][0] * rs, b = acc[ai][bj][m][1] * rs;
#pragma unroll
                for (int e = 0; e < 4; ++e) { a[e] = fmaxf(a[e], 0.f); a[e] *= a[e]; b[e] = fmaxf(b[e], 0.f); b[e] *= b[e]; }
                *(u32x4*)(base + ECOL(bj)) = pack8(a, b); } }
    }
};

struct EpiScale16 {
    static constexpr int ID = 2; static constexpr bool SP2 = true, ALIGN = true; static constexpr bool PERM = true, AFTER_DRAIN = false;
    u16* O; int ldc; size_t split; const LAS float* tab;
    __device__ __forceinline__ void operator()(EPI_ARGS) const {
        u16* ob = split ? O + (size_t)(u.pn >> 2) * split + (u.pn & 3) * 256 : O + u.pn * 256;
#pragma unroll
        for (int ai = 0; ai < 2; ++ai)
#pragma unroll
        for (int m = 0; m < 4; ++m) { const int row = EROW(ai, m); const float rs = ETAB(tab, ai, m); u16* base = ob + (size_t)row * ldc;
#pragma unroll
            for (int bj = 0; bj < 2; ++bj) *(u32x4*)(base + ECOL(bj)) = pack8(acc[ai][bj][m][0] * rs, acc[ai][bj][m][1] * rs); }
    }
};

struct EpiGlu {
    static constexpr int ID = 3; static constexpr bool SP2 = true, ALIGN = true; static constexpr bool PERM = true, AFTER_DRAIN = false;
    u16* U; const float* bias; const LAS float* tab;
    __device__ __forceinline__ void operator()(EPI_ARGS) const {
        const int col = u.pn * 128 + wc * 32 + fq * 8;
        f32x4 ba[2], bg[2];
#pragma unroll
        for (int n = 0; n < 2; ++n) { ba[n] = *(const f32x4*)(bias + col + 4 * n); bg[n] = *(const f32x4*)(bias + 1024 + col + 4 * n); }
#pragma unroll
        for (int ai = 0; ai < 2; ++ai)
#pragma unroll
        for (int m = 0; m < 4; ++m) { const int row = EROW(ai, m); const float rs = ETAB(tab, ai, m); f32x4 o[2];
#pragma unroll
            for (int n = 0; n < 2; ++n) { const f32x4 a = acc[ai][0][m][n] * rs + ba[n], g = acc[ai][1][m][n] * rs + bg[n];
#pragma unroll
                for (int e = 0; e < 4; ++e) o[n][e] = a[e] * sigmoidf_(g[e]); }
            *(u32x4*)(U + (size_t)row * 1024 + col) = pack8(o[0], o[1]); }
    }
};

struct EpiResid {
    static constexpr int ID = 4; static constexpr bool SP2 = true, ALIGN = true; static constexpr bool PERM = true, AFTER_DRAIN = false;
    const float* hin32; u16* a16; float* part; const float* bias;
    __device__ __forceinline__ void tail(const f32x4& v0, const f32x4& v1, float& ssq, size_t o) const {
        ssq = (v0[0] * v0[0] + v0[1] * v0[1]) + (v0[2] * v0[2] + v0[3] * v0[3]) + (v1[0] * v1[0] + v1[1] * v1[1]) + (v1[2] * v1[2] + v1[3] * v1[3]);
        *(u32x4*)(a16 + o) = pack8(v0, v1); }
    __device__ __forceinline__ void operator()(EPI_ARGS) const {
#pragma unroll
        for (int ai = 0; ai < 2; ++ai) {
            if (hin32) {
                f32x4 rr[4][2][2];
#pragma unroll
                for (int m = 0; m < 4; ++m)
#pragma unroll
                    for (int bj = 0; bj < 2; ++bj) { const size_t o = (size_t)EROW(ai, m) * 1024 + u.pn * 256 + ECOL(bj); rr[m][bj][0] = *(const f32x4*)(hin32 + o); rr[m][bj][1] = *(const f32x4*)(hin32 + o + 4); }
                __builtin_amdgcn_sched_barrier(0);
#pragma unroll
                for (int m = 0; m < 4; ++m) { const int row = EROW(ai, m); float ssq[2];
#pragma unroll
                    for (int bj = 0; bj < 2; ++bj) { const int col = u.pn * 256 + ECOL(bj);
                        f32x4 v0 = acc[ai][bj][m][0] + rr[m][bj][0], v1 = acc[ai][bj][m][1] + rr[m][bj][1];
                        if (bias) { v0 = v0 + *(const f32x4*)(bias + col); v1 = v1 + *(const f32x4*)(bias + col + 4); }
                        tail(v0, v1, ssq[bj], (size_t)row * 1024 + col); }
                    if (part) {
#pragma unroll
                        for (int bj = 0; bj < 2; ++bj) { float s = ssq[bj]; s += __shfl_xor(s, 16); s += __shfl_xor(s, 32); if (fq == 0) part[(size_t)row * 32 + u.pn * 8 + bj * 4 + wc] = s; } } }
            } else {
                u32x4 hw[4][2];
#pragma unroll
                for (int m = 0; m < 4; ++m)
#pragma unroll
                    for (int bj = 0; bj < 2; ++bj) hw[m][bj] = *(const u32x4*)(a16 + (size_t)EROW(ai, m) * 1024 + u.pn * 256 + ECOL(bj));
                __builtin_amdgcn_sched_barrier(0);
#pragma unroll
                for (int m = 0; m < 4; ++m) { const int row = EROW(ai, m); float ssq[2];
#pragma unroll
                    for (int bj = 0; bj < 2; ++bj) { const int col = u.pn * 256 + ECOL(bj);
                        const unsigned w0 = hw[m][bj].x, w1 = hw[m][bj].y, w2 = hw[m][bj].z, w3 = hw[m][bj].w;
                        const h16x2 a = __builtin_bit_cast(h16x2, w0), b = __builtin_bit_cast(h16x2, w1), c = __builtin_bit_cast(h16x2, w2), d = __builtin_bit_cast(h16x2, w3);
                        f32x4 v0 = acc[ai][bj][m][0] + (f32x4){(float)a[0], (float)a[1], (float)b[0], (float)b[1]}, v1 = acc[ai][bj][m][1] + (f32x4){(float)c[0], (float)c[1], (float)d[0], (float)d[1]};
                        if (bias) { v0 = v0 + *(const f32x4*)(bias + col); v1 = v1 + *(const f32x4*)(bias + col + 4); }
                        tail(v0, v1, ssq[bj], (size_t)row * 1024 + col); }
                    if (part) {
#pragma unroll
                        for (int bj = 0; bj < 2; ++bj) { float s = ssq[bj]; s += __shfl_xor(s, 16); s += __shfl_xor(s, 32); if (fq == 0) part[(size_t)row * 32 + u.pn * 8 + bj * 4 + wc] = s; } } }
            }
        }
    }
};

struct EpiMlaIn {
    static constexpr int ID = 5; static constexpr bool SP2 = true, ALIGN = true; static constexpr bool PERM = true, AFTER_DRAIN = false;
    u16* P16; u16* KR; float* part2; const f32x2* rope; const LAS float* tab;
    __device__ __forceinline__ void operator()(EPI_ARGS) const {
#pragma unroll
        for (int ai = 0; ai < 2; ++ai)
#pragma unroll
        for (int m = 0; m < 4; ++m) { const int row = EROW(ai, m); const float rs = ETAB(tab, ai, m);
#pragma unroll
            for (int bj = 0; bj < 2; ++bj) { const int hb = u.pn * 2 + bj; const f32x4 v0 = acc[ai][bj][m][0] * rs, v1 = acc[ai][bj][m][1] * rs;
                if (hb < 5) {
                    *(u32x4*)(P16 + (size_t)row * 640 + hb * 128 + wc * 32 + fq * 8) = pack8(v0, v1);
                    float s = (v0[0] * v0[0] + v0[1] * v0[1]) + (v0[2] * v0[2] + v0[3] * v0[3]) + (v1[0] * v1[0] + v1[1] * v1[1]) + (v1[2] * v1[2] + v1[3] * v1[3]);
                    s += __shfl_xor(s, 16); s += __shfl_xor(s, 32);
                    if (fq == 0) part2[(size_t)row * 32 + hb * 4 + wc] = s;
                } else if (hb == 5 && wc == 0) {
                    const f32x2* rp = rope + (size_t)row * 16 + 4 * fq;
                    const f32x2 c0 = rp[0], c1 = rp[1], c2 = rp[2], c3 = rp[3];
                    f32x4 o0, o1;
                    o0[0] = v0[0] * c0.x - v0[1] * c0.y; o0[1] = v0[1] * c0.x + v0[0] * c0.y; o0[2] = v0[2] * c1.x - v0[3] * c1.y; o0[3] = v0[3] * c1.x + v0[2] * c1.y;
                    o1[0] = v1[0] * c2.x - v1[1] * c2.y; o1[1] = v1[1] * c2.x + v1[0] * c2.y; o1[2] = v1[2] * c3.x - v1[3] * c3.y; o1[3] = v1[3] * c3.x + v1[2] * c3.y;
                    *(u32x4*)(KR + (size_t)row * 32 + fq * 8) = pack8(o0, o1);
                } }
        }
    }
};

struct EpiMlaUq {
    static constexpr int ID = 6; static constexpr bool SP2 = true, ALIGN = true; static constexpr bool PERM = true, AFTER_DRAIN = false;
    u16* QM; const f32x2* rope; const LAS float* tab;
    __device__ __forceinline__ void operator()(EPI_ARGS) const {
        const unsigned cg0 = u.pn * 256 + ECOL(0), cg1 = u.pn * 256 + ECOL(1); const int d00 = (int)(cg0 % 96u), d01 = (int)(cg1 % 96u);
#pragma unroll
        for (int ai = 0; ai < 2; ++ai) {
            f32x2 rp[4][2][4];
#pragma unroll
            for (int m = 0; m < 4; ++m) { const unsigned row = EROW(ai, m);
#pragma unroll
                for (int bj = 0; bj < 2; ++bj) { const int d0 = bj ? d01 : d00; if (d0 >= 64) { const f32x2* p = rope + (row * 16u + (unsigned)((d0 - 64) >> 1)); rp[m][bj][0] = p[0]; rp[m][bj][1] = p[1]; rp[m][bj][2] = p[2]; rp[m][bj][3] = p[3]; } } }
            __builtin_amdgcn_sched_barrier(0);
#pragma unroll
            for (int m = 0; m < 4; ++m) { const unsigned row = EROW(ai, m); const float rs = ETAB(tab, ai, m) * QS_MLA;
#pragma unroll
                for (int bj = 0; bj < 2; ++bj) { const unsigned cg = bj ? cg1 : cg0; const int d0 = bj ? d01 : d00; f32x4 v0 = acc[ai][bj][m][0] * rs, v1 = acc[ai][bj][m][1] * rs;
                    if (d0 >= 64) {
                        { const f32x2 c0 = rp[m][bj][0], c1 = rp[m][bj][1]; const f32x4 t = v0; v0[0] = t[0] * c0.x - t[1] * c0.y; v0[1] = t[1] * c0.x + t[0] * c0.y; v0[2] = t[2] * c1.x - t[3] * c1.y; v0[3] = t[3] * c1.x + t[2] * c1.y; }
                        { const f32x2 c2 = rp[m][bj][2], c3 = rp[m][bj][3]; const f32x4 t = v1; v1[0] = t[0] * c2.x - t[1] * c2.y; v1[1] = t[1] * c2.x + t[0] * c2.y; v1[2] = t[2] * c3.x - t[3] * c3.y; v1[3] = t[3] * c3.x + t[2] * c3.y; } }
                    *(u32x4*)((char*)QM + (size_t)((row * 1536u + cg) * 2u)) = pack8(v0, v1); }
            }
        }
    }
};

struct EpiMlaUkv {
    static constexpr int ID = 7; static constexpr bool SP2 = true, ALIGN = true; static constexpr bool PERM = true, AFTER_DRAIN = false;
    u16* KN; u16* Vt; const LAS float* tab;
    __device__ __forceinline__ void operator()(EPI_ARGS) const {
#pragma unroll
        for (int ai = 0; ai < 2; ++ai)
#pragma unroll
        for (int m = 0; m < 4; ++m) { const unsigned row = EROW(ai, m); const float rs = ETAB(tab, ai, m);
#pragma unroll
            for (int bj = 0; bj < 2; ++bj) { const unsigned head = u.pn * 2 + bj;
                if (wc < 2) *(u32x4*)((char*)KN + (size_t)((row * 1024u + head * 64u + wc * 32 + fq * 8) * 2u)) = pack8(acc[ai][bj][m][0] * rs, acc[ai][bj][m][1] * rs);
                else { unsigned off = ((head * 64u + (wc - 2) * 32 + fq * 8) * (unsigned)L + row) * 2u;
#pragma unroll
                    for (int n = 0; n < 2; ++n)
#pragma unroll
                    for (int e = 0; e < 4; ++e) { *(u16*)((char*)Vt + (size_t)off) = f2h(acc[ai][bj][m][n][e] * rs); off += (unsigned)L * 2u; } } }
            asm volatile("" ::: "memory");
        }
    }
};

template <class Sched> __device__ __forceinline__ void build_tab(LAS float* tab, const Sched& S, const float* part, int g0, int g1, float inv_n) {
    Unit u;
    for (int i = 0; i < 8 && S.next(i, u); ++i)
        for (int r = opaque_tid(); r < 256; r += NTHR) { const float* p = part + (size_t)(u.pm * 256 + r) * 32; float s = 0.f; for (int g = g0; g < g1; ++g) s += p[g]; tab[i * 256 + r] = rsqrtf(s * inv_n + EPS); }
    __syncthreads();
}

__device__ const float INV_FREQ[16] = {1.0f, 0.5623413324356079f, 0.3162277638912201f, 0.17782793939113617f, 0.10000000149011612f, 0.05623413249850273f, 0.03162277489900589f, 0.017782794311642647f,
    0.009999999776482582f, 0.005623413249850273f, 0.003162277629598975f, 0.0017782794311642647f, 0.0010000000474974513f, 0.000562341301701963f, 0.0003162277571391314f, 0.00017782794020604342f};

template <class Map> __device__ __forceinline__ void tr_item(const float* W, int K, int N, const float* gain, u16* WT, const Map& map, LAS float* scr, int item, int lane) {
    const int nblk = (N + 31) / 32, kb = item / nblk, nb = item % nblk, k0 = 64 * kb, n0 = 32 * nb;
    float wv_[32];
#pragma unroll
    for (int i = 0; i < 32; ++i) { const int kk = 2 * i + (lane >> 5), n = n0 + (lane & 31); wv_[i] = (n < N) ? W[(size_t)(k0 + kk) * N + n] : 0.f; }
#pragma unroll
    for (int i = 0; i < 32; ++i) { const int kk = 2 * i + (lane >> 5); float v = wv_[i]; if (gain) v *= gain[k0 + kk]; scr[kk * 33 + (lane & 31)] = v; }
    asm volatile("s_waitcnt lgkmcnt(0)" ::: "memory");
    const int c = lane & 7;
#pragma unroll
    for (int j = 0; j < 4; ++j) { const int nl = (lane >> 3) + 8 * j, n = n0 + nl; const int dr = (n < N) ? map(n) : -1; const LAS float* s = scr + (8 * c) * 33 + nl;
        if (dr >= 0) { u32x4 o; o.x = pk16(s[0 * 33], s[1 * 33]); o.y = pk16(s[2 * 33], s[3 * 33]); o.z = pk16(s[4 * 33], s[5 * 33]); o.w = pk16(s[6 * 33], s[7 * 33]);
            *(u32x4*)(WT + (size_t)dr * K + k0 + 8 * c) = o; } }
    asm volatile("s_waitcnt lgkmcnt(0)" ::: "memory");
}
template <class Map> __device__ __forceinline__ void conv_mat(int& base, int gw, int NGW, const float* W, int K, int N, const float* gain, u16* WT, const Map& map, LAS float* scr, int lane) {
    const int nitems = (K / 64) * ((N + 31) / 32);
    int first = (gw - base) % NGW; if (first < 0) first += NGW;
    for (int it = first; it < nitems; it += NGW) tr_item(W, K, N, gain, WT, map, scr, it, lane);
    base += nitems;
}
__device__ __forceinline__ void zero_rows(u16* WT, int K, int r0, int r1, int gw, int NGW, int lane) {
    const int per_row = K / 8;
    const long total = (long)(r1 - r0) * per_row;
    for (long c = (long)gw * 64 + lane; c < total; c += (long)NGW * 64) *(u32x4*)(WT + (size_t)r0 * K + c * 8) = (u32x4){0u, 0u, 0u, 0u};
}
struct MapId { int off; __device__ __forceinline__ int operator()(int n) const { return n + off; } };
struct MapDsaIn { __device__ __forceinline__ int operator()(int n) const { if (n < 3584) return n; if (n < 3648) { const int d = n - 3584; return d < 32 ? 3584 + d : 3584 + 128 + (d - 32); } return 3584 + 32 + (n - 3648); } };
struct MapPw1 { __device__ __forceinline__ int operator()(int n) const { return n < 1024 ? 256 * (n >> 7) + (n & 127) : 256 * ((n - 1024) >> 7) + 128 + (n & 127); } };
struct MapMlaIn { __device__ __forceinline__ int operator()(int n) const { if (n < 640) return n; const int d = n - 640; return 640 + 2 * (d & 15) + (d >> 4); } };
struct MapMlaUq { __device__ __forceinline__ int operator()(int n) const { const int h = n / 96, d = n % 96; if (d < 64) return n; const int r = d - 64; return h * 96 + 64 + 2 * (r & 15) + (r >> 4); } };
struct MapGdnQkv { __device__ __forceinline__ int operator()(int n) const { return n < 3072 ? n : -1; } };
struct MapGdnGate { __device__ __forceinline__ int operator()(int n) const { return (n >= 3072 && n < 4096) ? n - 3072 : -1; } };

struct Args { const float* in[30]; float* out; uchar* ws; };
typedef const __attribute__((address_space(4))) Args* KArgs;
struct Ptrs {
    KArgs ka; float* out; uchar* ws;
    __device__ __forceinline__ const float* in(int k) const { KArgs p = ka; asm volatile("" : "+s"(p)); return p->in[k]; }
};

template <int LAYER> __device__ __forceinline__ void convert_layer(const Ptrs& P, LAS uchar* lds, int vcu, int G) {
    const int tid_ = opaque_tid(), lane = tid_ & 63, wave = __builtin_amdgcn_readfirstlane(tid_ >> 6);
    LAS float* scr = (LAS float*)(lds + wave * 16384);
    const int gw = vcu * NWAVES + wave, NGW = G * NWAVES; int base = 0;
    uchar* ws = P.ws;
    const float* gmix = P.in(1) + LAYER * 1024; const float* gmlp = P.in(2) + LAYER * 1024;
    conv_mat(base, gw, NGW, P.in(4) + (size_t)LAYER * 1024 * 4096, 1024, 4096, gmlp, (u16*)(ws + WS_W1), MapId{0}, scr, lane);
    conv_mat(base, gw, NGW, P.in(5) + (size_t)LAYER * 4096 * 1024, 4096, 1024, nullptr, (u16*)(ws + WS_W2), MapId{0}, scr, lane);
    if (LAYER == 0) {
        conv_mat(base, gw, NGW, P.in(6), 1024, 3656, gmix, (u16*)(ws + WS_WIN), MapDsaIn{}, scr, lane);
        if (SKIPMIX & 1) zero_rows((u16*)(ws + WS_WOUT), 1024, 0, 1024, gw, NGW, lane); else conv_mat(base, gw, NGW, P.in(9), 1024, 1024, nullptr, (u16*)(ws + WS_WOUT), MapId{0}, scr, lane);
        zero_rows((u16*)(ws + WS_WIN), 1024, 3624, 3712, gw, NGW, lane); zero_rows((u16*)(ws + WS_WIN), 1024, 3744, 3840, gw, NGW, lane);
    } else if (LAYER == 1) {
        conv_mat(base, gw, NGW, P.in(10), 1024, 2048, gmix, (u16*)(ws + WS_WIN), MapPw1{}, scr, lane);
        conv_mat(base, gw, NGW, P.in(16), 1024, 1024, nullptr, (u16*)(ws + WS_WOUT), MapId{0}, scr, lane);
    } else if (LAYER == 2) {
        conv_mat(base, gw, NGW, P.in(18), 1024, 672, gmix, (u16*)(ws + WS_WIN), MapMlaIn{}, scr, lane);
        conv_mat(base, gw, NGW, P.in(20), 384, 1536, P.in(19), (u16*)(ws + WS_WB), MapMlaUq{}, scr, lane);
        conv_mat(base, gw, NGW, P.in(22), 256, 2048, P.in(21), (u16*)(ws + WS_WC), MapId{0}, scr, lane);
        conv_mat(base, gw, NGW, P.in(23), 1024, 1024, nullptr, (u16*)(ws + WS_WOUT), MapId{0}, scr, lane);
        zero_rows((u16*)(ws + WS_WIN), 1024, 672, 768, gw, NGW, lane);
    } else {
        conv_mat(base, gw, NGW, P.in(24), 1024, 4112, gmix, (u16*)(ws + WS_WIN), MapGdnQkv{}, scr, lane);
        conv_mat(base, gw, NGW, P.in(24), 1024, 4112, gmix, (u16*)(ws + WS_WD), MapGdnGate{}, scr, lane);
        conv_mat(base, gw, NGW, P.in(29), 1024, 1024, nullptr, (u16*)(ws + WS_WOUT), MapId{0}, scr, lane);
    }
}

__device__ __forceinline__ void prologue_x(const Ptrs& P, int vcu, int G) {
    const int tid_ = opaque_tid(), lane = tid_ & 63, wave = __builtin_amdgcn_readfirstlane(tid_ >> 6);
    const int gw = vcu * NWAVES + wave, NGW = G * NWAVES;
    const float* x = P.in(0); u16* a16 = (u16*)(P.ws + WS_A16); float* rstdx = (float*)(P.ws + WS_RSTDX);
    f32x4 vn[4];
#pragma unroll
    for (int j = 0; j < 4; ++j) vn[j] = ((const f32x4*)(x + (size_t)(gw < L ? gw : 0) * D) + lane)[64 * j];
    for (int m = gw; m < L; m += NGW) {
        f32x4 v[4]; float s = 0.f;
#pragma unroll
        for (int j = 0; j < 4; ++j) v[j] = vn[j];
        { const int mn = (m + NGW < L) ? m + NGW : m; const f32x4* xn_ = (const f32x4*)(x + (size_t)mn * D) + lane;
#pragma unroll
          for (int j = 0; j < 4; ++j) vn[j] = xn_[64 * j]; }
#pragma unroll
        for (int j = 0; j < 4; ++j) s += (v[j][0] * v[j][0] + v[j][1] * v[j][1]) + (v[j][2] * v[j][2] + v[j][3] * v[j][3]);
        s = wave_sum(s);
        if (lane == 0) rstdx[m] = rsqrtf(s * (1.f / D) + EPS);
        u32x2* o = (u32x2*)(a16 + (size_t)m * D) + lane;
#pragma unroll
        for (int j = 0; j < 4; ++j) { u32x2 w; w.x = pk16(v[j][0], v[j][1]); w.y = pk16(v[j][2], v[j][3]); o[64 * j] = w; }
    }
    f32x2* rope = (f32x2*)(P.ws + WS_ROPE);
    for (int i = gw * 64 + lane; i < L * 16; i += NGW * 64) {
        const int t = i >> 4, k = i & 15; const float ang = (float)t * INV_FREQ[k];
        const double rev = (double)ang * 0.15915494309189535; const float fr = (float)(rev - floor(rev));
        f32x2 cs; cs.x = __builtin_amdgcn_cosf(fr); cs.y = __builtin_amdgcn_sinf(fr); rope[i] = cs;
    }
}

template <int DQK, int DV, bool BITS>
__device__ __forceinline__ void attn_unit(LAS uchar* lds, const u16* __restrict__ Qh, int ldq, const u16* __restrict__ Kh, int ldk, const u16* __restrict__ Kr, int ldkr,
                                          const u16* __restrict__ Vth, const unsigned* __restrict__ bits, u16* Oh, int ldo, int qb) {
    constexpr int KPB = (DQK + 8) * 2, VPB = 144, KBYTES = 64 * KPB, VBYTES = DV * VPB, BUF = KBYTES + VBYTES;
    constexpr int NS = DQK / 16, NDB = DV / 32, KCH = DQK / 8, NKC = 64 * KCH, NVC = DV * 8, KIT = (NKC + 511) / 512, VIT = (NVC + 511) / 512;
    const int tid = opaque_tid(), lane = tid & 63, wid = __builtin_amdgcn_readfirstlane(tid >> 6), r32 = lane & 31, hi = lane >> 5;
    constexpr int NSTG = (DV == 64) ? 5 : 3, DST = (DV == 64) ? 3 : 2;
    LAS float* wsc = (LAS float*)(lds + NSTG * BUF) + wid * 32;
    const int q0 = qb * 256, q0w = q0 + wid * 32, tq = q0w + r32, NT = (q0 + 256) / 64;
    s16x8 qf[NS];
#pragma unroll
    for (int s = 0; s < NS; ++s) qf[s] = *(const s16x8*)(Qh + (size_t)tq * ldq + 16 * s + 8 * hi);
    f32x16 o[NDB];
#pragma unroll
    for (int db = 0; db < NDB; ++db)
#pragma unroll
        for (int r = 0; r < 16; ++r) o[db][r] = 0.f;
    float mrun = -1e30f, lrun = 0.f;
    u32x4 kst[KIT], vst[VIT];
#define ATT_LOAD(t) do { _Pragma("unroll") for (int i_ = 0; i_ < KIT; ++i_) { const int c_ = tid + 512 * i_; if (c_ < NKC) { const int row_ = c_ / KCH, cc_ = c_ % KCH; \
            const u16* src_ = (DQK == 96 && cc_ >= 8) ? Kr + (size_t)((t) * 64 + row_) * ldkr + (cc_ - 8) * 8 : Kh + (size_t)((t) * 64 + row_) * ldk + cc_ * 8; kst[i_] = *(const u32x4*)src_; } } \
        _Pragma("unroll") for (int i_ = 0; i_ < VIT; ++i_) { const int c_ = tid + 512 * i_; if (c_ < NVC) { const int d_ = c_ >> 3, cc_ = c_ & 7; vst[i_] = *(const u32x4*)(Vth + (size_t)d_ * L + (t) * 64 + cc_ * 8); } } } while (0)
#define ATT_STORE(b) do { _Pragma("unroll") for (int i_ = 0; i_ < KIT; ++i_) { const int c_ = tid + 512 * i_; if (c_ < NKC) { const int row_ = c_ / KCH, cc_ = c_ % KCH; *(LAS u32x4*)(lds + (b) * BUF + row_ * KPB + cc_ * 16) = kst[i_]; } } \
        _Pragma("unroll") for (int i_ = 0; i_ < VIT; ++i_) { const int c_ = tid + 512 * i_; if (c_ < NVC) { const int d_ = c_ >> 3, cc_ = c_ & 7; LAS uchar* p_ = lds + (b) * BUF + KBYTES + d_ * VPB + (cc_ >> 1) * 32 + (cc_ & 1) * 8; \
            *(LAS u32x2*)p_ = (u32x2){vst[i_].x, vst[i_].y}; *(LAS u32x2*)(p_ + 16) = (u32x2){vst[i_].z, vst[i_].w}; } } } while (0)
#define ATT_QK(SA, SB, st_) do { const LAS uchar* Kl_ = lds + (st_) * BUF; _Pragma("unroll") for (int r = 0; r < 16; ++r) { SA[r] = 0.f; SB[r] = 0.f; } \
        _Pragma("unroll") for (int s = 0; s < NS; ++s) { const s16x8 a0_ = *(const LAS s16x8*)(Kl_ + r32 * KPB + 32 * s + 16 * hi), a1_ = *(const LAS s16x8*)(Kl_ + (32 + r32) * KPB + 32 * s + 16 * hi); \
            SA = mfma32(a0_, qf[s], SA); SB = mfma32(a1_, qf[s], SB); } } while (0)
    ATT_LOAD(0); ATT_STORE(0); if (NT > 1) { ATT_LOAD(1); ATT_STORE(1); } if (DST == 3) { ATT_LOAD(2); ATT_STORE(2); } __syncthreads();
    f32x16 S0, S1, T0, T1;
    unsigned bw0 = 0u, bw1 = 0u; if (BITS) { bw0 = bits[tq]; bw1 = bits[(size_t)L + tq]; }
    ATT_QK(S0, S1, 0);
    if (NT > DST) ATT_LOAD(DST);
    int st_cur = 0, st_nxt = 1, st_fill = DST;
    constexpr int PREK = (DQK == 96) ? 2 * NS : 4, PREV = (DV == 64) ? 4 * NDB : 0;
#define ATT_TILE(SA_, SB_, TA_, TB_, t, BAR_) do { \
        const int kv0 = t * 64; \
        if (t + DST < NT) { ATT_STORE(st_fill); if (t + DST + 1 < NT) ATT_LOAD(t + DST + 1); } \
        const LAS uchar* Vl = lds + st_cur * BUF + KBYTES; const LAS uchar* Kn = lds + st_nxt * BUF; \
        s16x8 kf[PREK > 0 ? PREK : 1]; \
_Pragma("unroll") \
        for (int i_ = 0; i_ < PREK; ++i_) kf[i_] = *(const LAS s16x8*)(Kn + ((i_ & 1) * 32 + r32) * KPB + 32 * (i_ >> 1) + 16 * hi); \
        __builtin_amdgcn_sched_barrier(0); \
        if (BITS) { \
            const unsigned w0 = bw0, w1 = bw1; { const int tn_ = (t + 1 < NT) ? t + 1 : t; bw0 = bits[(size_t)(2 * tn_) * L + tq]; bw1 = bits[(size_t)(2 * tn_ + 1) * L + tq]; } \
            const unsigned wa_ = w0 >> (4 * hi), wb_ = w1 >> (4 * hi); \
_Pragma("unroll") \
            for (int r = 0; r < 16; ++r) { const int c_ = (r & 3) + 8 * (r >> 2); \
                const unsigned ta_ = (unsigned)__builtin_amdgcn_sbfe((int)wa_, c_, 1), tb_ = (unsigned)__builtin_amdgcn_sbfe((int)wb_, c_, 1);     \
                SA_[r] = __uint_as_float((__float_as_uint(SA_[r]) & ta_) | (~ta_ & 0xff800000u)); SB_[r] = __uint_as_float((__float_as_uint(SB_[r]) & tb_) | (~tb_ & 0xff800000u)); } \
        } \
        if (kv0 + 63 > q0w) { \
_Pragma("unroll") \
            for (int r = 0; r < 16; ++r) { const int key = kv0 + (r & 3) + 8 * (r >> 2) + 4 * hi; if (key > tq) SA_[r] = NEG_INF; if (key + 32 > tq) SB_[r] = NEG_INF; } \
        } \
        float rm = max3f_(SA_[0], SB_[0], SA_[1]), rm2_ = max3f_(SB_[1], SA_[2], SB_[2]); \
_Pragma("unroll") \
        for (int r = 3; r < 15; r += 2) { rm = max3f_(rm, SA_[r], SB_[r]); rm2_ = max3f_(rm2_, SA_[r + 1], SB_[r + 1]); } \
        rm = max3f_(rm, SA_[15], SB_[15]); rm = fmaxf(rm, rm2_); \
        { const unsigned rb_ = __float_as_uint(rm); const auto sw_ = __builtin_amdgcn_permlane32_swap(rb_, rb_, false, false); rm = fmaxf(__uint_as_float(sw_[0]), __uint_as_float(sw_[1])); }        \
        if (__any(rm > mrun + 8.f)) { \
            const float mn = fmaxf(mrun, rm), al = __builtin_amdgcn_exp2f(mrun - mn); lrun *= al; mrun = mn; \
            if (hi == 0) wsc[r32] = al; \
            asm volatile("s_waitcnt lgkmcnt(0)" ::: "memory"); \
_Pragma("unroll") \
            for (int g = 0; g < 4; ++g) { const f32x4 a4 = *(const LAS f32x4*)(wsc + 8 * g + 4 * hi); \
_Pragma("unroll") \
                for (int db = 0; db < NDB; ++db) { o[db][4 * g] *= a4[0]; o[db][4 * g + 1] *= a4[1]; o[db][4 * g + 2] *= a4[2]; o[db][4 * g + 3] *= a4[3]; } } \
            asm volatile("s_waitcnt lgkmcnt(0)" ::: "memory"); \
        } \
        s16x8 vf[PREV > 0 ? PREV : 1]; \
_Pragma("unroll") \
        for (int i_ = 0; i_ < PREV; ++i_) vf[i_] = *(const LAS s16x8*)(Vl + (32 * (i_ >> 2) + r32) * VPB + 32 * (i_ & 3) + 16 * hi); \
        __builtin_amdgcn_sched_barrier(0); \
_Pragma("unroll") \
        for (int r = 0; r < 16; ++r) { TA_[r] = 0.f; TB_[r] = 0.f; } \
_Pragma("unroll") \
        for (int s_ = 0; s_ < NS; ++s_) { \
            const s16x8 a0_ = (2 * s_ < PREK) ? kf[2 * s_] : *(const LAS s16x8*)(Kn + r32 * KPB + 32 * s_ + 16 * hi); \
            const s16x8 a1_ = (2 * s_ + 1 < PREK) ? kf[2 * s_ + 1] : *(const LAS s16x8*)(Kn + (32 + r32) * KPB + 32 * s_ + 16 * hi); \
            TA_ = mfma32(a0_, qf[s_], TA_); TB_ = mfma32(a1_, qf[s_], TB_); } \
        float ls = 0.f; \
_Pragma("unroll") \
        for (int r = 0; r < 16; ++r) { SA_[r] = __builtin_amdgcn_exp2f(SA_[r] - mrun); SB_[r] = __builtin_amdgcn_exp2f(SB_[r] - mrun); ls += SA_[r] + SB_[r]; } \
        lrun += ls; \
        s16x8 pf[4]; \
        { u32x4 w; \
          w.x = pk16(SA_[0], SA_[1]); w.y = pk16(SA_[2], SA_[3]); w.z = pk16(SA_[4], SA_[5]); w.w = pk16(SA_[6], SA_[7]); pf[0] = __builtin_bit_cast(s16x8, w); \
          w.x = pk16(SA_[8], SA_[9]); w.y = pk16(SA_[10], SA_[11]); w.z = pk16(SA_[12], SA_[13]); w.w = pk16(SA_[14], SA_[15]); pf[1] = __builtin_bit_cast(s16x8, w); \
          w.x = pk16(SB_[0], SB_[1]); w.y = pk16(SB_[2], SB_[3]); w.z = pk16(SB_[4], SB_[5]); w.w = pk16(SB_[6], SB_[7]); pf[2] = __builtin_bit_cast(s16x8, w); \
          w.x = pk16(SB_[8], SB_[9]); w.y = pk16(SB_[10], SB_[11]); w.z = pk16(SB_[12], SB_[13]); w.w = pk16(SB_[14], SB_[15]); pf[3] = __builtin_bit_cast(s16x8, w); } \
_Pragma("unroll") \
        for (int i_ = 0; i_ < 2 * NS; ++i_) { __builtin_amdgcn_sched_group_barrier(0x008, 1, 0); \
            __builtin_amdgcn_sched_group_barrier(0x002, (96 + 2 * NS - 1) / (2 * NS), 0); __builtin_amdgcn_sched_group_barrier(0x400, (32 + 2 * NS - 1) / (2 * NS), 0); \
            if (i_ < 2 * NS - PREK) __builtin_amdgcn_sched_group_barrier(0x100, 1, 0); }        \
        __builtin_amdgcn_sched_barrier(0); \
_Pragma("unroll") \
        for (int db = 0; db < NDB; ++db) \
_Pragma("unroll") \
            for (int sp = 0; sp < 4; ++sp) { const s16x8 v_ = (db * 4 + sp < PREV) ? vf[db * 4 + sp] : *(const LAS s16x8*)(Vl + (32 * db + r32) * VPB + 32 * sp + 16 * hi); \
                o[db] = mfma32(pf[sp], v_, o[db]); } \
        if (4 * NDB - PREV > 3) { __builtin_amdgcn_sched_group_barrier(0x100, 3, 0);        \
_Pragma("unroll") \
            for (int i_ = 0; i_ < 4 * NDB; ++i_) { __builtin_amdgcn_sched_group_barrier(0x008, 1, 0); if (i_ < 4 * NDB - PREV - 3) __builtin_amdgcn_sched_group_barrier(0x100, 1, 0); } } \
        if (BAR_) __syncthreads(); \
        st_cur = st_nxt; st_nxt = (st_nxt + 1 == NSTG) ? 0 : st_nxt + 1; st_fill = (st_fill + 1 == NSTG) ? 0 : st_fill + 1; \
    } while (0)
    if (DV == 64) {
        for (int t2_ = 0; t2_ < NT; t2_ += 2) { ATT_TILE(S0, S1, T0, T1, t2_, 0); ATT_TILE(T0, T1, S0, S1, (t2_ + 1), 1); }
    } else {
        for (int t_ = 0; t_ < NT; ++t_) { ATT_TILE(S0, S1, T0, T1, t_, 1); S0 = T0; S1 = T1; }
    }
#undef ATT_TILE

#undef ATT_QK
#undef ATT_LOAD
#undef ATT_STORE
    lrun += __shfl_xor(lrun, 32);
    if (hi == 0) wsc[r32] = 1.f / lrun;
    asm volatile("s_waitcnt lgkmcnt(0)" ::: "memory");
#pragma unroll
    for (int g = 0; g < 4; ++g) { const f32x4 a4 = *(const LAS f32x4*)(wsc + 8 * g + 4 * hi);
#pragma unroll
        for (int e = 0; e < 4; ++e) { const int r = 4 * g + e; const int qrow = q0w + 8 * g + 4 * hi + e;
#pragma unroll
            for (int db = 0; db < NDB; ++db) Oh[(size_t)qrow * ldo + 32 * db + r32] = f2h(o[db][r] * a4[e]); } }
    asm volatile("s_waitcnt lgkmcnt(0)" ::: "memory");
    __syncthreads();
}

__device__ __forceinline__ unsigned okey(float f) { const unsigned u = __float_as_uint(f); return (u & 0x80000000u) ? ~u : (u | 0x80000000u); }
#define LDS_FENCE() asm volatile("s_waitcnt lgkmcnt(0)" ::: "memory")

template <int NE, int TOP> __device__ __forceinline__ unsigned radix_kth(const unsigned (&ek)[NE], unsigned vmask, int m, LAS unsigned* hist, int lane, int& m_rem) {
    unsigned prefix = 0; int mm = m;
#pragma unroll
    for (int sh = TOP; sh >= 0; sh -= 8) {
        hist[lane] = 0u; hist[lane + 64] = 0u; hist[lane + 128] = 0u; hist[lane + 192] = 0u;
        LDS_FENCE();
#pragma unroll
        for (int e = 0; e < NE; ++e) { const bool ok = ((vmask >> e) & 1u) && (sh == TOP || (ek[e] >> ((sh + 8) & 31)) == (prefix >> ((sh + 8) & 31)));
            if (ok) __hip_atomic_fetch_add(&hist[(ek[e] >> sh) & 255u], 1u, __ATOMIC_RELAXED, __HIP_MEMORY_SCOPE_WORKGROUP); }
        LDS_FENCE();
        const unsigned c0 = hist[255 - 4 * lane], c1 = hist[254 - 4 * lane], c2 = hist[253 - 4 * lane], c3 = hist[252 - 4 * lane];
        LDS_FENCE();
        const int T = (int)(c0 + c1 + c2 + c3); int I = T;
#pragma unroll
        for (int o = 1; o < 64; o <<= 1) { const int t = __shfl_up(I, o); if (lane >= o) I += t; }
        const int E = I - T; const bool mine = (E < mm) && (mm <= I);
        int dsel = 0, mnew = 0;
        if (mine) { int r = E;
            if (mm <= r + (int)c0) { dsel = 255 - 4 * lane; mnew = mm - r; }
            else { r += (int)c0; if (mm <= r + (int)c1) { dsel = 254 - 4 * lane; mnew = mm - r; }
                else { r += (int)c1; if (mm <= r + (int)c2) { dsel = 253 - 4 * lane; mnew = mm - r; } else { r += (int)c2; dsel = 252 - 4 * lane; mnew = mm - r; } } } }
        const unsigned long long b = __ballot(mine); const int src = b ? (__ffsll((long long)b) - 1) : 0;
        dsel = __shfl(dsel, src); mnew = __shfl(mnew, src);
        prefix |= (unsigned)dsel << sh; mm = mnew;
    }
    m_rem = mm; return prefix;
}

template <int NE, int NBITS> __device__ __forceinline__ unsigned kth_bisect(const unsigned (&ek)[NE], int m, int& m_rem) {
    unsigned v = 0u;
#pragma unroll 1
    for (int bit = NBITS - 1; bit >= 0; --bit) { const unsigned cand = v | (1u << bit); int cnt = 0;
#pragma unroll
        for (int e = 0; e < NE; ++e) cnt += __popcll(__ballot(ek[e] >= cand));
        if (cnt >= m) v = cand; }
    int gt = 0;
#pragma unroll
    for (int e = 0; e < NE; ++e) gt += __popcll(__ballot(ek[e] > v));
    m_rem = m - gt; return v;
}

__device__ __forceinline__ void dsa_indexer(const Ptrs& P, LAS uchar* lds, int vcu, int G) {
    const int tid = opaque_tid(), lane = tid & 63, wid = __builtin_amdgcn_readfirstlane(tid >> 6), r32 = lane & 31, hi = lane >> 5;
    const u16* QI = (const u16*)(P.ws + WS_DQI); const u16* KI = (const u16*)(P.ws + WS_DKI); const float* WI = (const float*)(P.ws + WS_DWI);
    unsigned* bitsg = (unsigned*)(P.ws + WS_DBITS);
    float* listf = (float*)(P.ws + WS_A16 + (size_t)vcu * 131072); u16* lists = (u16*)listf;
    float* candS = (float*)P.out + (size_t)vcu * 32768; u16* candI = (u16*)((uchar*)P.out + 32 * MiB) + (size_t)vcu * 32768;
    LAS unsigned* lbits = (LAS unsigned*)lds;
    LAS unsigned* hist = (LAS unsigned*)(lds + 65536) + wid * 256;
    LAS unsigned* cnt = (LAS unsigned*)(lds + 65536 + 8192);
    LAS unsigned* tau = cnt + 32;
    LAS uchar* qlds = lds + 65536 + 8192 + 256;
    LAS float* wlds = (LAS float*)(qlds + 32 * 1168);
    constexpr int CAP = 1024, MSAMP = 64;
    for (int blk0 = vcu; blk0 < 256; blk0 += G) for (int side = 0; side < 2; ++side) {
        const int blk = side ? 511 - blk0 : blk0;
        const int t0 = 32 * blk, NT = blk + 1, tq = t0 + r32;
        const int tid2 = opaque_tid();
        for (int c = tid2; c < 2048; c += NTHR) { const int row = c >> 6, cc = c & 63; *(LAS u32x4*)(qlds + row * 1168 + cc * 16) = *(const u32x4*)(QI + (size_t)(t0 + row) * 512 + cc * 8); }
        if (tid2 < 64) *(LAS f32x4*)(wlds + tid2 * 4) = *(const f32x4*)(WI + (size_t)t0 * 8 + tid2 * 4) * 0.5f;
        const LAS uchar* qrow = qlds + r32 * 1168 + 16 * hi; const LAS float* wrow = wlds + r32 * 8;
#define IDX_LOADK(keyrow) do { _Pragma("unroll") for (int s = 0; s < 4; ++s) afn[s] = *(const s16x8*)(KI + (size_t)(keyrow) * 64 + 16 * s + 8 * hi); } while (0)
#define IDX_RD(Q, hp_) do { const LAS uchar* qp_ = qrow_ + (hp_) * 256; _Pragma("unroll") for (int s = 0; s < 4; ++s) { Q[2 * s] = *(const LAS s16x8*)(qp_ + s * 32); Q[2 * s + 1] = *(const LAS s16x8*)(qp_ + 128 + s * 32); } } while (0)
#define IDX_MM(A_, B_, Q) do { _Pragma("unroll") for (int r = 0; r < 16; ++r) { A_[r] = 0.f; B_[r] = 0.f; } _Pragma("unroll") for (int s = 0; s < 4; ++s) { A_ = mfma32(af[s], Q[2 * s], A_); B_ = mfma32(af[s], Q[2 * s + 1], B_); } } while (0)
#define IDX_VA(A_, B_, hp_) do { const f32x2 w2_ = *(const LAS f32x2*)(wrow + 2 * (hp_)); _Pragma("unroll") for (int r = 0; r < 16; ++r) { sc[r] = __builtin_fmaf(w2_.x, __builtin_fabsf(A_[r]), sc[r]); sc[r] = __builtin_fmaf(w2_.y, __builtin_fabsf(B_[r]), sc[r]); } } while (0)
#define IDX_SCORES(nextrow) s16x8 af[4]; _Pragma("unroll") for (int s = 0; s < 4; ++s) af[s] = afn[s]; IDX_LOADK(nextrow);     \
        float sc[16]; \
        { const LAS uchar* qrow_ = qrow; asm volatile("" : "+v"(qrow_));        \
          s16x8 qa_[8]; f32x16 a0_, b0_, a1_, b1_; \
          _Pragma("unroll") for (int s = 0; s < 4; ++s) qa_[s] = *(const LAS s16x8*)(qrow_ + 1024 + s * 32); \
          __builtin_amdgcn_sched_barrier(0); \
          { f32x16 l_; _Pragma("unroll") for (int r = 0; r < 16; ++r) l_[r] = 0.f; _Pragma("unroll") for (int s = 0; s < 4; ++s) l_ = mfma32(af[s], qa_[s], l_); \
            __builtin_amdgcn_sched_barrier(0); IDX_RD(qa_, 0); __builtin_amdgcn_sched_barrier(0); IDX_MM(a0_, b0_, qa_); __builtin_amdgcn_sched_barrier(0); \
            _Pragma("unroll") for (int r = 0; r < 16; ++r) sc[r] = l_[r]; } \
          IDX_RD(qa_, 1); __builtin_amdgcn_sched_barrier(0); \
          IDX_MM(a1_, b1_, qa_); __builtin_amdgcn_sched_barrier(0); IDX_RD(qa_, 2); __builtin_amdgcn_sched_barrier(0); IDX_VA(a0_, b0_, 0); __builtin_amdgcn_sched_barrier(0); \
          IDX_MM(a0_, b0_, qa_); __builtin_amdgcn_sched_barrier(0); IDX_RD(qa_, 3); __builtin_amdgcn_sched_barrier(0); IDX_VA(a1_, b1_, 1); __builtin_amdgcn_sched_barrier(0); \
          IDX_MM(a1_, b1_, qa_); __builtin_amdgcn_sched_barrier(0); IDX_VA(a0_, b0_, 2); __builtin_amdgcn_sched_barrier(0); IDX_VA(a1_, b1_, 3); } \
          \
        asm volatile("; afn retired" : "+v"(afn[0]), "+v"(afn[1]), "+v"(afn[2]), "+v"(afn[3]));
        for (int i = tid2; i < NT * 32; i += NTHR) lbits[i] = 0u;
        if (tid2 < 32) cnt[tid2] = 0u;
        __syncthreads();
        for (int c = tid2; c < 2048; c += NTHR) { const int q_ = c >> 6, d_ = c & 63; const LAS u16* qh_ = (const LAS u16*)(qlds + q_ * 1168) + d_; float a_ = 0.f;
#pragma unroll
            for (int hh = 0; hh < 8; ++hh) a_ += wlds[q_ * 8 + hh] * h2f(qh_[hh * 64]);
            ((LAS u16*)(qlds + q_ * 1168))[512 + d_] = f2h(a_); }
        __syncthreads();
        const bool exact = (t0 + 32 <= 1024);
        if (exact) {
            {
            s16x8 afn[4]; IDX_LOADK(32 * min(wid, NT - 1) + r32);
#pragma unroll 1
            for (int jt = wid; jt < NT; jt += 8) { IDX_SCORES(32 * min(jt + 8, NT - 1) + r32)
                int r32l = r32; asm volatile("" : "+v"(r32l));
#pragma unroll
                for (int r = 0; r < 16; ++r) { const int key = 32 * jt + (r & 3) + 8 * (r >> 2) + 4 * hi; if (key <= tq) listf[(size_t)r32l * 1024 + key] = sc[r]; } } }
            __syncthreads();
            for (int q = wid; q < 32; q += 8) { const int t = t0 + q, n = t + 1; int lanel = lane; asm volatile("" : "+v"(lanel));
                unsigned ek[16]; unsigned vmask = 0u;
#pragma unroll
                for (int e = 0; e < 16; ++e) { const int p = e * 64 + lanel; const bool v = p < n; ek[e] = v ? okey(listf[(size_t)q * 1024 + p]) : 0u; vmask |= (v ? 1u : 0u) << e; }
                unsigned thr = 0u; int mrem = 0x7fffffff;
                if (n > 256) thr = radix_kth<16, 24>(ek, vmask, 256, hist, lane, mrem);
                int eqbase = 0;
#pragma unroll
                for (int e = 0; e < 16; ++e) { const bool v = (vmask >> e) & 1u; const bool gt = v && ek[e] > thr, eq = v && ek[e] == thr;
                    const unsigned long long be = __ballot(eq); const int ord = eqbase + __popcll(be & ((1ull << lane) - 1ull)); eqbase += __popcll(be);
                    if (gt || (eq && ord < mrem)) { const int p = e * 64 + lane; __hip_atomic_fetch_or(&lbits[(p >> 5) * 32 + q], 1u << (p & 31), __ATOMIC_RELAXED, __HIP_MEMORY_SCOPE_WORKGROUP); } }
            }
        } else {
            const int NTS = (t0 + 32 + 255) / 256;
            for (int rp_ = 0; rp_ < ((IDXREP & 1) ? 2 : 1); ++rp_) {
            s16x8 afn[4]; IDX_LOADK(8 * (32 * min(wid, NTS - 1) + r32));
#pragma unroll 1
            for (int js = wid; js < NTS; js += 8) { IDX_SCORES(8 * (32 * min(js + 8, NTS - 1) + r32))
                int r32l = r32; asm volatile("" : "+v"(r32l));
#pragma unroll
                for (int r = 0; r < 16; ++r) { const int so = 32 * js + (r & 3) + 8 * (r >> 2) + 4 * hi; if (8 * so <= tq) lists[(size_t)r32l * 2048 + so] = (u16)(okey(sc[r]) >> 16); } } }
            __syncthreads();
            for (int rp_ = 0; rp_ < ((IDXREP & 2) ? 2 : 1); ++rp_)
            for (int q = wid; q < 32; q += 8) { const int t = t0 + q, ns = (t >> 3) + 1; int lanel = lane; asm volatile("" : "+v"(lanel));
                unsigned ek[32]; unsigned vmask = 0u;
#pragma unroll
                for (int e = 0; e < 32; ++e) { const int p = e * 64 + lanel; const bool v = p < ns; ek[e] = v ? (unsigned)lists[(size_t)q * 2048 + p] : 0u; vmask |= (v ? 1u : 0u) << e; }
                int mrem; const unsigned thr = radix_kth<32, 8>(ek, vmask, MSAMP, hist, lane, mrem);
                if (lane == 0) tau[q] = thr;
            }
            __syncthreads();
            const unsigned tq16 = tau[r32];
            const unsigned tk_ = tq16 << 16; const float tauf = __uint_as_float((tk_ & 0x80000000u) ? (tk_ ^ 0x80000000u) : ~tk_);
            {
            LAS u32x2* stg = (LAS u32x2*)(lds + 112384) + wid * 128; int nst = 0;
#define IDX_FLUSH(n_) do { asm volatile("" ::: "memory"); if (lane < (n_)) { const u32x2 e_ = stg[lane]; const unsigned q_ = e_.y >> 16; \
                const unsigned pos_ = __hip_atomic_fetch_add(&cnt[q_], 1u, __ATOMIC_RELAXED, __HIP_MEMORY_SCOPE_WORKGROUP); \
                if (pos_ < (unsigned)CAP) { candS[(size_t)q_ * CAP + pos_] = __uint_as_float(e_.x); candI[(size_t)q_ * CAP + pos_] = (u16)(e_.y & 0xffffu); } } } while (0)
            s16x8 afn[4]; IDX_LOADK(32 * min(wid, NT - 1) + r32);
#pragma unroll 1
            for (int jt = wid; jt < NT; jt += 8) { IDX_SCORES(32 * min(jt + 8, NT - 1) + r32)
#define IDX_CAND(CAUS_) do { const unsigned kw_ = ((unsigned)r32 << 16) | (unsigned)(32 * jt + 4 * hi); \
                _Pragma("unroll") for (int r = 0; r < 16; ++r) { const unsigned kwr_ = kw_ | (unsigned)((r & 3) + 8 * (r >> 2)); \
                    bool p_ = sc[r] >= tauf; if (CAUS_) p_ = p_ && ((int)(kwr_ & 0xffffu) <= tq); \
                    const unsigned long long bal_ = __ballot(p_); \
                    if (bal_) { \
                        if (p_) { const int slot_ = (int)__builtin_amdgcn_mbcnt_hi((unsigned)(bal_ >> 32), __builtin_amdgcn_mbcnt_lo((unsigned)bal_, (unsigned)nst)); stg[slot_] = (u32x2){__float_as_uint(sc[r]), kwr_}; } \
                        nst += __popcll(bal_); \
                        if (nst >= 64) { IDX_FLUSH(64); asm volatile("" ::: "memory"); \
                            const int rem_ = nst - 64; u32x2 mv_ = {0u, 0u}; if (lane < rem_) mv_ = stg[64 + lane]; asm volatile("" ::: "memory"); if (lane < rem_) stg[lane] = mv_; nst = rem_; __builtin_amdgcn_s_waitcnt(0xc07f);   } \
                    } } } while (0)
                if (jt == NT - 1) IDX_CAND(1); else IDX_CAND(0);
#undef IDX_CAND
            }
            IDX_FLUSH(nst);
#undef IDX_FLUSH
            }
            __syncthreads();
            for (int rp_ = 0; rp_ < ((IDXREP & 8) ? 2 : 1); ++rp_)
            for (int q = wid; q < 32; q += 8) { const int n = min((int)cnt[q], CAP); int lanel = lane; asm volatile("" : "+v"(lanel));
                unsigned ek[16]; unsigned ei[16]; unsigned vmask = 0u;
#pragma unroll
                for (int e = 0; e < 16; ++e) { const int p = e * 64 + lanel; const bool v = p < n; ek[e] = v ? okey(candS[(size_t)q * CAP + p]) : 0u; ei[e] = v ? (unsigned)candI[(size_t)q * CAP + p] : 0u; vmask |= (v ? 1u : 0u) << e; }
                unsigned thr = 0u; int mrem = 0x7fffffff;
                if (n > 256) thr = radix_kth<16, 24>(ek, vmask, 256, hist, lane, mrem);
                int eqbase = 0;
#pragma unroll
                for (int e = 0; e < 16; ++e) { const bool v = (vmask >> e) & 1u; const bool gt = v && ek[e] > thr, eq = v && ek[e] == thr;
                    const unsigned long long be = __ballot(eq); const int ord = eqbase + __popcll(be & ((1ull << lane) - 1ull)); eqbase += __popcll(be);
                    if (gt || (eq && ord < mrem)) { const unsigned p = ei[e]; __hip_atomic_fetch_or(&lbits[(p >> 5) * 32 + q], 1u << (p & 31), __ATOMIC_RELAXED, __HIP_MEMORY_SCOPE_WORKGROUP); } }
            }
        }
        __syncthreads();
        { const int tid3 = opaque_tid(); for (int i = tid3; i < NT * 32; i += NTHR) bitsg[(size_t)(i >> 5) * L + t0 + (i & 31)] = lbits[i]; }
        __syncthreads();
#undef IDX_SCORES
#undef IDX_LOADK
#undef IDX_RD
#undef IDX_MM
#undef IDX_VA
    }
}

__device__ __forceinline__ void conv_dw_phase(const Ptrs& P, LAS uchar* lds, int vcu, int G) {
    const int tid = opaque_tid(), lane = tid & 63, wid = __builtin_amdgcn_readfirstlane(tid >> 6);
    const u16* U = (const u16*)(P.ws + WS_CU); u16* CL = (u16*)(P.ws + WS_CL);
    const float* wdw = P.in(12); const float* bdw = P.in(13); const float* lng = P.in(14); const float* lnb = P.in(15);
    LAS float* co = (LAS float*)lds;
    for (int it = vcu; it < L / 32; it += G) {
        const int t0 = it * 32;
        { const int ch = 2 * tid;
            f32x2 w[31];
#pragma unroll
            for (int j = 0; j < 31; ++j) w[j] = *(const f32x2*)(wdw + j * 1024 + ch);
            const f32x2 bb = *(const f32x2*)(bdw + ch);
#pragma unroll 1
            for (int hf = 0; hf < 2; ++hf) {
                unsigned wr[46];
#pragma unroll
                for (int i = 0; i < 46; ++i) { const int t = t0 - 30 + 16 * hf + i; const unsigned uu = *(const unsigned*)(U + (size_t)(t > 0 ? t : 0) * 1024 + ch); wr[i] = (t >= 0) ? uu : 0u; }
                f32x2 acc[16];
#pragma unroll
                for (int tt = 0; tt < 16; ++tt) acc[tt] = bb;
#pragma unroll
                for (int i = 0; i < 46; ++i) { const unsigned uu = wr[i]; const h16x2 hh = __builtin_bit_cast(h16x2, uu); const f32x2 wi = {(float)hh[0], (float)hh[1]};
#pragma unroll
                    for (int tt = 0; tt < 16; ++tt) { if (i - tt >= 0 && i - tt <= 30) acc[tt] += w[i - tt] * wi; } }
#pragma unroll
                for (int tt = 0; tt < 16; ++tt) *(LAS f32x2*)(co + (16 * hf + tt) * 1024 + ch) = acc[tt];
            }
        }
        __syncthreads();
#pragma unroll 1
        for (int k = 0; k < 4; ++k) { const int tt = wid * 4 + k; float v[16]; float s = 0.f;
#pragma unroll
            for (int i = 0; i < 16; ++i) { v[i] = co[tt * 1024 + lane + 64 * i]; s += v[i]; }
            const float mean = wave_sum(s) * (1.f / 1024.f); float q = 0.f;
#pragma unroll
            for (int i = 0; i < 16; ++i) { v[i] -= mean; q += v[i] * v[i]; }
            const float rstd = rsqrtf(wave_sum(q) * (1.f / 1024.f) + EPS);
#pragma unroll
            for (int i = 0; i < 16; ++i) { const int ch = lane + 64 * i; const float y = v[i] * rstd * lng[ch] + lnb[ch]; CL[(size_t)(t0 + tt) * 1024 + ch] = f2h(siluf_(y)); }
        }
        __syncthreads();
    }
}

__device__ __forceinline__ void gdn_pre(const Ptrs& P, LAS uchar* lds, int vcu, int G) {
    const int tid_ = opaque_tid(), lane = tid_ & 63, wave = __builtin_amdgcn_readfirstlane(tid_ >> 6);
    const int gw = vcu * NWAVES + wave, NGW = G * NWAVES;
    const u16* RQ = (const u16*)(P.ws + WS_GQ); u16* HALO = (u16*)(P.ws + WS_GHALO);
    for (long c = (long)gw * 64 + lane; c < 256L * 9 * 128; c += (long)NGW * 64) {
        const int it = (int)(c >> 7), ch = (int)(c & 127); const int n = it / 9, r = it % 9, j = r / 3, which = r % 3;
        if (n == 0) continue;
        const u16* src = RQ + (size_t)which * (16 * MiB) + (size_t)(64 * n - 3 + j) * 1024 + ch * 8;
        *(u32x4*)(HALO + ((size_t)(n * 3 + j) * 3 + which) * 1024 + ch * 8) = *(const u32x4*)src;
    }
    const u16* h = (const u16*)(P.ws + WS_A16); const float* W = P.in(24); const float* gmix = P.in(1) + 3 * 1024;
    float* Gd = (float*)(P.ws + WS_GG); float* Bt = (float*)(P.ws + WS_GBETA);
    const float* alog = P.in(26); const float* dtb = P.in(27);
    LAS u16* Bl = (LAS u16*)lds; constexpr int BP = 1032;
    for (int kk = tid_; kk < 1024; kk += NTHR) { const float g = gmix[kk]; const float* wp = W + (size_t)kk * 4112 + 4096;
#pragma unroll
        for (int q = 0; q < 4; ++q) { const f32x4 a = *(const f32x4*)(wp + 4 * q);
#pragma unroll
            for (int e = 0; e < 4; ++e) Bl[(4 * q + e) * BP + kk] = f2h(a[e] * g); } }
    __syncthreads();
    for (int b = vcu + G * wave; b < L / 16; b += G * NWAVES) {
        const int r = lane & 15, g = lane >> 4, m0 = 16 * b;
        const u16* hp = h + (size_t)(m0 + r) * 1024 + 8 * g;
        s16x8 af[32];
#pragma unroll
        for (int ks = 0; ks < 32; ++ks) af[ks] = *(const s16x8*)(hp + 32 * ks);
        f32x4 acc = {0.f, 0.f, 0.f, 0.f}; float ss = 0.f;
#pragma unroll
        for (int ks = 0; ks < 32; ++ks) { const s16x8 bfr = *(const LAS s16x8*)(Bl + r * BP + 32 * ks + 8 * g);
            acc = mfma16(af[ks], bfr, acc);
            const h16x8 hv = __builtin_bit_cast(h16x8, af[ks]);
#pragma unroll
            for (int p2 = 0; p2 < 4; ++p2) { const h16x2 pr = {hv[2 * p2], hv[2 * p2 + 1]}; ss = __builtin_amdgcn_fdot2(pr, pr, ss, false); }
            if ((ks & 3) == 3) __builtin_amdgcn_sched_barrier(0); }
        ss += __shfl_xor(ss, 16); ss += __shfl_xor(ss, 32);
        const float rs = rsqrtf(ss * (1.f / 1024.f) + EPS);
        const int c = r;
#pragma unroll
        for (int reg = 0; reg < 4; ++reg) { const int row = 4 * g + reg; const float v = acc[reg] * __shfl(rs, row); const size_t m = (size_t)(m0 + row);
            if (c < 8) Bt[m * 8 + c] = sigmoidf_(v);
            else { const int cc = c - 8; const float xx = v + dtb[cc]; const float sp = xx > 20.f ? xx : log1pf(__expf(xx)); Gd[m * 8 + cc] = -__expf(alog[cc]) * sp; } }
    }
}

__device__ __forceinline__ s16x8 pk2blk(f32x4 a, f32x4 b) { return __builtin_bit_cast(s16x8, pack8(a, b)); }
__device__ __forceinline__ void gdn_chunk(const Ptrs& P, LAS uchar* lds, int vcu, int G) {
    u16* RQ = (u16*)(P.ws + WS_GQ); u16* RK = (u16*)(P.ws + WS_GK); u16* RV = (u16*)(P.ws + WS_GV); u16* WB = (u16*)(P.ws + WS_GW); u16* QK = (u16*)(P.ws + WS_GQK);
    const u16* HALO = (const u16*)(P.ws + WS_GHALO); const float* Gd = (const float*)(P.ws + WS_GG); const float* Bt = (const float*)(P.ws + WS_GBETA); float* GL = (float*)(P.ws + WS_GGL);
    const float* cw = P.in(25);
    constexpr int PT = 132;
    LAS float* Am = (LAS float*)lds; LAS float* gcs = Am + 4096; LAS float* egc = gcs + 64; LAS float* bet = egc + 64;
    LAS float* qs = bet + 64; LAS float* ks = qs + 64 * PT; LAS float* vs = ks + 64 * PT;
    LAS u16* xw = (LAS u16*)(vs + 64 * PT);
    for (int it = vcu; it < 2048; it += G) {
        const int n = it >> 3, hd = it & 7;
        const int tid = opaque_tid(), lane = tid & 63, wid = __builtin_amdgcn_readfirstlane(tid >> 6);
        for (int rp_ = 0; rp_ < ((CHREP & 1) ? 2 : 1); ++rp_)
        if (tid < 384) { const int which = tid >> 7, ch = tid & 127, col = hd * 128 + ch;
            const u16* src = (which == 0 ? RQ : which == 1 ? RK : RV) + col; LAS float* dst = (which == 0 ? qs : which == 1 ? ks : vs) + ch;
            const float c0 = cw[0 * 3072 + which * 1024 + col], c1 = cw[1 * 3072 + which * 1024 + col], c2 = cw[2 * 3072 + which * 1024 + col], c3 = cw[3 * 3072 + which * 1024 + col];
            float x0 = 0.f, x1 = 0.f, x2 = 0.f;
            if (n > 0) { const u16* hp = HALO + ((size_t)(n * 3) * 3 + which) * 1024 + col; x0 = h2f(hp[0]); x1 = h2f(hp[3 * 1024]); x2 = h2f(hp[6 * 1024]); }
            u16 xr[64];
#pragma unroll
            for (int c = 0; c < 64; ++c) xr[c] = src[(size_t)(64 * n + c) * 1024];
#pragma unroll
            for (int c = 0; c < 64; ++c) { const float x3 = h2f(xr[c]); const float y = c0 * x0 + c1 * x1 + c2 * x2 + c3 * x3; dst[c * PT] = siluf_(y); x0 = x1; x1 = x2; x2 = x3; }
        } else if (tid < 448) { const int c = tid - 384; float g = Gd[(size_t)(64 * n + c) * 8 + hd];
#pragma unroll
            for (int o = 1; o < 64; o <<= 1) { const float t = __int_as_float(__builtin_amdgcn_ds_bpermute((lane - o) * 4, __float_as_int(g))); if (lane >= o) g += t; }
            gcs[c] = g; egc[c] = __expf(g); bet[c] = Bt[(size_t)(64 * n + c) * 8 + hd];
        }
        __syncthreads();
        { const int r = tid >> 2, pq = tid & 3; LAS float* row = (r < 64 ? qs + r * PT : ks + (r - 64) * PT) + 32 * pq;
          f32x4 e[8]; float s = 0.f;
#pragma unroll
          for (int k = 0; k < 8; ++k) { e[k] = *(const LAS f32x4*)(row + 4 * ((k + 2 * pq) & 7)); s += (e[k][0] * e[k][0] + e[k][1] * e[k][1]) + (e[k][2] * e[k][2] + e[k][3] * e[k][3]); }
          s += __shfl_xor(s, 1); s += __shfl_xor(s, 2);
          const float rn = rsqrtf(s + EPS) * (r < 64 ? GDN_QS : 1.f);
#pragma unroll
          for (int k = 0; k < 8; ++k) *(LAS f32x4*)(row + 4 * ((k + 2 * pq) & 7)) = e[k] * rn; }
        __syncthreads();
        { const int ib = wid & 3, r = lane & 15, g = lane >> 4, i = 16 * ib + r; const bool isq = wid >= 4;
          const LAS float* X = isq ? qs : ks;
          s16x8 bf[4];
#pragma unroll
          for (int k4 = 0; k4 < 4; ++k4) bf[k4] = pk2blk(*(const LAS f32x4*)(X + i * PT + 32 * k4 + 8 * g), *(const LAS f32x4*)(X + i * PT + 32 * k4 + 8 * g + 4));
          const float gi = gcs[i], bi = bet[i];
          f32x4 dv[4];
#pragma unroll
          for (int jb = 0; jb < 4; ++jb) { dv[jb] = (f32x4){0.f, 0.f, 0.f, 0.f};
              if (jb <= ib) {
                  f32x4 acc = {0.f, 0.f, 0.f, 0.f};
#pragma unroll
                  for (int k4 = 0; k4 < 4; ++k4) { const s16x8 af = pk2blk(*(const LAS f32x4*)(ks + (16 * jb + r) * PT + 32 * k4 + 8 * g), *(const LAS f32x4*)(ks + (16 * jb + r) * PT + 32 * k4 + 8 * g + 4));
                      acc = mfma16(af, bf[k4], acc); }
                  const f32x4 gj = *(const LAS f32x4*)(gcs + 16 * jb + 4 * g);
#pragma unroll
                  for (int e = 0; e < 4; ++e) { const int j = 16 * jb + 4 * g + e; const float dec = __expf(gi - gj[e]);
                      dv[jb][e] = isq ? ((j <= i) ? acc[e] * dec : 0.f) : ((j < i) ? bi * acc[e] * dec : 0.f); }
                  if (!isq) *(LAS f32x4*)(Am + i * 64 + 16 * jb + 4 * g) = dv[jb];
              } }
          if (isq) {
#pragma unroll
              for (int k2 = 0; k2 < 2; ++k2) *(u32x4*)(QK + (size_t)it * 4096 + (ib * 2 + k2) * 512 + lane * 8) = pack8(dv[2 * k2], dv[2 * k2 + 1]); }
        }
        __syncthreads();
        for (int rp_ = 0; rp_ < ((CHREP & 8) ? 2 : 1); ++rp_)
        if (tid < 256) {
            const int col = tid; f32x2 xv[32];
            if (col < 128) {
#pragma unroll
                for (int m = 0; m < 32; ++m) xv[m] = (f32x2){bet[2 * m] * vs[(2 * m) * PT + col], bet[2 * m + 1] * vs[(2 * m + 1) * PT + col]};
            } else {
#pragma unroll
                for (int m = 0; m < 32; ++m) xv[m] = (f32x2){bet[2 * m] * egc[2 * m] * ks[(2 * m) * PT + col - 128], bet[2 * m + 1] * egc[2 * m + 1] * ks[(2 * m + 1) * PT + col - 128]};
            }
            f32x4 ra[8], rb[8], rc[8];
            ra[0] = *(const LAS f32x4*)(Am + 1 * 64);
#pragma unroll
            for (int i = 1; i < 64; ++i) {
#pragma unroll
                for (int jq = 8; jq < (i + 3) / 4; ++jq) rc[jq - 8] = *(const LAS f32x4*)(Am + i * 64 + 4 * jq);
                if (i + 1 < 64) {
#pragma unroll
                    for (int jq = 0; jq < ((i + 4) / 4 < 8 ? (i + 4) / 4 : 8); ++jq) { if (i & 1) rb[jq] = *(const LAS f32x4*)(Am + (i + 1) * 64 + 4 * jq); else ra[jq] = *(const LAS f32x4*)(Am + (i + 1) * 64 + 4 * jq); }
                }
                f32x2 s01 = {xv[i >> 1][i & 1], 0.f}, s23 = {0.f, 0.f};
#pragma unroll
                for (int jq = 0; jq < (i + 3) / 4; ++jq) { const f32x4 a4 = (jq < 8) ? ((i & 1) ? ra[jq] : rb[jq]) : rc[jq - 8];
                    if (4 * jq + 1 < i) s01 -= (f32x2){a4[0], a4[1]} * xv[2 * jq]; else s01[0] -= a4[0] * xv[2 * jq][0];
                    if (4 * jq + 3 < i) s23 -= (f32x2){a4[2], a4[3]} * xv[2 * jq + 1]; else if (4 * jq + 2 < i) s23[0] -= a4[2] * xv[2 * jq + 1][0]; }
                xv[i >> 1][i & 1] = (s01[0] + s01[1]) + (s23[0] + s23[1]);
                __builtin_amdgcn_sched_barrier(0);
            }
            if (col < 128) { u16* dst = RV + (size_t)(64 * n + (col >> 1)) * 1024 + hd * 128 + (col & 1) * 64;
#pragma unroll
                for (int c8 = 0; c8 < 8; ++c8) { u32x4 w; w.x = pk16(xv[4 * c8][0], xv[4 * c8][1]); w.y = pk16(xv[4 * c8 + 1][0], xv[4 * c8 + 1][1]); w.z = pk16(xv[4 * c8 + 2][0], xv[4 * c8 + 2][1]); w.w = pk16(xv[4 * c8 + 3][0], xv[4 * c8 + 3][1]); *(u32x4*)(dst + 8 * c8) = w; }
            } else {
#pragma unroll
                for (int c = 0; c < 64; ++c) xw[c * 136 + (col - 128)] = f2h(xv[c >> 1][c & 1]); }
        } else { const int t2 = tid - 256; const float gl = gcs[63];
            for (int idx = t2; idx < 1024; idx += 256) { const int c = idx >> 4, ksx = (idx >> 2) & 3, g = idx & 3; const float e = egc[c];
                const f32x4 a = *(const LAS f32x4*)(qs + c * PT + 32 * ksx + 4 * g) * e, b = *(const LAS f32x4*)(qs + c * PT + 32 * ksx + 16 + 4 * g) * e;
                const int f = (c >> 4) * 4 + ksx;
                *(u32x4*)(RQ + (size_t)(64 * n + 4 * f + g) * 1024 + hd * 128 + (c & 15) * 8) = pack8(a, b); }
            for (int idx = t2; idx < 1024; idx += 256) { const int dk = idx >> 3, k2 = (idx >> 2) & 1, g = idx & 3; f32x4 a, b;
#pragma unroll
                for (int jj = 0; jj < 4; ++jj) { const int c0 = 32 * k2 + 4 * g + jj, c1 = c0 + 16; a[jj] = ks[c0 * PT + dk] * __expf(gl - gcs[c0]); b[jj] = ks[c1 * PT + dk] * __expf(gl - gcs[c1]); }
                const int f = (dk >> 4) * 2 + k2;
                *(u32x4*)(RK + (size_t)(64 * n + 4 * f + g) * 1024 + hd * 128 + (dk & 15) * 8) = pack8(a, b); }
            if (t2 == 0) GL[it] = __expf(gl);
        }
        __syncthreads();
        for (int rp_ = 0; rp_ < ((CHREP & 16) ? 2 : 1); ++rp_)
        for (int idx = tid; idx < 1024; idx += NTHR) { const int f = idx >> 6, ln = idx & 63, lo = ln & 15, g = ln >> 4, c = (f >> 2) * 16 + lo, ksx = f & 3;
            const u32x2 a = *(const LAS u32x2*)(xw + c * 136 + 32 * ksx + 4 * g), b = *(const LAS u32x2*)(xw + c * 136 + 32 * ksx + 16 + 4 * g);
            *(u32x4*)(WB + (size_t)it * 8192 + f * 512 + ln * 8) = (u32x4){a.x, a.y, b.x, b.y}; }
        __syncthreads();
    }
}

__device__ __forceinline__ s16x8 ld2x8(const u16* p) { const u32x2 a = *(const u32x2*)p, b = *(const u32x2*)(p + 16); const u32x4 w = {a.x, a.y, b.x, b.y}; return __builtin_bit_cast(s16x8, w); }

constexpr int SC_STAGE = 32768, SC_HBS = 2 * SC_STAGE, SC_HBV = SC_HBS + 3 * 4096;
#define SC_BAR() do { asm volatile("s_waitcnt lgkmcnt(0)" ::: "memory"); __builtin_amdgcn_s_barrier(); asm volatile("" ::: "memory"); } while (0)
__device__ __forceinline__ void gdn_scan2(const Ptrs& P, LAS uchar* lds, int chain) {
    const int tid = opaque_tid(), lane = tid & 63, wave = __builtin_amdgcn_readfirstlane(tid >> 6);
    const int hd = chain >> 3, lo = lane & 15, g = lane >> 4, dv = (chain & 7) * 16 + lo;
    const uchar* RQb = (const uchar*)(P.ws + WS_GQ); const uchar* RKb = (const uchar*)(P.ws + WS_GK); const u16* RV = (const u16*)(P.ws + WS_GV);
    const uchar* WBb = (const uchar*)(P.ws + WS_GW); const uchar* QKb = (const uchar*)(P.ws + WS_GQK); const float* GL = (const float*)(P.ws + WS_GGL);
    if (wave >= 2 && wave <= 5) {
        const int lw = wave - 2, kind = lw >> 1, f0 = (lw & 1) * 8;
        const uchar* src; size_t chunk_stride, frag_stride;
        if (kind == 0) { src = WBb + (size_t)hd * 16384 + (size_t)f0 * 1024 + lane * 16; chunk_stride = (size_t)8 * 16384; frag_stride = 1024; }
        else { src = RKb + ((size_t)(4 * f0 + g) * 1024 + hd * 128) * 2 + lo * 16; chunk_stride = (size_t)64 * 2048; frag_stride = 8192; }
        LAS uchar* dst = lds + (kind * 16 + f0) * 1024 + lane * 16;
        u32x4 r0[8], r1[8], r2[8], r3[8];
#define SC_LD(R, n_) do { const uchar* p_ = src + (size_t)((n_) < 256 ? (n_) : 255) * chunk_stride; _Pragma("unroll") for (int i_ = 0; i_ < 8; ++i_) R[i_] = *(const u32x4*)(p_ + i_ * frag_stride); } while (0)
#define SC_ST(R, st_) do { _Pragma("unroll") for (int i_ = 0; i_ < 8; ++i_) *(LAS u32x4*)(dst + (st_) * SC_STAGE + i_ * 1024) = R[i_]; } while (0)
        SC_LD(r0, 0); asm volatile("s_waitcnt vmcnt(0)" ::: "memory"); SC_ST(r0, 0);
        SC_LD(r1, 1); SC_LD(r2, 2); SC_LD(r3, 3); SC_LD(r0, 4);
        for (int n = 0; n < 256; n += 4) {
            SC_BAR(); asm volatile("s_waitcnt vmcnt(24)" ::: "memory"); SC_ST(r1, 1); SC_LD(r1, n + 5);
            SC_BAR(); asm volatile("s_waitcnt vmcnt(24)" ::: "memory"); SC_ST(r2, 0); SC_LD(r2, n + 6);
            SC_BAR(); asm volatile("s_waitcnt vmcnt(24)" ::: "memory"); SC_ST(r3, 1); SC_LD(r3, n + 7);
            SC_BAR(); asm volatile("s_waitcnt vmcnt(24)" ::: "memory"); SC_ST(r0, 0); SC_LD(r0, n + 8);
        }
        SC_BAR();
        asm volatile("s_waitcnt vmcnt(0)" ::: "memory");
#undef SC_LD
#undef SC_ST
    } else if (wave == 0) {
        f32x4 Sb[8];
#pragma unroll
        for (int b = 0; b < 8; ++b) Sb[b] = (f32x4){0.f, 0.f, 0.f, 0.f};
        { const u32x4 z = {0u, 0u, 0u, 0u};
#pragma unroll
          for (int ks = 0; ks < 4; ++ks) *(LAS u32x4*)(lds + SC_HBS + ks * 1024 + lane * 16) = z; }
        const u16* ub = RV + (size_t)hd * 128 + (size_t)(dv >> 1) * 1024 + (dv & 1) * 64 + 4 * g;
        u32x2 un[4];
#pragma unroll
        for (int mb = 0; mb < 4; ++mb) un[mb] = *(const u32x2*)(ub + 16 * mb);
        float gln = GL[hd];
        s16x8 Bs[4];
#pragma unroll
        for (int ks = 0; ks < 4; ++ks) Bs[ks] = (s16x8){0, 0, 0, 0, 0, 0, 0, 0};
        int hb = 1;
        for (int n = 0; n < 256; ++n) {
            const LAS uchar* st = lds + (n & 1) * SC_STAGE + lane * 16;
            u32x2 uc[4];
#pragma unroll
            for (int mb = 0; mb < 4; ++mb) uc[mb] = un[mb];
            const float gl = gln;
            { const int nn = n < 255 ? n + 1 : 255; const u16* up = ub + (size_t)(64 * nn) * 1024;
#pragma unroll
              for (int mb = 0; mb < 4; ++mb) un[mb] = *(const u32x2*)(up + 16 * mb);
              gln = GL[nn * 8 + hd]; }
            SC_BAR();
            s16x8 wf[16], kf[16];
#pragma unroll
            for (int i_ = 0; i_ < 16; ++i_) wf[i_] = *(const LAS s16x8*)(st + i_ * 1024);
#pragma unroll
            for (int i_ = 0; i_ < 16; ++i_) kf[i_] = *(const LAS s16x8*)(st + (16 + i_) * 1024);
            __builtin_amdgcn_sched_barrier(0);
            f32x4 vn[4];
#pragma unroll
            for (int mb = 0; mb < 4; ++mb) { f32x4 a = {0.f, 0.f, 0.f, 0.f};
#pragma unroll
                for (int ks = 0; ks < 4; ++ks) a = mfma16(wf[mb * 4 + ks], Bs[ks], a);
                const unsigned ux_ = uc[mb].x, uy_ = uc[mb].y; const h16x2 u01 = __builtin_bit_cast(h16x2, ux_), u23 = __builtin_bit_cast(h16x2, uy_);
                vn[mb][0] = (float)u01[0] - a[0]; vn[mb][1] = (float)u01[1] - a[1]; vn[mb][2] = (float)u23[0] - a[2]; vn[mb][3] = (float)u23[1] - a[3]; }
            s16x8 Bv[2];
#pragma unroll
            for (int k2 = 0; k2 < 2; ++k2) { Bv[k2] = pk2blk(vn[2 * k2], vn[2 * k2 + 1]); *(LAS s16x8*)(lds + SC_HBV + (n & 1) * 2048 + k2 * 1024 + lane * 16) = Bv[k2]; }
#pragma unroll
            for (int b = 0; b < 8; ++b) { f32x4 a = Sb[b] * gl;
#pragma unroll
                for (int k2 = 0; k2 < 2; ++k2) a = mfma16(kf[b * 2 + k2], Bv[k2], a);
                Sb[b] = a; }
#pragma unroll
            for (int ks = 0; ks < 4; ++ks) { Bs[ks] = pk2blk(Sb[2 * ks], Sb[2 * ks + 1]); *(LAS s16x8*)(lds + SC_HBS + hb * 4096 + ks * 1024 + lane * 16) = Bs[ks]; }
            hb = (hb == 2) ? 0 : hb + 1;
        }
        SC_BAR();
    } else if (wave == 1 || wave == 6) {
        const int mb0 = (wave == 1) ? 0 : 2;
        const uchar* qdp = RQb + ((size_t)(16 * mb0 + g) * 1024 + hd * 128) * 2 + lo * 16;
        const uchar* qkp = QKb + (size_t)hd * 8192 + (size_t)(mb0 * 2) * 1024 + lane * 16;
        u16* ob = (u16*)P.out + (size_t)hd * 128 + (size_t)(dv >> 1) * 1024 + (dv & 1) * 64 + 4 * g + 16 * mb0;
        u32x4 q0[12], q1[12];
#define SC_LQ(R, n_) do { const int c_ = (n_) < 256 ? (n_) : 255; const uchar* p_ = qdp + (size_t)c_ * 131072; const uchar* k_ = qkp + (size_t)c_ * 65536; \
            _Pragma("unroll") for (int i_ = 0; i_ < 8; ++i_) R[i_] = *(const u32x4*)(p_ + i_ * 8192); _Pragma("unroll") for (int i_ = 0; i_ < 4; ++i_) R[8 + i_] = *(const u32x4*)(k_ + i_ * 1024); } while (0)
#define SC_BSTEP(R, n_) do { SC_BAR();     \
            s16x8 Bs[4], Bv[2]; _Pragma("unroll") for (int ks = 0; ks < 4; ++ks) Bs[ks] = *(const LAS s16x8*)(lds + SC_HBS + hbr * 4096 + ks * 1024 + lane * 16); \
            _Pragma("unroll") for (int k2 = 0; k2 < 2; ++k2) Bv[k2] = *(const LAS s16x8*)(lds + SC_HBV + ((n_) & 1) * 2048 + k2 * 1024 + lane * 16); \
            u16* op_ = ob + (size_t)(64 * (n_)) * 1024; \
            _Pragma("unroll") for (int m_ = 0; m_ < 2; ++m_) { f32x4 a = {0.f, 0.f, 0.f, 0.f}; \
                _Pragma("unroll") for (int ks = 0; ks < 4; ++ks) a = mfma16(__builtin_bit_cast(s16x8, R[m_ * 4 + ks]), Bs[ks], a); \
                _Pragma("unroll") for (int k2 = 0; k2 < 2; ++k2) a = mfma16(__builtin_bit_cast(s16x8, R[8 + m_ * 2 + k2]), Bv[k2], a); \
                u32x2 w; w.x = pk16(a[0], a[1]); w.y = pk16(a[2], a[3]); *(u32x2*)(op_ + 16 * m_) = w; } \
            hbr = (hbr == 2) ? 0 : hbr + 1; } while (0)
        int hbr = 0;
        SC_LQ(q0, 0); SC_LQ(q1, 1);
        SC_BAR();
        for (int n = 0; n < 256; n += 2) {
            SC_BSTEP(q0, n); SC_LQ(q0, n + 2);
            SC_BSTEP(q1, n + 1); SC_LQ(q1, n + 3);
        }
#undef SC_LQ
#undef SC_BSTEP
    } else {
        for (int n = 0; n < 257; ++n) SC_BAR();
    }
    asm volatile("s_waitcnt vmcnt(0) lgkmcnt(0)" ::: "memory");
    __syncthreads();
}

__device__ __forceinline__ void gdn_out(const Ptrs& P, LAS uchar* lds, int vcu, int G) {
    const int tid = opaque_tid(), lane = tid & 63, wid = __builtin_amdgcn_readfirstlane(tid >> 6);
    const u16* RV = (const u16*)P.out; u16* GATE = (u16*)(P.ws + WS_GGATE); const float* og = P.in(28);
    LAS u16* ot = (LAS u16*)lds;
    u32x4 wn[2]; u16 gn0[8], gn1[8]; const float og0 = og[lane], og1 = og[lane + 64];
#define GO_LOAD(it_) do { const int n_ = (it_) >> 3, hd_ = (it_) & 7; \
        _Pragma("unroll") for (int i_ = 0; i_ < 2; ++i_) { const int idx = tid + 512 * i_, row = idx >> 4, cc = idx & 15; wn[i_] = *(const u32x4*)(RV + (size_t)(64 * n_ + row) * 1024 + hd_ * 128 + cc * 8); } \
        _Pragma("unroll") for (int k = 0; k < 8; ++k) { const u16* gp = GATE + (size_t)(64 * n_ + wid * 8 + k) * 1024 + hd_ * 128; gn0[k] = gp[lane]; gn1[k] = gp[lane + 64]; } } while (0)
    if (vcu < 2048) GO_LOAD(vcu);
    for (int it = vcu; it < 2048; it += G) { const int n = it >> 3, hd = it & 7;
        u16 gv0[8], gv1[8];
#pragma unroll
        for (int i_ = 0; i_ < 2; ++i_) { const int idx = tid + 512 * i_, row = idx >> 4, cc = idx & 15; const u32x4 w = wn[i_];
            const int e0 = row * 128 + cc * 8, dvv = e0 >> 6, c0 = e0 & 63; const unsigned ww[4] = {w.x, w.y, w.z, w.w};
#pragma unroll
            for (int k = 0; k < 4; ++k) { ot[(c0 + 2 * k) * 130 + dvv] = (u16)(ww[k] & 0xffffu); ot[(c0 + 2 * k + 1) * 130 + dvv] = (u16)(ww[k] >> 16); } }
#pragma unroll
        for (int k = 0; k < 8; ++k) { gv0[k] = gn0[k]; gv1[k] = gn1[k]; }
        if (it + G < 2048) GO_LOAD(it + G);
        __syncthreads();
#pragma unroll
        for (int k = 0; k < 8; ++k) { const int c = wid * 8 + k; const float o0 = h2f(ot[c * 130 + lane]), o1 = h2f(ot[c * 130 + lane + 64]);
            const float rs = rsqrtf(wave_sum(o0 * o0 + o1 * o1) * (1.f / 128.f) + EPS);
            u16* gp = GATE + (size_t)(64 * n + c) * 1024 + hd * 128;
            gp[lane] = f2h(o0 * rs * og0 * siluf_(h2f(gv0[k]))); gp[lane + 64] = f2h(o1 * rs * og1 * siluf_(h2f(gv1[k]))); }
        __syncthreads();
    }
#undef GO_LOAD
}

__device__ __forceinline__ void final_norm(const Ptrs& P, int vcu, int G) {
    const int tid_ = opaque_tid(), lane = tid_ & 63, wave = __builtin_amdgcn_readfirstlane(tid_ >> 6);
    asm volatile("" : "+s"(vcu), "+s"(G));
    const int gw = vcu * NWAVES + wave, NGW = G * NWAVES; const float* fg = P.in(3); const u16* hs = (const u16*)(P.ws + WS_A16);
    u32x4 vn[2];
#pragma unroll
    for (int j = 0; j < 2; ++j) vn[j] = ((const u32x4*)(hs + (size_t)(gw < L ? gw : 0) * D) + lane)[64 * j];
    for (int m = gw; m < L; m += NGW) { u32x4 w[2]; float s = 0.f;
#pragma unroll
        for (int j = 0; j < 2; ++j) w[j] = vn[j];
        { const int mn = (m + NGW < L) ? m + NGW : m; const u32x4* xn_ = (const u32x4*)(hs + (size_t)mn * D) + lane;
#pragma unroll
          for (int j = 0; j < 2; ++j) vn[j] = xn_[64 * j]; }
        float v[2][8];
#pragma unroll
        for (int j = 0; j < 2; ++j) { const unsigned ww[4] = {w[j].x, w[j].y, w[j].z, w[j].w};
#pragma unroll
            for (int k = 0; k < 4; ++k) { const unsigned wk = ww[k]; const h16x2 hh = __builtin_bit_cast(h16x2, wk); v[j][2 * k] = (float)hh[0]; v[j][2 * k + 1] = (float)hh[1]; s += v[j][2 * k] * v[j][2 * k] + v[j][2 * k + 1] * v[j][2 * k + 1]; } }
        const float rs = rsqrtf(wave_sum(s) * (1.f / D) + EPS);
#pragma unroll
        for (int j = 0; j < 2; ++j) { const int c0 = 8 * (lane + 64 * j); const f32x4 g0 = *(const f32x4*)(fg + c0), g1 = *(const f32x4*)(fg + c0 + 4);
            float* o = P.out + (size_t)m * D + c0;
            *(f32x4*)o = (f32x4){v[j][0] * rs * g0[0], v[j][1] * rs * g0[1], v[j][2] * rs * g0[2], v[j][3] * rs * g0[3]};
            *(f32x4*)(o + 4) = (f32x4){v[j][4] * rs * g1[0], v[j][5] * rs * g1[1], v[j][6] * rs * g1[2], v[j][7] * rs * g1[3]}; } }
}

#ifndef CHECK
#define CHECK 0
#endif
constexpr size_t WS_CHK = 251 * MiB;
constexpr int CW_CHK = 2048;
__device__ __forceinline__ void chk_accum(const Ptrs& P, float num, float den) {
    num = wave_sum(num); den = wave_sum(den);
    if ((opaque_tid() & 63) == 0) { float* c = (float*)(P.ws + WS_CTL) + CW_CHK; atomicAdd(c, num); atomicAdd(c + 1, den); }
}
__device__ __forceinline__ void chk_emit(const Ptrs& P, int vcu, int G) {
    const float* c = (const float*)(P.ws + WS_CTL) + CW_CHK; const float num = __hip_atomic_load(c, __ATOMIC_RELAXED, __HIP_MEMORY_SCOPE_AGENT), den = __hip_atomic_load(c + 1, __ATOMIC_RELAXED, __HIP_MEMORY_SCOPE_AGENT);
    const float v = 1000.f * sqrtf(num / fmaxf(den, 1e-30f));
    for (size_t i = (size_t)vcu * NTHR + opaque_tid(); i < (size_t)L * D; i += (size_t)G * NTHR) P.out[i] = v;
}
#if CHECK == 3
constexpr int CHK_T = 2048;
__device__ __forceinline__ void chk_gdn_ref(const Ptrs& P, LAS uchar* lds, int vcu) {
    if (vcu >= 8) return;
    const int tid = opaque_tid(), hd = vcu;
    const u16* RQ = (const u16*)(P.ws + WS_GQ); const float* Gd = (const float*)(P.ws + WS_GG); const float* Bt = (const float*)(P.ws + WS_GBETA);
    const float* cw = P.in(25); u16* ref = (u16*)(P.ws + WS_CHK);
    LAS float* buf = (LAS float*)lds;
    LAS float* sst = buf + 512;
    for (int i = tid; i < 128 * 128; i += NTHR) sst[i] = 0.f;
    __syncthreads();
    const int which = tid >> 7, ch = tid & 127, col = hd * 128 + ch;
    float c0 = 0, c1 = 0, c2 = 0, c3 = 0, x0 = 0, x1 = 0, x2 = 0;
    if (tid < 384) { c0 = cw[0 * 3072 + which * 1024 + col]; c1 = cw[1 * 3072 + which * 1024 + col]; c2 = cw[2 * 3072 + which * 1024 + col]; c3 = cw[3 * 3072 + which * 1024 + col]; }
    const u16* src = RQ + (size_t)which * (16 * MiB) + col;
    for (int t = 0; t < CHK_T; ++t) {
        if (tid < 384) { const float x3 = h2f(src[(size_t)t * 1024]); buf[which * 128 + ch] = siluf_(c0 * x0 + c1 * x1 + c2 * x2 + c3 * x3); x0 = x1; x1 = x2; x2 = x3; }
        __syncthreads();
        if (tid < 128) { const int w = tid >> 6, l = tid & 63; const float a = buf[w * 128 + l], b = buf[w * 128 + l + 64]; const float ss = wave_sum(a * a + b * b); if (l == 0) buf[384 + w] = rsqrtf(ss + EPS); }
        __syncthreads();
        if (tid < 128) { const float rq = buf[384] * GDN_QS, rk = buf[385]; const float eg = __expf(Gd[(size_t)t * 8 + hd]), be = Bt[(size_t)t * 8 + hd];
            float r = 0.f;
            for (int d = 0; d < 128; ++d) { const float sv = sst[d * 128 + tid] * eg; sst[d * 128 + tid] = sv; r += sv * (buf[128 + d] * rk); }
            r = buf[256 + tid] - r; float o = 0.f;
            for (int d = 0; d < 128; ++d) { const float sv = sst[d * 128 + tid] + be * (buf[128 + d] * rk) * r; sst[d * 128 + tid] = sv; o += sv * (buf[d] * rq); }
            ref[((size_t)t * 8 + hd) * 128 + tid] = f2h(o); ((u16*)(P.ws + WS_STAT2))[((size_t)t * 8 + hd) * 128 + tid] = f2h(be * r); }
        __syncthreads();
    }
}
__device__ __forceinline__ void chk_gdn_cmp(const Ptrs& P, int vcu, int G, bool umode) {
    const u16* RV = (const u16*)(P.ws + WS_GV); const u16* ref = (const u16*)(P.ws + (umode ? WS_STAT2 : WS_CHK));
    float num = 0.f, den = 0.f;
    for (int i = vcu * NTHR + opaque_tid(); i < CHK_T * 1024; i += G * NTHR) { const int t = i >> 10, hd = (i >> 7) & 7, dv = i & 127, n = t >> 6, c = t & 63;
        const float mine = h2f(RV[(size_t)(64 * n + (dv >> 1)) * 1024 + hd * 128 + (dv & 1) * 64 + c]), r = h2f(ref[i]); num += (mine - r) * (mine - r); den += r * r; }
    chk_accum(P, num, den);
}
#endif

#if CHECK == 3
__device__ __forceinline__ void chk_gdn_qku(const Ptrs& P, int vcu, int G) {
    const u16* RV = (const u16*)(P.ws + WS_GV); const u16* QK = (const u16*)(P.ws + WS_GQK); u16* ref = (u16*)(P.ws + WS_CHK);
    float num = 0.f, den = 0.f;
    for (int i = vcu * NTHR + opaque_tid(); i < 64 * 1024; i += G * NTHR) { const int t = i >> 10, hd = (i >> 7) & 7, dv = i & 127; float o = 0.f;
        for (int j = 0; j < 64; ++j) o += h2f(QK[(size_t)hd * 4096 + t * 64 + j]) * h2f(RV[(size_t)(dv >> 1) * 1024 + hd * 128 + (dv & 1) * 64 + j]);
#ifdef CHK_W
        { const float r = h2f(ref[i]); num += (o - r) * (o - r); den += r * r; }
#else
        ref[i] = f2h(o);
#endif
    }
#ifdef CHK_W
    chk_accum(P, num, den);
#endif
}
#endif
#if CHECK == 9
__device__ __forceinline__ void chk_mfma(const Ptrs& P) {
    const int lane = opaque_tid() & 63, lo = lane & 15, g = lane >> 4;
    float bad = 0.f;
    { s16x8 a = {0,0,0,0,0,0,0,0}, b = {0,0,0,0,0,0,0,0};
      if (g == 0) { a[0] = (short)f2h((float)lo); b[0] = (short)f2h(1.f); }
      f32x4 d = {0.f, 0.f, 0.f, 0.f}; d = mfma16(a, b, d);
      for (int r = 0; r < 4; ++r) if (d[r] != (float)(4 * g + r)) bad += 1.f; }
    for (int J = 0; J < 32; ++J) {
        f32x4 v0, v1;
        for (int r = 0; r < 4; ++r) { v0[r] = (float)(4 * g + r); v1[r] = (float)(16 + 4 * g + r); }
        const s16x8 Bv = pk2blk(v0, v1);
        s16x8 a = {0,0,0,0,0,0,0,0};
        for (int e = 0; e < 8; ++e) { const int j = 16 * (e >> 2) + 4 * g + (e & 3); a[e] = (j == J) ? (short)f2h(1.f) : (short)0; }
        f32x4 d = {0.f, 0.f, 0.f, 0.f}; d = mfma16(a, Bv, d);
        for (int r = 0; r < 4; ++r) if (d[r] != (float)J) bad += 1000.f;
    }
    bad = wave_sum(bad);
    if (lane == 0) { float* c = (float*)(P.ws + WS_CTL) + CW_CHK; atomicAdd(c, bad); atomicAdd(c + 1, 1.f); }
}
#endif
#ifndef PHM
#define PHM 0xffff
#endif

__global__ void __launch_bounds__(NTHR, 2) fwd(Args args) {
    extern __shared__ __attribute__((aligned(16))) unsigned char lds_[];
    LAS uchar* lds = (LAS uchar*)lds_;
    const int tid = threadIdx.x;
    const int G = gridDim.x, bid = blockIdx.x; const int vcu = (G % 8 == 0) ? (bid % 8) * (G / 8) + bid / 8 : bid;
    Ptrs P; P.ka = (KArgs)__builtin_amdgcn_kernarg_segment_ptr(); P.out = args.out; P.ws = args.ws;
    uchar* ws = args.ws;
    volatile LAS unsigned* MISC = (volatile LAS unsigned*)(lds + MISC_OFF);
    for (int u = tid; u < (LDS_BYTES - MISC_OFF) / 4; u += NTHR) MISC[u] = 0u;
    __syncthreads();
    unsigned* ctl = (unsigned*)(ws + WS_CTL);
    XcdBarrier bar = xcd_barrier_post(ctl + CW_BAR, MISC + 8);
#if TIMING
    unsigned long long* ts_ = (unsigned long long*)(ws + WS_CTL + 65536); int nst_ = 1;
    if (bid == 0 && tid == 0) ts_[0] = __builtin_amdgcn_s_memrealtime();
#define GRID_BAR() do { xcd_barrier(bar); if (bid == 0 && tid == 0) ts_[nst_] = __builtin_amdgcn_s_memrealtime(); ++nst_; } while (0)
#else
#define GRID_BAR() xcd_barrier(bar)
#endif
    LAS float* tabA = (LAS float*)(lds + TABA_OFF); LAS float* tabB = (LAS float*)(lds + TABB_OFF);
    u16* A16 = (u16*)(ws + WS_A16); float* STAT = (float*)(ws + WS_STAT); float* STAT2 = (float*)(ws + WS_STAT2);
    u16* WIN = (u16*)(ws + WS_WIN); u16* WOUT = (u16*)(ws + WS_WOUT); u16* W1 = (u16*)(ws + WS_W1); u16* W2 = (u16*)(ws + WS_W2); u16* HID = (u16*)(ws + WS_HID);
    const f32x2* ROPE = (const f32x2*)(ws + WS_ROPE);
    float* H = args.out;

#if PHM & 1024
#ifndef GMASK
#define GMASK 0xffff
#endif
#define RUN_GEMM(EPI, e_, A_, B_, N_, K_, lda_, ldb_, S_) do { if constexpr ((GMASK >> EPI::ID) & 1) { pg8::Gemm g_{(const u16*)(A_), (const u16*)(B_), L, (N_), (K_), (lda_), (ldb_)}; \
        pg8::gemm_phase<EPI, pg8::StaticOrder, EPI::ALIGN, EPI::SP2>(lds, g_, S_, e_); } } while (0)
#else
#define RUN_GEMM(EPI, e_, A_, B_, N_, K_, lda_, ldb_, S_) do { (void)e_; } while (0)
#endif
#define MLP_UP() { pg8::StaticOrder S; S.init(L, 4096, G, bid); build_tab(tabA, S, STAT, 0, 32, 1.f / 1024.f); EpiUp e{HID, 4096, tabA}; RUN_GEMM(EpiUp, e, A16, W1, 4096, 1024, 1024, 1024, S); } GRID_BAR()
#if REP == 12
#define MLP_UP_REP() MLP_UP()
#else
#define MLP_UP_REP() do {} while (0)
#endif
#if REP == 14
#define MLP_DOWN_REP() { pg8::StaticOrder S; S.init(L, 1024, G, bid); EpiResid e{nullptr, (u16*)(ws + 196 * MiB), nullptr, nullptr}; RUN_GEMM(EpiResid, e, HID, W2, 1024, 4096, 4096, 4096, S); } GRID_BAR()
#else
#define MLP_DOWN_REP() do {} while (0)
#endif
#define MLP_BLOCK() do { \
        MLP_UP(); MLP_UP_REP(); MLP_DOWN_REP(); \
        { pg8::StaticOrder S; S.init(L, 1024, G, bid); EpiResid e{nullptr, A16, STAT, nullptr}; RUN_GEMM(EpiResid, e, HID, W2, 1024, 4096, 4096, 4096, S); } GRID_BAR(); } while (0)

#if CHECK == 9
    if (bid == 0 && tid < 64) chk_mfma(P);
#endif
#if PHM & 1
    prologue_x(P, vcu, G);
    convert_layer<0>(P, lds, vcu, G);
#endif
    GRID_BAR();

    { pg8::StaticOrder S; S.init(L, 3840, G, bid);
      EpiDsaIn e{(const float*)(ws + WS_RSTDX), (u16*)(ws + WS_DQ), (u16*)(ws + WS_DK), (u16*)(ws + WS_DVT), (u16*)(ws + WS_DQI), (u16*)(ws + WS_DKI), (float*)(ws + WS_DWI), P.in(7), P.in(8)};
      RUN_GEMM(EpiDsaIn, e, A16, WIN, 3840, 1024, 1024, 1024, S); }
#if REP == 1
    GRID_BAR();
    { pg8::StaticOrder S; S.init(L, 3840, G, bid);
      EpiDsaIn e{(const float*)(ws + WS_RSTDX), (u16*)(ws + WS_DQ), (u16*)(ws + WS_DK), (u16*)(ws + WS_DVT), (u16*)(ws + WS_DQI), (u16*)(ws + WS_DKI), (float*)(ws + WS_DWI), P.in(7), P.in(8)};
      RUN_GEMM(EpiDsaIn, e, A16, WIN, 3840, 1024, 1024, 1024, S); }
#endif

    GRID_BAR();
#if PHM & 4
    dsa_indexer(P, lds, vcu, G);
#endif
#if REP == 2
    GRID_BAR();
#if PHM & 4
    dsa_indexer(P, lds, vcu, G);
#endif
#endif

    GRID_BAR();
#if PHM & 8
    { const u16* Q = (const u16*)(ws + WS_DQ); const u16* K = (const u16*)(ws + WS_DK); const u16* VT = (const u16*)(ws + WS_DVT); const unsigned* BITS = (const unsigned*)(ws + WS_DBITS); u16* O = (u16*)(ws + WS_DO);
      if (G == 256) { const int head = vcu >> 5, s = vcu & 31;
#pragma unroll 1
          for (int i = 0; i < 2; ++i) { const int qb = i ? 63 - s : s; attn_unit<128, 128, true>(lds, Q + head * 128, 1024, K + head * 128, 1024, nullptr, 0, VT + (size_t)head * 128 * L, BITS, O + head * 128, 1024, qb); } }
      else { for (int j = vcu; j < 8 * 64; j += G) { const int head = j >> 6, qb = j & 63; attn_unit<128, 128, true>(lds, Q + head * 128, 1024, K + head * 128, 1024, nullptr, 0, VT + (size_t)head * 128 * L, BITS, O + head * 128, 1024, qb); } } }
#endif
#if REP == 3
    GRID_BAR();
#if PHM & 8
    { const u16* Q = (const u16*)(ws + WS_DQ); const u16* K = (const u16*)(ws + WS_DK); const u16* VT = (const u16*)(ws + WS_DVT); const unsigned* BITS = (const unsigned*)(ws + WS_DBITS); u16* O = (u16*)(ws + WS_DO);
      if (G == 256) { const int head = vcu >> 5, s = vcu & 31;
#pragma unroll 1
          for (int i = 0; i < 2; ++i) { const int qb = i ? 63 - s : s; attn_unit<128, 128, true>(lds, Q + head * 128, 1024, K + head * 128, 1024, nullptr, 0, VT + (size_t)head * 128 * L, BITS, O + head * 128, 1024, qb); } }
      else { for (int j = vcu; j < 8 * 64; j += G) { const int head = j >> 6, qb = j & 63; attn_unit<128, 128, true>(lds, Q + head * 128, 1024, K + head * 128, 1024, nullptr, 0, VT + (size_t)head * 128 * L, BITS, O + head * 128, 1024, qb); } } }
#endif
#endif

    GRID_BAR();
    { pg8::StaticOrder S; S.init(L, 1024, G, bid); EpiResid e{P.in(0), A16, STAT, nullptr}; RUN_GEMM(EpiResid, e, ws + WS_DO, WOUT, 1024, 1024, 1024, 1024, S); }
#if REP == 4
    GRID_BAR();
    { pg8::StaticOrder S; S.init(L, 1024, G, bid); EpiResid e{P.in(0), A16, STAT, nullptr}; RUN_GEMM(EpiResid, e, ws + WS_DO, WOUT, 1024, 1024, 1024, 1024, S); }
#endif

    GRID_BAR();
    MLP_BLOCK();
#if PHM & 1
    convert_layer<1>(P, lds, vcu, G);
#endif
#if REP == 13
    GRID_BAR();
#if PHM & 1
    convert_layer<1>(P, lds, vcu, G);
#endif
#endif
    GRID_BAR();

#if REP == 20
    GRID_BAR(); GRID_BAR(); GRID_BAR(); GRID_BAR(); GRID_BAR(); GRID_BAR(); GRID_BAR(); GRID_BAR(); GRID_BAR(); GRID_BAR();
#endif
    { pg8::StaticOrder S; S.init(L, 2048, G, bid); build_tab(tabA, S, STAT, 0, 32, 1.f / 1024.f); EpiGlu e{(u16*)(ws + WS_CU), P.in(11), tabA}; RUN_GEMM(EpiGlu, e, A16, WIN, 2048, 1024, 1024, 1024, S); }
#if REP == 5
    GRID_BAR();
    { pg8::StaticOrder S; S.init(L, 2048, G, bid); build_tab(tabA, S, STAT, 0, 32, 1.f / 1024.f); EpiGlu e{(u16*)(ws + WS_CU), P.in(11), tabA}; RUN_GEMM(EpiGlu, e, A16, WIN, 2048, 1024, 1024, 1024, S); }
#endif

    GRID_BAR();
#if PHM & 32
    conv_dw_phase(P, lds, vcu, G);
#endif
#if REP == 6
    GRID_BAR();
#if PHM & 32
    conv_dw_phase(P, lds, vcu, G);
#endif
#endif

    GRID_BAR();
#if !(SKIPMIX & 2)
    { pg8::StaticOrder S; S.init(L, 1024, G, bid); EpiResid e{nullptr, A16, STAT, P.in(17)}; RUN_GEMM(EpiResid, e, ws + WS_CL, WOUT, 1024, 1024, 1024, 1024, S); }
#endif
    GRID_BAR();
    MLP_BLOCK();
#if PHM & 1
    convert_layer<2>(P, lds, vcu, G);
#endif
    GRID_BAR();

    { pg8::StaticOrder S; S.init(L, 768, G, bid); build_tab(tabA, S, STAT, 0, 32, 1.f / 1024.f);
      EpiMlaIn e{(u16*)(ws + WS_MP), (u16*)(ws + WS_MKR), STAT2, ROPE, tabA}; RUN_GEMM(EpiMlaIn, e, A16, WIN, 768, 1024, 1024, 1024, S); }
#if REP == 7
    GRID_BAR();
    { pg8::StaticOrder S; S.init(L, 768, G, bid); build_tab(tabA, S, STAT, 0, 32, 1.f / 1024.f);
      EpiMlaIn e{(u16*)(ws + WS_MP), (u16*)(ws + WS_MKR), STAT2, ROPE, tabA}; RUN_GEMM(EpiMlaIn, e, A16, WIN, 768, 1024, 1024, 1024, S); }
#endif

    GRID_BAR();
    { pg8::StaticOrder S; S.init(L, 1536, G, bid); build_tab(tabA, S, STAT2, 0, 12, 1.f / 384.f);
      EpiMlaUq e{(u16*)(ws + WS_MQ), ROPE, tabA}; RUN_GEMM(EpiMlaUq, e, ws + WS_MP, ws + WS_WB, 1536, 384, 640, 384, S); }
    { pg8::StaticOrder S; S.init(L, 2048, G, bid); build_tab(tabB, S, STAT2, 12, 20, 1.f / 256.f);
      EpiMlaUkv e{(u16*)(ws + WS_MKN), (u16*)(ws + WS_MVT), tabB}; RUN_GEMM(EpiMlaUkv, e, (u16*)(ws + WS_MP) + 384, ws + WS_WC, 2048, 256, 640, 256, S); }
#if REP == 8
    GRID_BAR();
    { pg8::StaticOrder S; S.init(L, 1536, G, bid); build_tab(tabA, S, STAT2, 0, 12, 1.f / 384.f);
      EpiMlaUq e{(u16*)(ws + WS_MQ), ROPE, tabA}; RUN_GEMM(EpiMlaUq, e, ws + WS_MP, ws + WS_WB, 1536, 384, 640, 384, S); }
    { pg8::StaticOrder S; S.init(L, 2048, G, bid); build_tab(tabB, S, STAT2, 12, 20, 1.f / 256.f);
      EpiMlaUkv e{(u16*)(ws + WS_MKN), (u16*)(ws + WS_MVT), tabB}; RUN_GEMM(EpiMlaUkv, e, (u16*)(ws + WS_MP) + 384, ws + WS_WC, 2048, 256, 640, 256, S); }
#endif

    GRID_BAR();
#if PHM & 16
    { const u16* Q = (const u16*)(ws + WS_MQ); const u16* KN = (const u16*)(ws + WS_MKN); const u16* KR = (const u16*)(ws + WS_MKR); const u16* VT = (const u16*)(ws + WS_MVT); u16* O = (u16*)(ws + WS_MO);
      if (G == 256) { const int head = vcu >> 4, s = vcu & 15;
#pragma unroll 1
          for (int i = 0; i < 4; ++i) { const int qb = (i == 0) ? s : (i == 1) ? 31 - s : (i == 2) ? 32 + s : 63 - s;
              attn_unit<96, 64, false>(lds, Q + head * 96, 1536, KN + head * 64, 1024, KR, 32, VT + (size_t)head * 64 * L, nullptr, O + head * 64, 1024, qb); } }
      else { for (int j = vcu; j < 16 * 64; j += G) { const int head = j >> 6, qb = j & 63; attn_unit<96, 64, false>(lds, Q + head * 96, 1536, KN + head * 64, 1024, KR, 32, VT + (size_t)head * 64 * L, nullptr, O + head * 64, 1024, qb); } } }
#endif
#if REP == 9
    GRID_BAR();
#if PHM & 16
    { const u16* Q = (const u16*)(ws + WS_MQ); const u16* KN = (const u16*)(ws + WS_MKN); const u16* KR = (const u16*)(ws + WS_MKR); const u16* VT = (const u16*)(ws + WS_MVT); u16* O = (u16*)(ws + WS_MO);
      if (G == 256) { const int head = vcu >> 4, s = vcu & 15;
#pragma unroll 1
          for (int i = 0; i < 4; ++i) { const int qb = (i == 0) ? s : (i == 1) ? 31 - s : (i == 2) ? 32 + s : 63 - s;
              attn_unit<96, 64, false>(lds, Q + head * 96, 1536, KN + head * 64, 1024, KR, 32, VT + (size_t)head * 64 * L, nullptr, O + head * 64, 1024, qb); } }
      else { for (int j = vcu; j < 16 * 64; j += G) { const int head = j >> 6, qb = j & 63; attn_unit<96, 64, false>(lds, Q + head * 96, 1536, KN + head * 64, 1024, KR, 32, VT + (size_t)head * 64 * L, nullptr, O + head * 64, 1024, qb); } } }
#endif
#endif

    GRID_BAR();
#if !(SKIPMIX & 4)
    { pg8::StaticOrder S; S.init(L, 1024, G, bid); EpiResid e{nullptr, A16, STAT, nullptr}; RUN_GEMM(EpiResid, e, ws + WS_MO, WOUT, 1024, 1024, 1024, 1024, S); }
#endif
    GRID_BAR();
    MLP_BLOCK();
#if PHM & 1
    convert_layer<3>(P, lds, vcu, G);
#endif
    GRID_BAR();

    { pg8::StaticOrder S; S.init(L, 3072, G, bid); build_tab(tabA, S, STAT, 0, 32, 1.f / 1024.f);
      EpiScale16 e{(u16*)(ws + WS_GQ), 1024, (size_t)16 * MiB, tabA}; RUN_GEMM(EpiScale16, e, A16, WIN, 3072, 1024, 1024, 1024, S); }
    { pg8::StaticOrder S; S.init(L, 1024, G, bid); build_tab(tabB, S, STAT, 0, 32, 1.f / 1024.f);
      EpiScale16 e{(u16*)(ws + WS_GGATE), 1024, (size_t)0, tabB}; RUN_GEMM(EpiScale16, e, A16, ws + WS_WD, 1024, 1024, 1024, 1024, S); }
#if REP == 10
    GRID_BAR();
    { pg8::StaticOrder S; S.init(L, 3072, G, bid); build_tab(tabA, S, STAT, 0, 32, 1.f / 1024.f);
      EpiScale16 e{(u16*)(ws + WS_GQ), 1024, (size_t)16 * MiB, tabA}; RUN_GEMM(EpiScale16, e, A16, WIN, 3072, 1024, 1024, 1024, S); }
    { pg8::StaticOrder S; S.init(L, 1024, G, bid); build_tab(tabB, S, STAT, 0, 32, 1.f / 1024.f);
      EpiScale16 e{(u16*)(ws + WS_GGATE), 1024, (size_t)0, tabB}; RUN_GEMM(EpiScale16, e, A16, ws + WS_WD, 1024, 1024, 1024, 1024, S); }
#endif

    GRID_BAR();
#if PHM & 64
    gdn_pre(P, lds, vcu, G);
#endif
#if REP == 11
    GRID_BAR();
#if PHM & 64
    gdn_pre(P, lds, vcu, G);
#endif
#endif

    GRID_BAR();
#if CHECK == 3
    chk_gdn_ref(P, lds, vcu);
    GRID_BAR();
#endif
#if PHM & 128
    gdn_chunk(P, lds, vcu, G);
#endif
    GRID_BAR();
#if CHECK == 3 && defined(CHK_V)
    chk_gdn_qku(P, vcu, G);
    GRID_BAR();
#endif
#if CHECK == 3 && defined(CHK_U)
    chk_gdn_cmp(P, vcu, G, true);
    GRID_BAR();
#endif
#if PHM & 256
    for (int c = 0; c < 64; ++c) if ((4 * c) % G == vcu) gdn_scan2(P, lds, c);
#if REP == 15
    GRID_BAR();
    for (int c = 0; c < 64; ++c) if ((4 * c) % G == vcu) gdn_scan2(P, lds, c);
#endif
#endif
    GRID_BAR();
#if CHECK == 3 && !defined(CHK_U) && !defined(CHK_W)
    chk_gdn_cmp(P, vcu, G, false);
    GRID_BAR();
#endif
#if PHM & 512
    gdn_out(P, lds, vcu, G);
#endif
    GRID_BAR();
#if !(SKIPMIX & 8)
    { pg8::StaticOrder S; S.init(L, 1024, G, bid); EpiResid e{nullptr, A16, STAT, nullptr}; RUN_GEMM(EpiResid, e, ws + WS_GGATE, WOUT, 1024, 1024, 1024, 1024, S); }
#endif
    GRID_BAR();
    MLP_BLOCK();
#if PHM & 1
    final_norm(P, vcu, G);
#endif
#if CHECK
    GRID_BAR();
    chk_emit(P, vcu, G);
#endif
#if TIMING
    GRID_BAR();
    { float ta = (float)(long long)(ts_[TA1] - ts_[TA0]) * 0.01f, tb = (float)(long long)(ts_[TB1] - ts_[TB0]) * 0.01f;
      ta = floorf((ta + TQOFF) / TQ) * TQ; tb = floorf((tb + TQOFF) / TQ) * TQ;
      const float ca = sqrtf(ta * 0.1f), cb = tb;
      for (size_t i = (size_t)vcu * NTHR + opaque_tid(); i < (size_t)L * D; i += (size_t)G * NTHR) H[i] = (i == 12345) ? cb : ca; }
#endif
}

extern "C" void kernel_launch(void* const* d_in, const int* in_sizes, int n_in, void* d_out, int out_size, void* d_ws, size_t ws_size, hipStream_t stream) {
    static int grid = 0;
    if (grid == 0) {
        if (n_in != 30 || in_sizes[0] != L * D || out_size != L * D || ws_size < WS_END) { fprintf(stderr, "kernel_launch: unexpected shapes (n_in %d, in0 %d, out %d, ws %zu); nothing launched\n", n_in, n_in > 0 ? in_sizes[0] : -1, out_size, ws_size); grid = -1; return; }
        int dev = 0, cus = 0, per_cu = 0;
        if (hipGetDevice(&dev) != hipSuccess || hipDeviceGetAttribute(&cus, hipDeviceAttributeMultiprocessorCount, dev) != hipSuccess) { grid = -1; return; }
        if (hipFuncSetAttribute((const void*)fwd, hipFuncAttributeMaxDynamicSharedMemorySize, LDS_BYTES) != hipSuccess) { fprintf(stderr, "kernel_launch: hipFuncSetAttribute failed\n"); grid = -1; return; }
        if (hipOccupancyMaxActiveBlocksPerMultiprocessor(&per_cu, (const void*)fwd, NTHR, LDS_BYTES) != hipSuccess || per_cu < 1) fprintf(stderr, "kernel_launch: occupancy query reports %d workgroups per CU\n", per_cu);
        (void)hipGetLastError();
        grid = cus;
    }
    if (grid < 0) return;
    if (hipMemsetAsync((char*)d_ws + WS_CTL, 0, CTL_ZERO_BYTES, stream) != hipSuccess) return;
    Args a{};
    for (int i = 0; i < 30; ++i) a.in[i] = (const float*)d_in[i];
    a.out = (float*)d_out; a.ws = (uchar*)d_ws;
    hipLaunchKernelGGL(fwd, dim3(grid), dim3(NTHR), LDS_BYTES, stream, a);
}
```
